# Optimizing an MI355X kernel written in HIP

```python
import math
import jax, jax.numpy as jnp
from jax import lax
import numpy as np

D_MODEL = 2048
BATCH = 4
SEQ = 4096
DEPTH = 4

N_MIXERS = 3
FOX_HEADS = 16
FOX_HEAD_DIM = D_MODEL // FOX_HEADS
FOX_Q_BLOCK = 128
GLA_HEADS = 4
GLA_KEY_DIM = D_MODEL // 2
GLA_VALUE_DIM = D_MODEL
GLA_DK = GLA_KEY_DIM // GLA_HEADS
GLA_DV = GLA_VALUE_DIM // GLA_HEADS
GLA_GATE_RANK = 16
GLA_GATE_TAU = 16.0
GLA_CHUNK = 64
CONV_WIDTH = 3
D_FF = 5632
LN_EPS = 1e-5
RMS_EPS = 1e-5
DEEPNORM_ALPHA = (2 * DEPTH) ** 0.25
DEEPNORM_BETA = (8 * DEPTH) ** -0.25
N_FOX = (DEPTH + 2) // 3
N_GLA = (DEPTH + 1) // 3
N_CONV = DEPTH // 3

kernel_name = 'hybrid_fox_gla_shortconv_deepnorm_adaln'


def layer_norm(x, g, b):
    xf = x.astype(jnp.float32)
    mu = jnp.mean(xf, axis=-1, keepdims=True)
    var = jnp.mean(jnp.square(xf - mu), axis=-1, keepdims=True)
    return ((xf - mu) * lax.rsqrt(var + LN_EPS) * g + b).astype(x.dtype)


def causal_dwconv(x, w):
    s = x.shape[1]
    xp = jnp.pad(x, ((0, 0), (CONV_WIDTH - 1, 0), (0, 0)))
    y = xp[:, 0:s] * w[0]
    for k in range(1, CONV_WIDTH):
        y = y + xp[:, k:k + s] * w[k]
    return y


def fox_mixer(h, wq, wk, wv, wg, wf, bf, wo):
    b, s, _ = h.shape
    nq = s // FOX_Q_BLOCK

    def heads(w):
        return (h @ w).reshape(b, s, FOX_HEADS, FOX_HEAD_DIM).transpose(0, 2, 1, 3)

    q = heads(wq) * (FOX_HEAD_DIM ** -0.5)
    k = heads(wk)
    v = heads(wv)
    log_f = jax.nn.log_sigmoid((h @ wf + bf).astype(jnp.float32))
    cum = jnp.cumsum(log_f, axis=1).transpose(0, 2, 1)
    pos = jnp.arange(s)
    q_blocks = q.reshape(b, FOX_HEADS, nq, FOX_Q_BLOCK, FOX_HEAD_DIM).transpose(2, 0, 1, 3, 4)
    f_blocks = cum.reshape(b, FOX_HEADS, nq, FOX_Q_BLOCK).transpose(2, 0, 1, 3)
    p_blocks = pos.reshape(nq, FOX_Q_BLOCK)

    def attend(args):
        q_blk, f_blk, p_blk = args
        logits = jnp.einsum('bhqd,bhkd->bhqk', q_blk, k).astype(jnp.float32)
        logits = logits + f_blk[..., None] - cum[:, :, None, :]
        logits = jnp.where(pos[None, :] <= p_blk[:, None], logits, -jnp.inf)
        probs = jax.nn.softmax(logits, axis=-1)
        return jnp.einsum('bhqk,bhkd->bhqd', probs.astype(v.dtype), v)

    o = lax.map(attend, (q_blocks, f_blocks, p_blocks))
    o = o.transpose(1, 0, 3, 2, 4).reshape(b, s, FOX_HEADS * FOX_HEAD_DIM)
    o = o * jax.nn.sigmoid(h @ wg)
    return o @ wo


def gla_mixer(h, wq, wk, wv, wa1, wa2, ba, wr, norm_g, wo):
    b, s, _ = h.shape
    nc = s // GLA_CHUNK
    f32 = jnp.float32

    def heads(t, d):
        return t.astype(f32).reshape(b, nc, GLA_CHUNK, GLA_HEADS, d).transpose(0, 3, 1, 2, 4)

    q = heads(h @ wq, GLA_DK) * (GLA_DK ** -0.5)
    k = heads(h @ wk, GLA_DK)
    v = heads(h @ wv, GLA_DV)
    log_a = jax.nn.log_sigmoid(((h @ wa1) @ wa2 + ba).astype(f32)) / GLA_GATE_TAU
    log_a = heads(log_a, GLA_DK)
    cb = jnp.cumsum(log_a, axis=3)
    cb_last = cb[:, :, :, -1]
    q_dec = q * jnp.exp(cb)
    k_inv = k * jnp.exp(-cb)
    k_dec = k * jnp.exp(cb_last[:, :, :, None, :] - cb)
    causal = jnp.tril(jnp.ones((GLA_CHUNK, GLA_CHUNK), dtype=bool))
    att = jnp.einsum('bhnid,bhnjd->bhnij', q_dec, k_inv)
    att = jnp.where(causal, att, 0.0)
    o_intra = jnp.einsum('bhnij,bhnjv->bhniv', att, v)

    def step(state, xs):
        qd, kd, vc, bl = xs
        o_c = jnp.einsum('bhcd,bhdv->bhcv', qd, state)
        state = jnp.exp(bl)[..., None] * state + jnp.einsum('bhcd,bhcv->bhdv', kd, vc)
        return state, o_c

    def chunk_major(t):
        return jnp.moveaxis(t, 2, 0)

    s0 = jnp.zeros((b, GLA_HEADS, GLA_DK, GLA_DV), f32)
    _, o_inter = lax.scan(step, s0, (chunk_major(q_dec), chunk_major(k_dec),
                                     chunk_major(v), chunk_major(cb_last)))
    o = o_intra + jnp.moveaxis(o_inter, 0, 2)
    o = o * lax.rsqrt(jnp.mean(o * o, axis=-1, keepdims=True) + RMS_EPS) * norm_g
    o = o.transpose(0, 2, 3, 1, 4).reshape(b, s, GLA_VALUE_DIM).astype(h.dtype)
    o = o * jax.nn.silu(h @ wr)
    return o @ wo


def short_conv_mixer(h, w_in, conv_w, w_out):
    gate_b, gate_c, u = jnp.split(h @ w_in, 3, axis=-1)
    return (gate_b * causal_dwconv(gate_c * u, conv_w)) @ w_out


def conv_ffn(h, w_up, conv_w, conv_b, w_down):
    z = causal_dwconv(h @ w_up, conv_w) + conv_b
    a, u = jnp.split(z, 2, axis=-1)
    return (jax.nn.silu(a) * u) @ w_down


def setup_inputs(seed: int = 0) -> dict:
    key = jax.random.key(seed)
    keys = list(jax.random.split(key, 40))
    counter = [0]

    def nrm(shape, scale):
        kk = keys[counter[0]]
        counter[0] += 1
        return jax.random.normal(kk, shape, jnp.float32) * scale

    D = D_MODEL
    beta = DEEPNORM_BETA
    x = nrm((BATCH, SEQ, D), 1.0)
    c = nrm((BATCH, D), 1.0)
    ada_w = nrm((DEPTH, D, 6 * D), D ** -0.5)
    ada_b = nrm((DEPTH, 6 * D), 0.02)
    ln1_g = 1.0 + nrm((DEPTH, D), 0.02)
    ln1_b = nrm((DEPTH, D), 0.02)
    ln2_g = 1.0 + nrm((DEPTH, D), 0.02)
    ln2_b = nrm((DEPTH, D), 0.02)
    fox_wq = nrm((N_FOX, D, D), D ** -0.5)
    fox_wk = nrm((N_FOX, D, D), D ** -0.5)
    fox_wv = nrm((N_FOX, D, D), D ** -0.5)
    fox_wg = nrm((N_FOX, D, D), D ** -0.5)
    fox_wf = nrm((N_FOX, D, FOX_HEADS), D ** -0.5)
    fox_bf = 2.0 + nrm((N_FOX, FOX_HEADS), 0.5)
    fox_wo = nrm((N_FOX, D, D), D ** -0.5 * beta)
    gla_wq = nrm((N_GLA, D, GLA_KEY_DIM), D ** -0.5)
    gla_wk = nrm((N_GLA, D, GLA_KEY_DIM), D ** -0.5)
    gla_wv = nrm((N_GLA, D, GLA_VALUE_DIM), D ** -0.5)
    gla_wa1 = nrm((N_GLA, D, GLA_GATE_RANK), D ** -0.5)
    gla_wa2 = nrm((N_GLA, GLA_GATE_RANK, GLA_KEY_DIM), GLA_GATE_RANK ** -0.5)
    gla_ba = nrm((N_GLA, GLA_KEY_DIM), 0.1)
    gla_wr = nrm((N_GLA, D, GLA_VALUE_DIM), D ** -0.5)
    gla_norm_g = 1.0 + nrm((N_GLA, GLA_DV), 0.02)
    gla_wo = nrm((N_GLA, GLA_VALUE_DIM, D), GLA_VALUE_DIM ** -0.5 * beta)
    conv_w_in = nrm((N_CONV, D, 3 * D), D ** -0.5)
    conv_w = nrm((N_CONV, CONV_WIDTH, D), CONV_WIDTH ** -0.5)
    conv_w_out = nrm((N_CONV, D, D), D ** -0.5 * beta)
    ffn_w_up = nrm((DEPTH, D, 2 * D_FF), D ** -0.5)
    ffn_conv_w = nrm((DEPTH, CONV_WIDTH, 2 * D_FF), CONV_WIDTH ** -0.5)
    ffn_conv_b = nrm((DEPTH, 2 * D_FF), 0.02)
    ffn_w_down = nrm((DEPTH, D_FF, D), D_FF ** -0.5 * beta)
    return {'x': x, 'c': c, 'ada_w': ada_w, 'ada_b': ada_b,
            'ln1_g': ln1_g, 'ln1_b': ln1_b, 'ln2_g': ln2_g, 'ln2_b': ln2_b,
            'fox_wq': fox_wq, 'fox_wk': fox_wk, 'fox_wv': fox_wv, 'fox_wg': fox_wg,
            'fox_wf': fox_wf, 'fox_bf': fox_bf, 'fox_wo': fox_wo,
            'gla_wq': gla_wq, 'gla_wk': gla_wk, 'gla_wv': gla_wv, 'gla_wa1': gla_wa1,
            'gla_wa2': gla_wa2, 'gla_ba': gla_ba, 'gla_wr': gla_wr,
            'gla_norm_g': gla_norm_g, 'gla_wo': gla_wo,
            'conv_w_in': conv_w_in, 'conv_w': conv_w, 'conv_w_out': conv_w_out,
            'ffn_w_up': ffn_w_up, 'ffn_conv_w': ffn_conv_w, 'ffn_conv_b': ffn_conv_b,
            'ffn_w_down': ffn_w_down}


def reference(x, c, ada_w, ada_b, ln1_g, ln1_b, ln2_g, ln2_b,
              fox_wq, fox_wk, fox_wv, fox_wg, fox_wf, fox_bf, fox_wo,
              gla_wq, gla_wk, gla_wv, gla_wa1, gla_wa2, gla_ba, gla_wr,
              gla_norm_g, gla_wo,
              conv_w_in, conv_w, conv_w_out,
              ffn_w_up, ffn_conv_w, ffn_conv_b, ffn_w_down):
    cond = jax.nn.silu(c)
    for i in range(DEPTH):
        mod = cond @ ada_w[i] + ada_b[i]
        sh1, sc1, g1, sh2, sc2, g2 = [m[:, None, :] for m in jnp.split(mod, 6, axis=-1)]
        h = x * (1.0 + sc1) + sh1
        kind = i % N_MIXERS
        j = i // N_MIXERS
        if kind == 0:
            y = fox_mixer(h, fox_wq[j], fox_wk[j], fox_wv[j], fox_wg[j],
                          fox_wf[j], fox_bf[j], fox_wo[j])
        elif kind == 1:
            y = gla_mixer(h, gla_wq[j], gla_wk[j], gla_wv[j], gla_wa1[j], gla_wa2[j],
                          gla_ba[j], gla_wr[j], gla_norm_g[j], gla_wo[j])
        else:
            y = short_conv_mixer(h, conv_w_in[j], conv_w[j], conv_w_out[j])
        x = layer_norm(DEEPNORM_ALPHA * x + g1 * y, ln1_g[i], ln1_b[i])
        h = x * (1.0 + sc2) + sh2
        y = conv_ffn(h, ffn_w_up[i], ffn_conv_w[i], ffn_conv_b[i], ffn_w_down[i])
        x = layer_norm(DEEPNORM_ALPHA * x + g2 * y, ln2_g[i], ln2_b[i])
    return x
```

```cpp
#include <hip/hip_runtime.h>
#include <hip/hip_bf16.h>
#include <cstdio>
#include <cstdint>

#ifndef MK_PER_PHASE
#define MK_PER_PHASE 0
#endif

namespace pg8 {
#define PG8_LAS __attribute__((address_space(3)))
typedef unsigned short bf16_t;
typedef short bf16x8 __attribute__((ext_vector_type(8)));
typedef float f32x4 __attribute__((ext_vector_type(4)));
typedef unsigned u32x4 __attribute__((ext_vector_type(4)));
constexpr int BM = 256, BK = 64, HALF = 128, HTB = HALF * BK * 2  , STAGE_BYTES = 8 * HTB, NXCD = 8, WGM = 8;

__host__ __device__ __forceinline__ int lds_byte(int r, int c) { const int st = (r >> 4) * 2 + (c >> 5), rr = r & 15, cc = c & 31, ob = rr * 64 + cc * 2; return st * 1024 + (ob ^ (((ob >> 9) & 1) << 5)); }
__host__ __device__ __forceinline__ void stage_rc(int b, int& R, int& C) { const int st = b / 1024, sb = b % 1024, swz = sb ^ (((sb >> 9) & 1) << 5); R = (st >> 1) * 16 + swz / 64; C = (st & 1) * 32 + (swz % 64) / 2; }
__host__ __device__ __forceinline__ int perm32(int rho) { const int n = rho >> 4, i = rho & 15; return 8 * (i >> 2) + 4 * n + (i & 3); }

struct Unit { int pm, pn; };
struct Gemm { const bf16_t* A; const bf16_t* Bt; int M, N, K; };

struct StaticOrder {
    int nM, nN, nwg, G, c;
    __host__ __device__ void init(int M, int N, int G_, int c_) { nM = M / BM; nN = N / BM; nwg = nM * nN; G = G_; c = c_; }
    __host__ __device__ bool next(int i, Unit& u) const {
        const long L = (long)i * G + c; if (L >= nwg) return false;
        int wgid = (int)L; { const int q = nwg / NXCD, r = nwg % NXCD, xcd = wgid % NXCD, off = wgid / NXCD; wgid = (xcd < r ? xcd * (q + 1) : r * (q + 1) + (xcd - r) * q) + off; }
        const int nig = WGM * nN, gid = wgid / nig, fm = gid * WGM, gsz = (nM - fm) < WGM ? (nM - fm) : WGM;
        u.pm = fm + ((wgid % nig) % gsz); u.pn = (wgid % nig) / gsz; return true;
    }
    __device__ __forceinline__ void a_ready(const Unit&) const {}
    __device__ __forceinline__ void done(const Unit&) const {}
};

__device__ __forceinline__ unsigned cvt_pk_bf16(float lo, float hi) { unsigned r; asm volatile("v_cvt_pk_bf16_f32 %0, %1, %2" : "=v"(r) : "v"(lo), "v"(hi)); return r; }
typedef float f32x2 __attribute__((ext_vector_type(2)));
template <class Epi, class Sched, bool ALIGN_EPI = false, bool SP2 = false>
__device__ __forceinline__ void gemm_phase(PG8_LAS unsigned char* lds, const Gemm g, const Sched& S, const Epi& E, int tid_in) {
    int tid_ = tid_in; asm volatile("" : "+v"(tid_));
    const int tid = tid_, wid = __builtin_amdgcn_readfirstlane(tid >> 6), lane = tid & 63, wr = wid >> 2, wc = wid & 3, fr = lane & 15, fq = lane >> 4;
    const int K = g.K, nt = K / BK;
    unsigned voffA[2], voffB[2];
#pragma unroll
    for (int i = 0; i < 2; ++i) { int R, C; stage_rc(tid * 16 + i * 8192, R, C); const int Rb = Epi::PERM ? ((R & ~31) + perm32(R & 31)) : R;
        voffA[i] = (unsigned)(R * K + C) * 2u; voffB[i] = (unsigned)(Rb * K + C) * 2u; }
    const size_t kstep = (size_t)(BK * 2);
    const size_t hstep = (size_t)HALF * K * 2;
    const size_t tstep = 2 * hstep;
    const unsigned ldsw = (unsigned)wid * 1024u;
    const int aoff = lds_byte(wr * 64 + fr, fq * 8), boff = lds_byte(wc * 32 + fr, fq * 8);
#define PG8_SA(b, h) (((b) * 2 + (h)) * HTB)
#define PG8_SB(b, h) ((4 + (b) * 2 + (h)) * HTB)
#define PG8_STAGE(bufoff, gbase, voff) do { _Pragma("unroll") for (int _i = 0; _i < 2; ++_i) \
        __builtin_amdgcn_global_load_lds((const unsigned*)((const char*)(gbase) + (voff)[_i]), (PG8_LAS unsigned*)(lds + (bufoff) + ldsw + _i * 8192), 16, 0, 0); } while (0)
#define PG8_LDA(dst, b, h) do { _Pragma("unroll") for (int m = 0; m < 4; ++m) _Pragma("unroll") for (int k = 0; k < 2; ++k) dst[m][k] = *(const PG8_LAS bf16x8*)(lds + PG8_SA(b, h) + aoff + m * 2048 + k * 1024); } while (0)
#define PG8_LDB(dst, b, h) do { _Pragma("unroll") for (int n = 0; n < 2; ++n) _Pragma("unroll") for (int k = 0; k < 2; ++k) dst[n][k] = *(const PG8_LAS bf16x8*)(lds + PG8_SB(b, h) + boff + n * 2048 + k * 1024); } while (0)
#define PG8_MMA(ai, bj, At, Bt) do { __builtin_amdgcn_s_setprio(1); _Pragma("unroll") for (int m = 0; m < 4; ++m) _Pragma("unroll") for (int n = 0; n < 2; ++n) _Pragma("unroll") for (int k = 0; k < 2; ++k) \
        acc[ai][bj][m][n] = __builtin_amdgcn_mfma_f32_16x16x32_bf16(Bt[n][k], At[m][k], acc[ai][bj][m][n], 0, 0, 0); __builtin_amdgcn_s_setprio(0); } while (0)
#define PG8_WAIT_V(n) asm volatile("s_waitcnt vmcnt(" #n ")" ::: "memory")
#define PG8_WAIT_L(n) asm volatile("s_waitcnt lgkmcnt(" #n ")" ::: "memory")
#define PG8_BAR __builtin_amdgcn_s_barrier()
#define PG8_SCHED __builtin_amdgcn_sched_barrier(0)
    Unit cur, nxt; int ui = 0;
    if (!S.next(0, cur)) return;
    f32x4 acc[2][2][4][2];
#pragma unroll
    for (int a = 0; a < 2; ++a)
#pragma unroll
        for (int b = 0; b < 2; ++b)
#pragma unroll
            for (int m = 0; m < 4; ++m)
#pragma unroll
                for (int n = 0; n < 2; ++n) acc[a][b][m][n] = (f32x4){0.f, 0.f, 0.f, 0.f};
    bf16x8 At[4][2], B0[2][2], B1[2][2];
    const char* cA = (const char*)g.A + (size_t)cur.pm * tstep; const char* cB = (const char*)g.Bt + (size_t)cur.pn * tstep;
    S.a_ready(cur);
    if constexpr (SP2) {
        PG8_STAGE(PG8_SB(0, 0), cB, voffB); PG8_STAGE(PG8_SB(0, 1), cB + hstep, voffB); PG8_STAGE(PG8_SA(0, 0), cA, voffA); PG8_STAGE(PG8_SA(0, 1), cA + hstep, voffA);
        if (wr == 1) PG8_BAR;
        PG8_WAIT_V(2); PG8_BAR;
        PG8_STAGE(PG8_SB(1, 0), cB + kstep, voffB); PG8_STAGE(PG8_SA(1, 0), cA + kstep, voffA); PG8_STAGE(PG8_SB(1, 1), cB + hstep + kstep, voffB);
        PG8_WAIT_V(6); PG8_BAR;
    } else {
        PG8_STAGE(PG8_SB(0, 0), cB, voffB); PG8_STAGE(PG8_SA(0, 0), cA, voffA); PG8_STAGE(PG8_SB(0, 1), cB + hstep, voffB); PG8_STAGE(PG8_SA(0, 1), cA + hstep, voffA);
        if (wr == 1) PG8_BAR;
        PG8_WAIT_V(4); PG8_BAR;
        PG8_STAGE(PG8_SB(1, 0), cB + kstep, voffB); PG8_STAGE(PG8_SA(1, 0), cA + kstep, voffA); PG8_STAGE(PG8_SB(1, 1), cB + hstep + kstep, voffB);
        PG8_WAIT_V(6); PG8_BAR;
    }
    for (;;) {
        const bool has_next = S.next(ui + 1, nxt);
        const char* nA = has_next ? (const char*)g.A + (size_t)nxt.pm * tstep : cA; const char* nB = has_next ? (const char*)g.Bt + (size_t)nxt.pn * tstep : cB;
        for (int t = 0; t < nt; t += 2) {
            const bool last = (t == nt - 2);
            const char* a1 = cA + (size_t)(t + 1) * kstep;
            const char* a2 = last ? nA : cA + (size_t)(t + 2) * kstep; const char* b2 = last ? nB : cB + (size_t)(t + 2) * kstep;
            const char* a3 = a2 + kstep; const char* b3 = b2 + kstep;
            if (last && has_next) S.a_ready(nxt);
            if constexpr (SP2) {
            PG8_LDB(B0, 0, 0); PG8_LDB(B1, 0, 1); PG8_SCHED; PG8_LDA(At, 0, 0); PG8_STAGE(PG8_SA(1, 1), a1 + hstep, voffA);
            PG8_WAIT_V(8); PG8_WAIT_L(0); PG8_BAR; PG8_MMA(0, 0, At, B0); PG8_MMA(0, 1, At, B1); PG8_BAR; PG8_SCHED;
            PG8_LDA(At, 0, 1); PG8_STAGE(PG8_SB(0, 0), b2, voffB); PG8_STAGE(PG8_SB(0, 1), b2 + hstep, voffB); PG8_STAGE(PG8_SA(0, 0), a2, voffA);
            PG8_WAIT_V(8); PG8_WAIT_L(0); PG8_BAR; PG8_MMA(1, 0, At, B0); PG8_MMA(1, 1, At, B1); PG8_BAR; PG8_SCHED;
            PG8_LDB(B0, 1, 0); PG8_LDB(B1, 1, 1); PG8_SCHED; PG8_LDA(At, 1, 0); PG8_STAGE(PG8_SA(0, 1), a2 + hstep, voffA);
            PG8_WAIT_V(8); PG8_WAIT_L(0); PG8_BAR; PG8_MMA(0, 0, At, B0); PG8_MMA(0, 1, At, B1); PG8_BAR; PG8_SCHED;
            PG8_LDA(At, 1, 1); PG8_STAGE(PG8_SB(1, 0), b3, voffB); PG8_STAGE(PG8_SB(1, 1), b3 + hstep, voffB); PG8_STAGE(PG8_SA(1, 0), a3, voffA);
            PG8_WAIT_V(8); PG8_WAIT_L(0); PG8_BAR; PG8_MMA(1, 0, At, B0); PG8_MMA(1, 1, At, B1); PG8_BAR; PG8_SCHED;
            } else {
            PG8_LDB(B0, 0, 0); PG8_SCHED; PG8_LDA(At, 0, 0); PG8_STAGE(PG8_SA(1, 1), a1 + hstep, voffA);
            PG8_WAIT_L(8); PG8_BAR; PG8_WAIT_L(0); PG8_MMA(0, 0, At, B0); PG8_BAR; PG8_SCHED;
            PG8_LDB(B1, 0, 1); PG8_STAGE(PG8_SB(0, 0), b2, voffB);
            PG8_BAR; PG8_WAIT_L(0); PG8_MMA(0, 1, At, B1); PG8_BAR;
            PG8_LDA(At, 0, 1); PG8_STAGE(PG8_SA(0, 0), a2, voffA);
            PG8_BAR; PG8_WAIT_L(0); PG8_MMA(1, 0, At, B0); PG8_BAR; PG8_SCHED;
            PG8_STAGE(PG8_SB(0, 1), b2 + hstep, voffB);
            PG8_WAIT_V(6); PG8_BAR; PG8_MMA(1, 1, At, B1); PG8_BAR;
            PG8_LDB(B0, 1, 0); PG8_SCHED; PG8_LDA(At, 1, 0); PG8_STAGE(PG8_SA(0, 1), a2 + hstep, voffA);
            PG8_WAIT_L(8); PG8_BAR; PG8_WAIT_L(0); PG8_MMA(0, 0, At, B0); PG8_BAR; PG8_SCHED;
            PG8_LDB(B1, 1, 1); PG8_STAGE(PG8_SB(1, 0), b3, voffB);
            PG8_BAR; PG8_WAIT_L(0); PG8_MMA(0, 1, At, B1); PG8_BAR;
            PG8_LDA(At, 1, 1); PG8_STAGE(PG8_SA(1, 0), a3, voffA);
            PG8_BAR; PG8_WAIT_L(0); PG8_MMA(1, 0, At, B0); PG8_BAR; PG8_SCHED;
            PG8_STAGE(PG8_SB(1, 1), b3 + hstep, voffB);
            PG8_WAIT_V(6); PG8_BAR; PG8_MMA(1, 1, At, B1); PG8_BAR;
            }
        }
        if constexpr (ALIGN_EPI) { if (wr == 0) PG8_BAR; }
        if constexpr (!Epi::AFTER_DRAIN) { E(acc, cur, wr, wc, fr, fq); S.done(cur); }
        if (!has_next) break;
#pragma unroll
        for (int a = 0; a < 2; ++a)
#pragma unroll
            for (int b = 0; b < 2; ++b)
#pragma unroll
                for (int m = 0; m < 4; ++m)
#pragma unroll
                    for (int n = 0; n < 2; ++n) acc[a][b][m][n] = (f32x4){0.f, 0.f, 0.f, 0.f};
        cur = nxt; cA = nA; cB = nB; ++ui;
        if constexpr (ALIGN_EPI) { if (wr == 1) PG8_BAR; }
    }
    PG8_WAIT_V(0);
    if constexpr (!ALIGN_EPI) { if (wr == 0) PG8_BAR; }
    PG8_BAR;
    if constexpr (Epi::AFTER_DRAIN) { E.fused(acc, cur, wr, wc, fr, fq, lds, wid, lane); S.done(cur); }
#undef PG8_SA
#undef PG8_SB
#undef PG8_STAGE
#undef PG8_LDA
#undef PG8_LDB
#undef PG8_MMA
#undef PG8_WAIT_V
#undef PG8_WAIT_L
#undef PG8_BAR
#undef PG8_SCHED
}
}

namespace pg8 {
struct EpiStore {
    static constexpr bool PERM = true, AFTER_DRAIN = false;
    bf16_t* O; int ldc; int hm; float* n2p;
    __device__ __forceinline__ void operator()(const f32x4 (&acc)[2][2][4][2], const Unit& u, int wr, int wc, int fr, int fq) const {
        const int row0 = u.pm * BM + wr * 64 + fr, col0 = u.pn * BM + wc * 32 + 8 * fq;
        size_t base[2]; size_t rstride;
        if (hm) { const int b = row0 >> 12, s = row0 & 4095;
#pragma unroll
            for (int bj = 0; bj < 2; ++bj) { const int c = col0 + bj * HALF, t = c >> 11, h = (c >> 7) & 15, d = c & 127; base[bj] = ((size_t)((t * 4 + b) * 16 + h) * 4096 + s) * 128 + d; }
            rstride = 128;
            if (u.pn < 16) {
#pragma unroll
                for (int bj = 0; bj < 2; ++bj) { const int c = col0 + bj * HALF, t = c >> 11, h = (c >> 7) & 15;
                    float* np = n2p + ((size_t)((t * 4 + b) * 16 + h) * 4096 + s) * 4 + wc;
#pragma unroll
                    for (int ai = 0; ai < 2; ++ai)
#pragma unroll
                        for (int m = 0; m < 4; ++m) { const f32x4 v0 = acc[ai][bj][m][0], v1 = acc[ai][bj][m][1];
                            float q = (v0[0] * v0[0] + v0[1] * v0[1]) + (v0[2] * v0[2] + v0[3] * v0[3]) + (v1[0] * v1[0] + v1[1] * v1[1]) + (v1[2] * v1[2] + v1[3] * v1[3]);
                            q += __shfl_xor(q, 16); q += __shfl_xor(q, 32);
                            if (fq == 0) np[(size_t)(ai * HALF + m * 16) * 4] = q; } } }
        }
        else { base[0] = (size_t)row0 * ldc + col0; base[1] = base[0] + HALF; rstride = (size_t)ldc; }
#pragma unroll
        for (int ai = 0; ai < 2; ++ai)
#pragma unroll
            for (int m = 0; m < 4; ++m) {
#pragma unroll
                for (int bj = 0; bj < 2; ++bj) { const f32x4 v0 = acc[ai][bj][m][0], v1 = acc[ai][bj][m][1];
                    u32x4 w; w.x = cvt_pk_bf16(v0[0], v0[1]); w.y = cvt_pk_bf16(v0[2], v0[3]); w.z = cvt_pk_bf16(v1[0], v1[1]); w.w = cvt_pk_bf16(v1[2], v1[3]);
                    *(u32x4*)(O + base[bj] + (size_t)(ai * HALF + m * 16) * rstride) = w; } }
    }
};
struct EpiResid {
    static constexpr bool PERM = false, AFTER_DRAIN = false;
    const float* Xs; float* Xd; const float* gate; int gstride; const float* stats;
    __device__ __forceinline__ void operator()(const f32x4 (&acc)[2][2][4][2], const Unit& u, int wr, int wc, int fr, int fq) const {
        const int row0 = u.pm * BM + wr * 64 + fr, col0 = u.pn * BM + wc * 32 + 4 * fq;
        const float* g = gate + (size_t)((u.pm * BM) >> 12) * gstride + col0;
        f32x4 gv[2][2], av[2][2], bv[2][2];
#pragma unroll
        for (int bj = 0; bj < 2; ++bj)
#pragma unroll
            for (int n = 0; n < 2; ++n) { gv[bj][n] = *(const f32x4*)(g + bj * HALF + n * 16); av[bj][n] = *(const f32x4*)(stats + 2 * 16384 + col0 + bj * HALF + n * 16); bv[bj][n] = *(const f32x4*)(stats + 2 * 16384 + 2048 + col0 + bj * HALF + n * 16); }
#pragma unroll
        for (int ai = 0; ai < 2; ++ai)
#pragma unroll
            for (int mp = 0; mp < 2; ++mp) {
                f32x4 xv[2][2][2]; f32x2 st[2];
#pragma unroll
                for (int mm = 0; mm < 2; ++mm) { const size_t row = (size_t)(row0 + ai * HALF + (2 * mp + mm) * 16); st[mm] = *(const f32x2*)(stats + row * 2); const float* rowp = Xs + row * 2048 + col0;
#pragma unroll
                    for (int bj = 0; bj < 2; ++bj)
#pragma unroll
                        for (int n = 0; n < 2; ++n) xv[mm][bj][n] = *(const f32x4*)(rowp + bj * HALF + n * 16); }
#pragma unroll
                for (int mm = 0; mm < 2; ++mm) { float* rowp = Xd + (size_t)(row0 + ai * HALF + (2 * mp + mm) * 16) * 2048 + col0; const float mean = st[mm][0], rstd = st[mm][1];
#pragma unroll
                    for (int bj = 0; bj < 2; ++bj)
#pragma unroll
                        for (int n = 0; n < 2; ++n) *(f32x4*)(rowp + bj * HALF + n * 16) = (xv[mm][bj][n] - mean) * rstd * av[bj][n] + bv[bj][n] + gv[bj][n] * acc[ai][bj][2 * mp + mm][n]; } }
    }
};
template <int CTRL> __device__ __forceinline__ float dppf(float v) { return __builtin_bit_cast(float, __builtin_amdgcn_update_dpp(0, __builtin_bit_cast(int, v), CTRL, 0xf, 0xf, true)); }
typedef unsigned u32x2v __attribute__((ext_vector_type(2)));
struct EpiFfn {
    static constexpr bool PERM = true, AFTER_DRAIN = false;
    bf16_t* ACT; float* ZH; const float* cw; const float* cb;
    __device__ __forceinline__ void operator()(const f32x4 (&acc)[2][2][4][2], const Unit& u, int wr, int wc, int fr, int fq) const {
#pragma unroll
        for (int n = 0; n < 2; ++n) {
            const int ch0 = u.pn * 128 + wc * 32 + 8 * fq + 4 * n;
            f32x4 wa[3], wu[3];
#pragma unroll
            for (int k = 0; k < 3; ++k) { wa[k] = *(const f32x4*)(cw + k * 11264 + ch0); wu[k] = *(const f32x4*)(cw + k * 11264 + 5632 + ch0); }
            const f32x4 ba = *(const f32x4*)(cb + ch0), bu = *(const f32x4*)(cb + 5632 + ch0);
#pragma unroll
            for (int ai = 0; ai < 2; ++ai) { const int blk = u.pm * 4 + ai * 2 + wr;
                if (fr < 2) { float* zp = ZH + ((size_t)(blk * 4 + 2 + fr) * 2) * 5632 + ch0; *(f32x4*)zp = acc[ai][0][0][n]; *(f32x4*)(zp + 5632) = acc[ai][1][0][n]; }
                if (fr >= 14) { float* zp = ZH + ((size_t)((blk + 1) * 4 + fr - 14) * 2) * 5632 + ch0; *(f32x4*)zp = acc[ai][0][3][n]; *(f32x4*)(zp + 5632) = acc[ai][1][3][n]; }
#pragma unroll
                for (int m = 0; m < 4; ++m) { float o[4];
#pragma unroll
                    for (int e = 0; e < 4; ++e) {
                        const float va = acc[ai][0][m][n][e], vu = acc[ai][1][m][n][e], pa = m ? acc[ai][0][m ? m - 1 : 0][n][e] : 0.f, pu = m ? acc[ai][1][m ? m - 1 : 0][n][e] : 0.f;
                        const float a1 = dppf<0x111>(va) + dppf<0x10F>(pa), a2 = dppf<0x112>(va) + dppf<0x10E>(pa);
                        const float u1 = dppf<0x111>(vu) + dppf<0x10F>(pu), u2 = dppf<0x112>(vu) + dppf<0x10E>(pu);
                        const float ya = ba[e] + wa[0][e] * a2 + wa[1][e] * a1 + wa[2][e] * va;
                        const float yu = bu[e] + wu[0][e] * u2 + wu[1][e] * u1 + wu[2][e] * vu;
                        o[e] = ya * __builtin_amdgcn_rcpf(1.f + __expf(-ya)) * yu; }
                    if (m > 0 || fr >= 2) { u32x2v w; w.x = cvt_pk_bf16(o[0], o[1]); w.y = cvt_pk_bf16(o[2], o[3]); *(u32x2v*)(ACT + (size_t)(blk * 64 + m * 16 + fr) * 5632 + ch0) = w; }
                    __builtin_amdgcn_sched_barrier(0); } } }
    }
};
}
namespace fx {
using bf16 = __hip_bfloat16;
constexpr int D = 128, RS = 128  , OS = 2048  ;
constexpr float THR = 24.f;     constexpr bool WSKIP = false; constexpr float T_DEAD = 32.f;
constexpr float SCALE = 0.08838834764831845f;
constexpr int NW = 8, QBLK = 32, KVBLK = 64, QB = NW * QBLK;
constexpr int SHM_V = KVBLK * D * 2, SHM_K = KVBLK * D * 2;
constexpr int BIAS_OFF = 2 * SHM_V + 2 * SHM_K + NW * 64 * 4;
constexpr int GATE_OFF = BIAS_OFF + 4096 * 4;
constexpr int LDS_BYTES = GATE_OFF + 8 * 8192;
typedef short bf16x8 __attribute__((ext_vector_type(8)));
typedef short s16x4 __attribute__((ext_vector_type(4)));
typedef float f32x16 __attribute__((ext_vector_type(16)));
typedef float f32x4 __attribute__((ext_vector_type(4)));
typedef unsigned u32x4 __attribute__((ext_vector_type(4)));
template <class A, class Bt> struct same_t { static constexpr bool v = false; };
template <class A> struct same_t<A, A> { static constexpr bool v = true; };
#define KSWZ(row, colB) ((row) * 256 + ((colB) ^ (((row) & 7) << 4)))
#define SBAR() __builtin_amdgcn_sched_barrier(0)
__device__ __forceinline__ int v_st(int k, int c) { const int kk = (k & ~0xC) | ((k & 4) << 1) | ((k & 8) >> 1); return ((kk >> 3) * 4 + (c >> 5)) * 512 + ((kk & 7) * 32 + (c & 31)) * 2; }
__device__ __forceinline__ int v_rd_base(int lane) { return ((lane & 3) << 3) | (((lane >> 2) & 3) << 6) | (((lane >> 4) & 1) << 5) | (((lane >> 5) & 1) << 8); }
constexpr int v_rd_off(int d0, int ks, int half) { return d0 * 512 + ks * 4096 + half * 2048; }
__device__ __forceinline__ int crow(int r, int hi) { return (r & 3) + 8 * (r >> 2) + 4 * hi; }
__device__ __forceinline__ unsigned cvtpk(float lo, float hi) {
    unsigned r; asm volatile("v_cvt_pk_bf16_f32 %0, %1, %2" : "=v"(r) : "v"(lo), "v"(hi)); return r;
}
__device__ __forceinline__ bf16x8 pack8(f32x4 a, f32x4 b) {
    u32x4 w = {cvtpk(a[0], a[1]), cvtpk(a[2], a[3]), cvtpk(b[0], b[1]), cvtpk(b[2], b[3])};
    return *reinterpret_cast<bf16x8*>(&w);
}
template <class T> __device__ __forceinline__ bf16x8 load8(const T* p) {
    if constexpr (same_t<T, float>::v) { return pack8(*(const f32x4*)p, *(const f32x4*)(p + 4)); }
    else { return *reinterpret_cast<const bf16x8*>(p); }
}
__device__ __forceinline__ void mask_tile(f32x16& p0, f32x16& p1, int dq, unsigned W) {
    const float NEG = -__builtin_inff();
#pragma unroll
    for (int r = 0; r < 16; ++r) {
        const int c = (r & 3) + 8 * (r >> 2);
        if ((unsigned)(dq - c) >= W) p0[r] = NEG;
        if ((unsigned)(dq - c - 32) >= W) p1[r] = NEG;
    }
}
__device__ __forceinline__ void partialSM(f32x16& p0, f32x16& p1, float& m_reg, float& mn, float& alpha, bool& dead) {
    float pmax = p0[0]; for (int r = 1; r < 16; ++r) pmax = fmaxf(pmax, p0[r]); for (int r = 0; r < 16; ++r) pmax = fmaxf(pmax, p1[r]);
    { auto rr = __builtin_amdgcn_permlane32_swap(__float_as_uint(pmax), __float_as_uint(pmax), false, false);
      pmax = fmaxf(__uint_as_float(rr[0]), __uint_as_float(rr[1])); }
    constexpr float C2 = 1.4426950408889634f * SCALE;
    dead = __all((pmax - m_reg) * SCALE < -T_DEAD);
    if (dead) { mn = m_reg; alpha = 1.f; return; }
    if (__builtin_expect(__all((pmax - m_reg) * SCALE <= THR), 1)) { mn = m_reg; alpha = 1.f; }
    else { mn = fmaxf(m_reg, pmax); alpha = __builtin_amdgcn_exp2f((m_reg - mn) * C2); m_reg = mn; }
    const float mnL = -mn * C2;
    for (int r = 0; r < 16; ++r) p0[r] = fmaf(p0[r], C2, mnL); for (int r = 0; r < 16; ++r) p1[r] = fmaf(p1[r], C2, mnL);
    for (int r = 0; r < 16; ++r) p0[r] = __builtin_amdgcn_exp2f(p0[r]);
}
__device__ __forceinline__ void finishSM(f32x16& p0, f32x16& p1, float alpha, float& l_reg, bf16x8& pa0, bf16x8& pa1, bf16x8& pa2, bf16x8& pa3) {
    for (int r = 0; r < 16; ++r) p1[r] = __builtin_amdgcn_exp2f(p1[r]);
    float ps = 0; for (int r = 0; r < 16; ++r) ps += p0[r]; for (int r = 0; r < 16; ++r) ps += p1[r];
    { auto rr = __builtin_amdgcn_permlane32_swap(__float_as_uint(ps), __float_as_uint(ps), false, false);
      ps = __uint_as_float(rr[0]) + __uint_as_float(rr[1]); }
    l_reg = l_reg * alpha + ps;
#define PK4(P, B_, OUT) do { unsigned a0 = cvtpk(P[B_+0], P[B_+1]), a1 = cvtpk(P[B_+2], P[B_+3]);                          \
        unsigned b0 = cvtpk(P[B_+4], P[B_+5]), b1 = cvtpk(P[B_+6], P[B_+7]);                                             \
        auto r0 = __builtin_amdgcn_permlane32_swap(a0, b0, false, false); auto r1 = __builtin_amdgcn_permlane32_swap(a1, b1, false, false); \
        u32x4 w = {r0[0], r1[0], r0[1], r1[1]}; OUT = *reinterpret_cast<bf16x8*>(&w); } while (0)
    PK4(p0, 0, pa0); PK4(p0, 8, pa1); PK4(p1, 0, pa2); PK4(p1, 8, pa3);
#undef PK4
}
template <int KB, bool SK>
__device__ __forceinline__ void qkt(f32x16& p0, f32x16& p1, const char* K_lds, int r32, int hi, const bf16x8* qr, bool act, const float* bl) {
    if (SK && !act) { const float NEG = -__builtin_inff();
#pragma unroll
        for (int r = 0; r < 16; ++r) { p0[r] = NEG; p1[r] = NEG; } return; }
#pragma unroll
    for (int g_ = 0; g_ < 4; ++g_) { const f32x4 t0 = *(const f32x4*)(bl + 8 * g_), t1 = *(const f32x4*)(bl + 32 + 8 * g_);
#pragma unroll
        for (int e_ = 0; e_ < 4; ++e_) { p0[4 * g_ + e_] = t0[e_]; p1[4 * g_ + e_] = t1[e_]; } }
    const char* kb[4];
#pragma unroll
    for (int dd = 0; dd < 4; ++dd) kb[dd] = K_lds + KB * SHM_K + KSWZ(r32, (dd * 16 + hi * 8) * 2);
#pragma unroll
    for (int d0 = 0; d0 < 8; ++d0) { const char* a = kb[d0 & 3] + (d0 >> 2) * 128;
        bf16x8 b0 = *reinterpret_cast<const bf16x8*>(a);
        bf16x8 b1 = *reinterpret_cast<const bf16x8*>(a + 32 * 256);
        p0 = __builtin_amdgcn_mfma_f32_32x32x16_bf16(b0, qr[d0], p0, 0, 0, 0);
        p1 = __builtin_amdgcn_mfma_f32_32x32x16_bf16(b1, qr[d0], p1, 0, 0, 0); }
}
template <int VB, bool SK>
__device__ __forceinline__ void pv_tile(f32x16* o, int vb0, bf16x8 pa0, bf16x8 pa1, bf16x8 pa2, bf16x8 pa3, bool act) {
    if (SK && !act) return;
#define TRRD(dst, off) asm volatile("ds_read_b64_tr_b16 %0, %1 offset:%2" : "=&v"(dst) : "v"(vb0), "i"(off) : "memory")
#define PV_D0(d0) do { s16x4 l0, l1, l2, l3, h0, h1, h2, h3; constexpr int b_ = VB * SHM_V + v_rd_off(d0, 0, 0);     \
        TRRD(l0, b_); TRRD(h0, b_ + 2048); TRRD(l1, b_ + 4096); TRRD(h1, b_ + 6144); TRRD(l2, b_ + 8192); TRRD(h2, b_ + 10240); TRRD(l3, b_ + 12288); TRRD(h3, b_ + 14336); \
        asm volatile("s_waitcnt lgkmcnt(0)" ::: "memory"); SBAR();                 \
        o[d0] = __builtin_amdgcn_mfma_f32_32x32x16_bf16(pa0, (bf16x8){l0[0], l0[1], l0[2], l0[3], h0[0], h0[1], h0[2], h0[3]}, o[d0], 0, 0, 0);   \
        o[d0] = __builtin_amdgcn_mfma_f32_32x32x16_bf16(pa1, (bf16x8){l1[0], l1[1], l1[2], l1[3], h1[0], h1[1], h1[2], h1[3]}, o[d0], 0, 0, 0);   \
        o[d0] = __builtin_amdgcn_mfma_f32_32x32x16_bf16(pa2, (bf16x8){l2[0], l2[1], l2[2], l2[3], h2[0], h2[1], h2[2], h2[3]}, o[d0], 0, 0, 0);   \
        o[d0] = __builtin_amdgcn_mfma_f32_32x32x16_bf16(pa3, (bf16x8){l3[0], l3[1], l3[2], l3[3], h3[0], h3[1], h3[2], h3[3]}, o[d0], 0, 0, 0); } while (0)
    PV_D0(0); PV_D0(1); PV_D0(2); PV_D0(3);
#undef PV_D0
#undef TRRD
}

template <class TIn, class TOut> struct BlockRef { const TIn* Q; const TIn* K; const TIn* V; TOut* O; const float* Bias; const TIn* G; int P0; int JLO; };
#define FX_LASU __attribute__((address_space(3))) unsigned
#define BIAS_DMA(ref) do { _Pragma("unroll") for (int i_ = 0; i_ < 2; ++i_) __builtin_amdgcn_global_load_lds((const unsigned*)((ref).Bias + (size_t)(i_ * 512 + tid) * 4), (FX_LASU*)(lds + BIAS_OFF + i_ * 8192 + wid * 1024), 16, 0, 0); } while (0)
template <class TIn> struct Seam {
    bf16x8 qr[8];
    bf16x8 st_v0, st_v1, st_k0, st_k1; f32x4 sf0, sf1, sf2, sf3;
    f32x4 tq[16];
};
__device__ __forceinline__ int swa_jlo(int P0, int W) { const int lowk = P0 - W + 1; return lowk > 0 ? lowk / KVBLK : 0; }
#define ROW(p, k0, rr) ((p) + (size_t)((k0) + (rr)) * RS + sc)
#define VMW() asm volatile("s_waitcnt vmcnt(0)" ::: "memory")
#define VMWN(n) asm volatile("s_waitcnt vmcnt(%0)" :: "i"(n) : "memory")
#define SLOAD_H(Kp, Vp, k0) do { S.st_v0 = load8<TIn>(ROW(Vp, k0, sr)); S.st_v1 = load8<TIn>(ROW(Vp, k0, 32 + sr));              \
                         S.st_k0 = load8<TIn>(ROW(Kp, k0, sr)); S.st_k1 = load8<TIn>(ROW(Kp, k0, 32 + sr)); } while (0)
#define SWRITE_HK(bf) do { *(bf16x8*)(K_lds + (bf) * SHM_K + kws) = S.st_k0; *(bf16x8*)(K_lds + (bf) * SHM_K + kws + 32 * 256) = S.st_k1; } while (0)
#define SWRITE_HV(bf) do { *(bf16x8*)(V_lds + (bf) * SHM_V + vst0) = S.st_v0; *(bf16x8*)(V_lds + (bf) * SHM_V + vst1) = S.st_v1; } while (0)
#define SWRITE_H(bf) do { SWRITE_HV(bf); SWRITE_HK(bf); } while (0)
#define SLOAD_F(p, k0) do { S.sf0 = *(const f32x4*)ROW(p, k0, sr); S.sf1 = *(const f32x4*)(ROW(p, k0, sr) + 4);                \
                            S.sf2 = *(const f32x4*)ROW(p, k0, 32 + sr); S.sf3 = *(const f32x4*)(ROW(p, k0, 32 + sr) + 4); } while (0)
#define SWRITE_KF(bf) do { *(bf16x8*)(K_lds + (bf) * SHM_K + kws) = pack8(S.sf0, S.sf1); *(bf16x8*)(K_lds + (bf) * SHM_K + kws + 32 * 256) = pack8(S.sf2, S.sf3); } while (0)
#define SWRITE_VF(bf) do { *(bf16x8*)(V_lds + (bf) * SHM_V + vst0) = pack8(S.sf0, S.sf1); *(bf16x8*)(V_lds + (bf) * SHM_V + vst1) = pack8(S.sf2, S.sf3); } while (0)
template <class TIn, class TOut>
__device__ __forceinline__ void causal_swa_prime(const BlockRef<TIn, TOut>& cur, int W, char* lds, Seam<TIn>& S, int tid_in) {
    constexpr bool F32 = same_t<TIn, float>::v;
    int tid_l_ = tid_in; asm volatile("" : "+v"(tid_l_));
    const int tid = tid_l_, wid = __builtin_amdgcn_readfirstlane(tid >> 6), lane = tid & 63, r32 = lane & 31, hi = lane >> 5;
    const int sr = tid >> 4, sc = (tid & 15) * 8, kws = KSWZ(sr, sc * 2); char* K_lds = lds + 2 * SHM_V;
    const int kb0 = ((cur.P0 + QB - 1) / KVBLK) * KVBLK;
    for (int d0 = 0; d0 < 8; ++d0) S.qr[d0] = load8<TIn>(cur.Q + (size_t)(wid * QBLK + r32) * RS + d0 * 16 + hi * 8);
    BIAS_DMA(cur);
    if constexpr (F32) { SLOAD_F((const float*)cur.K, kb0); VMW(); SWRITE_KF(0); SBAR(); SLOAD_F((const float*)cur.V, kb0); }
    else { SLOAD_H(cur.K, cur.V, kb0); VMW(); SWRITE_HK(0); }
    __syncthreads();
}
template <class TIn, class TOut>
__device__ __forceinline__ void causal_swa_block(const BlockRef<TIn, TOut>& cur, const BlockRef<TIn, TOut>& nxt, int skv, int W, char* lds, Seam<TIn>& S, int tid_in) {
    constexpr bool F32 = same_t<TIn, float>::v;
    int tid_l_ = tid_in; asm volatile("" : "+v"(tid_l_));
    const int tid = tid_l_, wid = __builtin_amdgcn_readfirstlane(tid >> 6), lane = tid & 63, r32 = lane & 31, hi = lane >> 5;
    const int j_lo = cur.JLO;
    int j_hi = (cur.P0 + QB - 1) / KVBLK + 1; if (j_hi > skv / KVBLK) j_hi = skv / KVBLK;
    const int NT = j_hi - j_lo;
    const int kbn = ((nxt.P0 + QB - 1) / KVBLK) * KVBLK;
    const int qlo = cur.P0 + wid * QBLK, qm = qlo + r32 - 4 * hi;
    char* V_lds = lds; char* K_lds = lds + 2 * SHM_V; const float* bias_l = (const float*)(lds + BIAS_OFF) + 4 * hi;
    float* ws = (float*)(lds + 2 * SHM_V + 2 * SHM_K) + wid * 64; float* li_l = ws, * al_l = ws + 32;
    float m_reg = -1e30f, l_reg = 0; f32x16 o[4] = {};
    const int sr = tid >> 4, sc = (tid & 15) * 8, vst0 = v_st(sr, sc), vst1 = v_st(32 + sr, sc), kws = KSWZ(sr, sc * 2);
    const int vb0 = (int)(uintptr_t)V_lds + v_rd_base(lane);
    const TIn* Kh = cur.K; const TIn* Vh = cur.V;
#define RESC(a) do { if (__any((a) < 1.f)) { if (hi == 0) al_l[r32] = (a); asm volatile("s_waitcnt lgkmcnt(0)" ::: "memory");              \
                     for (int d_ = 0; d_ < 4; ++d_) for (int r = 0; r < 16; ++r) o[d_][r] *= al_l[crow(r, hi)]; } } while (0)
#define KBASE(t) ((j_hi - 1 - (t)) * KVBLK)
#define ACT(t) (KBASE(t) <= qlo + QBLK - 1 && KBASE(t) + KVBLK - 1 >= qlo - W + 1)
#define MASKT(P0_, P1_, t) do { const int kb_ = KBASE(t); if ((!SK || ACT(t)) && (kb_ + KVBLK - 1 > qlo || kb_ <= qlo + QBLK - 1 - W)) mask_tile(P0_, P1_, qm - kb_, (unsigned)W); } while (0)
    constexpr int NQL = F32 ? 16 : 8;
    constexpr bool SK = WSKIP && !F32;
#define SEAM_K0() do { VMWN(NQL); if constexpr (F32) { SWRITE_KF(0); SBAR(); SLOAD_F((const float*)nxt.V, kbn); } else { SWRITE_HK(0); } SBAR(); } while (0)
    f32x16 pA0, pA1, pB0, pB1; float mnA, mnB, alA, alB; bf16x8 pa0, pa1, pa2, pa3;
    if constexpr (F32) { VMW(); SWRITE_VF(0); SBAR(); } else { SWRITE_HV(0); SBAR(); }
    if (NT > 1) { if constexpr (F32) SLOAD_F((const float*)Kh, KBASE(1)); else SLOAD_H(Kh, Vh, KBASE(1)); }
    SBAR(); qkt<0, SK>(pA0, pA1, K_lds, r32, hi, S.qr, ACT(0), bias_l + KBASE(0));
    if constexpr (F32) { if (NT > 1) { VMW(); SWRITE_KF(1); SBAR(); SLOAD_F((const float*)Vh, KBASE(1)); } }
    bool dA = false, dB = false;
    MASKT(pA0, pA1, 0); partialSM(pA0, pA1, m_reg, mnA, alA, dA);
    if (NT > 1) { VMW(); if constexpr (F32) { SWRITE_VF(1); SBAR(); if (NT > 2) SLOAD_F((const float*)Kh, KBASE(2)); } else SWRITE_H(1); }
    __syncthreads();
#define HALF_STEP(PX0, PX1, mnX, alX, dX, PY0, PY1, alY, dY, t, KB, VB, SB) do {                                                      \
        SBAR(); qkt<KB, SK>(PX0, PX1, K_lds, r32, hi, S.qr, ACT(t), bias_l + KBASE(t));                                             \
        if (!(dY)) finishSM(PY0, PY1, alY, l_reg, pa0, pa1, pa2, pa3); SBAR();                                                \
        if ((t) + 1 < NT) { if constexpr (F32) { VMW(); SWRITE_KF(SB); SBAR(); SLOAD_F((const float*)Vh, KBASE((t) + 1)); }  \
                            else { SLOAD_H(Kh, Vh, KBASE((t) + 1)); } SBAR(); }                                               \
        if (!(dY)) pv_tile<VB, SK>(o, vb0, pa0, pa1, pa2, pa3, ACT((t) - 1)); MASKT(PX0, PX1, (t)); partialSM(PX0, PX1, m_reg, mnX, alX, dX);                                        \
        __syncthreads();                                                                                                      \
        if ((t) + 1 < NT) { VMW(); if constexpr (F32) { SWRITE_VF(SB); SBAR(); if ((t) + 2 < NT) SLOAD_F((const float*)Kh, KBASE((t) + 2)); } \
                            else { SWRITE_H(SB); } }                                                                          \
        RESC(alX); __syncthreads(); } while (0)
    for (int t = 1; t + 1 < NT; t += 2) {
        HALF_STEP(pB0, pB1, mnB, alB, dB, pA0, pA1, alA, dA, t, 1, 0, 0);
        HALF_STEP(pA0, pA1, mnA, alA, dA, pB0, pB1, alB, dB, t + 1, 0, 1, 1);
    }
    const bool even = (NT & 1) == 0;
    if (even) { SBAR(); qkt<1, SK>(pB0, pB1, K_lds, r32, hi, S.qr, ACT(NT - 1), bias_l + KBASE(NT - 1)); SBAR(); } else { BIAS_DMA(nxt); }
    { const char* gsrc_ = (const char*)(cur.G + (size_t)(wid * QBLK + (lane >> 4)) * RS + (lane & 15) * 8);
      _Pragma("unroll") for (int i_ = 0; i_ < 8; ++i_) __builtin_amdgcn_global_load_lds((const unsigned*)(gsrc_ + (size_t)i_ * 4 * RS * 2), (FX_LASU*)(lds + GATE_OFF + wid * 8192 + i_ * 1024), 16, 0, 0); }
#define QROW(e) (nxt.Q + (size_t)(wid * QBLK + r32) * RS + ((e) >> 1) * 16 + hi * 8 + ((e) & 1) * 4)
    if constexpr (F32) { SLOAD_F((const float*)nxt.K, kbn); SBAR();
#pragma unroll
        for (int e = 0; e < 8; ++e) S.tq[e] = *(const f32x4*)QROW(e); }
    else { SLOAD_H(nxt.K, nxt.V, kbn); SBAR();
#pragma unroll
        for (int d0 = 0; d0 < 8; ++d0) S.qr[d0] = load8<TIn>(nxt.Q + (size_t)(wid * QBLK + r32) * RS + d0 * 16 + hi * 8); }
    SBAR();
    if (!dA) finishSM(pA0, pA1, alA, l_reg, pa0, pa1, pa2, pa3); SBAR();
    if constexpr (F32) {
#pragma unroll
        for (int e = 8; e < 16; ++e) S.tq[e] = *(const f32x4*)QROW(e); SBAR(); }
#undef QROW
    if (!dA) pv_tile<0, SK>(o, vb0, pa0, pa1, pa2, pa3, ACT(even ? NT - 2 : NT - 1));
    if (even) { MASKT(pB0, pB1, NT - 1); partialSM(pB0, pB1, m_reg, mnB, alB, dB); __syncthreads(); BIAS_DMA(nxt); RESC(alB);
        if (!dB) { finishSM(pB0, pB1, alB, l_reg, pa0, pa1, pa2, pa3); SBAR(); pv_tile<1, SK>(o, vb0, pa0, pa1, pa2, pa3, ACT(NT - 1)); } }
    SBAR(); SEAM_K0();
    if (hi == 0) li_l[r32] = l_reg; asm volatile("s_waitcnt lgkmcnt(0)" ::: "memory");
    float rli[16];
#pragma unroll
    for (int r = 0; r < 16; ++r) rli[r] = __builtin_amdgcn_rcpf(li_l[crow(r, hi)]);
    TOut* Owl = cur.O + (size_t)(wid * QBLK + 4 * hi) * OS + r32; const char* gll = lds + GATE_OFF + wid * 8192 + hi * 1024 + r32 * 2;
#pragma unroll
    for (int r = 0; r < 16; ++r) { constexpr int dummy_ = 0; const int rc = (r & 3) + 8 * (r >> 2);
#pragma unroll
        for (int d0 = 0; d0 < 4; ++d0) { const float v = o[d0][r] * rli[r];
            const float vn = __shfl_xor(v, 1);
            if ((r32 & 1) == 0) { const unsigned gg = *(const unsigned*)(gll + rc * 256 + d0 * 64);
                const float g0 = __uint_as_float(gg << 16), g1 = __uint_as_float(gg & 0xffff0000u);
                const float s0 = __builtin_amdgcn_rcpf(1.f + __expf(-g0)), s1 = __builtin_amdgcn_rcpf(1.f + __expf(-g1));
                *(unsigned*)(Owl + (size_t)rc * OS + d0 * 32) = cvtpk(v * s0, vn * s1); } }
        SBAR(); }
    asm volatile("s_waitcnt vmcnt(0)" ::: "memory");
    if constexpr (F32) {
#pragma unroll
        for (int d0 = 0; d0 < 8; ++d0) S.qr[d0] = pack8(S.tq[2 * d0], S.tq[2 * d0 + 1]); }
    __syncthreads();
#undef RESC
#undef KBASE
#undef ACT
#undef MASKT
#undef SEAM_K0
#undef HALF_STEP
}
#undef ROW
#undef VMW
#undef VMWN
#undef SLOAD_H
#undef SWRITE_HK
#undef SWRITE_HV
#undef SWRITE_H
#undef SLOAD_F
#undef SWRITE_KF
#undef SWRITE_VF

}

typedef unsigned short bf16_t;
typedef float f32x4 __attribute__((ext_vector_type(4)));
typedef float f32x16 __attribute__((ext_vector_type(16)));
typedef float f32x2 __attribute__((ext_vector_type(2)));
typedef short bf16x8 __attribute__((ext_vector_type(8)));
typedef short bf16x4 __attribute__((ext_vector_type(4)));
typedef unsigned u32x4 __attribute__((ext_vector_type(4)));
typedef unsigned u32x2 __attribute__((ext_vector_type(2)));
constexpr int DM = 2048, NBATCH = 4, SEQ = 4096, MTOK = NBATCH * SEQ, DFF = 5632;
constexpr float LN_EPS = 1e-5f, RMS_EPS = 1e-5f, DN_ALPHA = 1.6817928305074290f;
constexpr size_t MiB = 1u << 20;
constexpr size_t WS_CTL = 0, CTL_ZERO_BYTES = 1 * MiB;
constexpr size_t WS_MOD = 1 * MiB;
constexpr size_t WS_SK16 = 2 * MiB;
constexpr size_t WS_FB = 3 * MiB;
constexpr size_t WS_ELAST = 4 * MiB;
constexpr size_t WS_ST = 5 * MiB;
constexpr size_t WS_ID = 5 * MiB + 512 * 1024;
constexpr size_t WS_WFOX = 8 * MiB;
constexpr size_t WS_WGLA = 88 * MiB;
constexpr size_t WS_WCONV = 120 * MiB;
constexpr size_t WS_WUP = 152 * MiB;
constexpr size_t WS_WDOWN = 328 * MiB;
constexpr size_t WS_H = 416 * MiB;
constexpr size_t WS_PROJ = 480 * MiB;
constexpr size_t WS_ACT = 832 * MiB;
constexpr size_t WS_QD = 1008 * MiB, WS_KI = 1040 * MiB, WS_KDT = 1072 * MiB, WS_VT = 1104 * MiB;
constexpr size_t WS_OINT = 1168 * MiB;
constexpr size_t WS_QDF = 1296 * MiB;
constexpr size_t WS_N2P = 1328 * MiB;
constexpr size_t WS_END = 1336 * MiB;
constexpr int LDS_TOTAL = 163840, MISC_OFF = LDS_TOTAL - 64;
constexpr int CW_BAR = 4096;

__device__ __forceinline__ float bf2f(unsigned short b) { return __uint_as_float(((unsigned)b) << 16); }
__device__ __forceinline__ unsigned pk2(float lo, float hi) { return pg8::cvt_pk_bf16(lo, hi); }
__device__ __forceinline__ unsigned short f2bf(float f) { return (unsigned short)(pk2(f, 0.f) & 0xffffu); }
template <int CTRL> __device__ __forceinline__ float dpp_rot(float v) { return __builtin_bit_cast(float, __builtin_amdgcn_update_dpp(0, __builtin_bit_cast(int, v), CTRL, 0xf, 0xf, false)); }
__device__ __forceinline__ float wave_sum(float v) {
    v += dpp_rot<0x128>(v); v += dpp_rot<0x124>(v); v += dpp_rot<0x122>(v); v += dpp_rot<0x121>(v);
    v += __shfl_xor(v, 16); v += __shfl_xor(v, 32);
    return v;
}
__device__ __forceinline__ float log_sigmoid(float x) { return fminf(x, 0.f) - __logf(1.f + __expf(-fabsf(x))); }
__device__ __forceinline__ float silu_f(float x) { return x * __builtin_amdgcn_rcpf(1.f + __expf(-x)); }
__device__ __forceinline__ int crow(int r, int hi) { return (r & 3) + 8 * (r >> 2) + 4 * hi; }
__device__ __forceinline__ void cvt8(const u32x4 w, float (&f)[8]) {
    f[0] = __uint_as_float(w.x << 16); f[1] = __uint_as_float(w.x & 0xffff0000u); f[2] = __uint_as_float(w.y << 16); f[3] = __uint_as_float(w.y & 0xffff0000u);
    f[4] = __uint_as_float(w.z << 16); f[5] = __uint_as_float(w.z & 0xffff0000u); f[6] = __uint_as_float(w.w << 16); f[7] = __uint_as_float(w.w & 0xffff0000u);
}
__device__ __forceinline__ u32x4 pack8f(const float (&f)[8]) { u32x4 w; w.x = pk2(f[0], f[1]); w.y = pk2(f[2], f[3]); w.z = pk2(f[4], f[5]); w.w = pk2(f[6], f[7]); return w; }

#define XB_TMO      128
#define XB_XCNT(j)  (256  + 64 * (j))
#define XB_XSUB(j)  (1280 + 64 * (j))
#define XB_XGEN(j)  (2304 + 64 * (j))
#define XB_TOP      3328
#define XB_TOPGEN   3392
#define XCD_BAR_WORDS 3456
#define XB_SPIN_CAP (1u << 18)
#define LAS __attribute__((address_space(3)))

__device__ __forceinline__ unsigned xb_ld(unsigned* p)              { return __hip_atomic_load(p, __ATOMIC_RELAXED, __HIP_MEMORY_SCOPE_AGENT); }
__device__ __forceinline__ unsigned xb_add(unsigned* p, unsigned v) { return __hip_atomic_fetch_add(p, v, __ATOMIC_RELAXED, __HIP_MEMORY_SCOPE_AGENT); }
__device__ __forceinline__ unsigned xb_xcc_id() { return (unsigned)__builtin_amdgcn_s_getreg((3 << 11) | 20) & 0xFu; }
#define XB_SPIN(cond, bar) do { unsigned _sp = 0; while (cond) { __builtin_amdgcn_s_sleep(1); \
    if ((++_sp & 255u) == 0u) { if (xb_ld(&(bar)[XB_TMO])) break; if (_sp > XB_SPIN_CAP) { atomicAdd(&(bar)[XB_TMO], 1u); break; } } } } while (0)

struct XcdBarrier {
    unsigned* bar; unsigned x;
    volatile LAS unsigned* st;
};

__device__ __forceinline__ XcdBarrier xcd_barrier_post(unsigned* bar, volatile LAS unsigned* st, int xb_tid) {
    XcdBarrier b; b.bar = bar; b.x = xb_xcc_id(); b.st = st;
    if (xb_tid == 0) (void)xb_add(&bar[XB_XCNT(b.x)], 1u);
    return b;
}
__device__ __forceinline__ void xcd_barrier_complete(unsigned* bar, unsigned x, unsigned& nloc, unsigned& nx) {
    const unsigned G = gridDim.x * gridDim.y * gridDim.z;
    unsigned sum, cnt, mine, sp = 0u;
    for (;;) {
        sum = 0u; cnt = 0u; mine = 0u;
#pragma unroll
        for (unsigned j = 0; j < 16; ++j) { const unsigned c = xb_ld(&bar[XB_XCNT(j)]); sum += c; cnt += (c > 0u) ? 1u : 0u; mine = (j == x) ? c : mine; }
        if (sum == G) break;
        __builtin_amdgcn_s_sleep(1);
        if ((++sp & 255u) == 0u) { if (xb_ld(&bar[XB_TMO])) break; if (sp > XB_SPIN_CAP) { atomicAdd(&bar[XB_TMO], 1u); break; } }
    }
    nloc = mine > 0u ? mine : 1u; nx = cnt > 0u ? cnt : 1u;
}

__device__ __forceinline__ void xcd_barrier(const XcdBarrier& b, int xb_tid) {
    asm volatile("s_waitcnt vmcnt(0)" ::: "memory");
    __syncthreads();
    if (xb_tid == 0) {
        unsigned* bar = b.bar;
        __builtin_amdgcn_s_waitcnt(0);
        unsigned nloc = b.st[0], nx = b.st[1];
        if (nloc == 0u) { xcd_barrier_complete(bar, b.x, nloc, nx); b.st[0] = nloc; b.st[1] = nx; }
        const unsigned old = xb_add(&bar[XB_XSUB(b.x)], 1u);
        const unsigned gen = old / nloc;
        if (old + 1u == (gen + 1u) * nloc) {
            __builtin_amdgcn_fence(__ATOMIC_RELEASE, "agent");
            asm volatile("s_waitcnt vmcnt(0)" ::: "memory");
            const unsigned og = xb_add(&bar[XB_TOP], 1u);
            const unsigned tg = og / nx;
            if (og + 1u == (tg + 1u) * nx) xb_add(&bar[XB_TOPGEN], 1u);
            else XB_SPIN(xb_ld(&bar[XB_TOPGEN]) == tg, bar);
            __builtin_amdgcn_fence(__ATOMIC_ACQUIRE, "agent");
            xb_add(&bar[XB_XGEN(b.x)], 1u);
            asm volatile("s_waitcnt vmcnt(0)" ::: "memory");
        } else {
            XB_SPIN(xb_ld(&bar[XB_XGEN(b.x)]) == gen, bar);
            __builtin_amdgcn_fence(__ATOMIC_ACQUIRE, "agent");
            asm volatile("s_waitcnt vmcnt(0)" ::: "memory");
        }
    }
    __syncthreads();
}


#define MK_GRID_VARS int BID = blockIdx.x, NBLK = gridDim.x; asm volatile("" : "+s"(BID), "+s"(NBLK))
struct Args { const float* in[31]; float* out; unsigned char* ws; int ph_lo, ph_hi, flags, pad; };

__device__ __forceinline__ void p0_transpose_item(const float* W, int K, int N, bf16_t* WT, int row_off, LAS float* scr, int item, int lane) {
    const int nblk = N / 32, kb = item / nblk, nb = item % nblk, k0 = 64 * kb, n0 = 32 * nb;
    int rbase = row_off + n0; if (row_off < 0) { const int half = n0 >= DFF ? 1 : 0, ch = n0 - half * DFF; rbase = 256 * (ch >> 7) + 128 * half + (ch & 127); }
#pragma unroll 8
    for (int i = 0; i < 32; ++i) { const int kk = 2 * i + (lane >> 5); scr[kk * 33 + (lane & 31)] = __builtin_nontemporal_load(W + (size_t)(k0 + kk) * N + n0 + (lane & 31)); }
    asm volatile("s_waitcnt lgkmcnt(0)" ::: "memory");
    const int c = lane & 7;
#pragma unroll
    for (int j = 0; j < 4; ++j) { const int n = (lane >> 3) + 8 * j; const LAS float* s = scr + (8 * c) * 33 + n;
        u32x4 o; o.x = pk2(s[0 * 33], s[1 * 33]); o.y = pk2(s[2 * 33], s[3 * 33]); o.z = pk2(s[4 * 33], s[5 * 33]); o.w = pk2(s[6 * 33], s[7 * 33]);
        *(u32x4*)(WT + (size_t)(rbase + n) * K + k0 + 8 * c) = o; }
    asm volatile("s_waitcnt lgkmcnt(0)" ::: "memory");
}
typedef const __attribute__((address_space(4))) Args CArgs;
__device__ __forceinline__ void phase_prologue(CArgs* ap, unsigned char* lds, int tid, int wid, int lane) {
    MK_GRID_VARS;
    unsigned char* ws = ap->ws;
    for (int t = BID; t < 192; t += NBLK) {
        float* cond = (float*)lds;
        for (int i = tid; i < 4 * DM; i += 512) { const float c = ap->in[1][i]; cond[i] = c / (1.f + __expf(-c)); }
        __syncthreads();
        const int l = t / 48, col0 = (t % 48) * 256;
        const float* wp = ap->in[2] + ((size_t)l * DM + wid * 256) * 12288 + col0 + 4 * lane;
        f32x4 acc[4] = {{0.f, 0.f, 0.f, 0.f}, {0.f, 0.f, 0.f, 0.f}, {0.f, 0.f, 0.f, 0.f}, {0.f, 0.f, 0.f, 0.f}};
#pragma unroll 8
        for (int k = 0; k < 256; ++k) { const f32x4 wv = __builtin_nontemporal_load((const f32x4*)(wp + (size_t)k * 12288)); const int kk = wid * 256 + k;
#pragma unroll
            for (int b = 0; b < 4; ++b) acc[b] += cond[b * DM + kk] * wv; }
        float* red = (float*)(lds + 32768);
#pragma unroll
        for (int b = 0; b < 4; ++b) *(f32x4*)(red + ((wid * 4 + b) * 256 + 4 * lane)) = acc[b];
        __syncthreads();
        float* mod = (float*)(ws + WS_MOD);
        for (int idx = tid; idx < 1024; idx += 512) { const int b = idx >> 8, col = idx & 255; float s = ap->in[3][l * 12288 + col0 + col];
#pragma unroll
            for (int w = 0; w < 8; ++w) s += red[(w * 4 + b) * 256 + col];
            mod[(size_t)(l * 4 + b) * 12288 + col0 + col] = s; }
        __syncthreads();
    }
    LAS float* scr = (LAS float*)((LAS unsigned char*)lds + wid * 16384);
    const int gw = BID * 8 + wid, NGW = NBLK * 8;
    bf16_t* wfox0 = (bf16_t*)(ws + WS_WFOX); bf16_t* wfox1 = (bf16_t*)(ws + WS_WFOX + 40 * MiB);
    bf16_t* wgla = (bf16_t*)(ws + WS_WGLA); bf16_t* wconv = (bf16_t*)(ws + WS_WCONV);
    bf16_t* wup = (bf16_t*)(ws + WS_WUP); bf16_t* wdn = (bf16_t*)(ws + WS_WDOWN);
    constexpr int I_DD = (DM / 64) * (DM / 32), I_DH = (DM / 64) * (1024 / 32), I_D3 = (DM / 64) * (6144 / 32), I_UP = (DM / 64) * (11264 / 32), I_DN = (DFF / 64) * (DM / 32);
    constexpr int NITEMS = 10 * I_DD + 2 * I_DH + 3 * I_DD + I_D3 + I_DD + 4 * I_UP + 4 * I_DN;
    constexpr size_t DD = (size_t)DM * DM;
#define TJOB(SRC, KK, NN, DST, ROFF, CNT) { if (r < (CNT)) { p0_transpose_item((SRC), (KK), (NN), (DST), (ROFF), scr, r, lane); continue; } r -= (CNT); }
    for (int it = gw; it < NITEMS; it += NGW) {
        int r = it;
        TJOB(ap->in[8], DM, DM, wfox0, 0, I_DD) TJOB(ap->in[9], DM, DM, wfox0, 2048, I_DD) TJOB(ap->in[10], DM, DM, wfox0, 4096, I_DD) TJOB(ap->in[11], DM, DM, wfox0, 6144, I_DD)
        TJOB(ap->in[14], DM, DM, wfox0 + (size_t)8192 * DM, 0, I_DD)
        TJOB(ap->in[8] + DD, DM, DM, wfox1, 0, I_DD) TJOB(ap->in[9] + DD, DM, DM, wfox1, 2048, I_DD) TJOB(ap->in[10] + DD, DM, DM, wfox1, 4096, I_DD) TJOB(ap->in[11] + DD, DM, DM, wfox1, 6144, I_DD)
        TJOB(ap->in[14] + DD, DM, DM, wfox1 + (size_t)8192 * DM, 0, I_DD)
        TJOB(ap->in[15], DM, 1024, wgla, 0, I_DH) TJOB(ap->in[16], DM, 1024, wgla, 1024, I_DH) TJOB(ap->in[17], DM, DM, wgla, 2048, I_DD) TJOB(ap->in[21], DM, DM, wgla, 4096, I_DD)
        TJOB(ap->in[23], DM, DM, wgla + (size_t)6144 * DM, 0, I_DD)
        TJOB(ap->in[24], DM, 6144, wconv, 0, I_D3) TJOB(ap->in[26], DM, DM, wconv + (size_t)6144 * DM, 0, I_DD)
        TJOB(ap->in[27], DM, 11264, wup, -1, I_UP) TJOB(ap->in[27] + (size_t)1 * DM * 11264, DM, 11264, wup + (size_t)1 * 11264 * DM, -1, I_UP)
        TJOB(ap->in[27] + (size_t)2 * DM * 11264, DM, 11264, wup + (size_t)2 * 11264 * DM, -1, I_UP) TJOB(ap->in[27] + (size_t)3 * DM * 11264, DM, 11264, wup + (size_t)3 * 11264 * DM, -1, I_UP)
        TJOB(ap->in[30], DFF, DM, wdn, 0, I_DN) TJOB(ap->in[30] + (size_t)1 * DFF * DM, DFF, DM, wdn + (size_t)1 * DM * DFF, 0, I_DN)
        TJOB(ap->in[30] + (size_t)2 * DFF * DM, DFF, DM, wdn + (size_t)2 * DM * DFF, 0, I_DN) TJOB(ap->in[30] + (size_t)3 * DFF * DM, DFF, DM, wdn + (size_t)3 * DM * DFF, 0, I_DN)
    }
#undef TJOB
}

__device__ __forceinline__ void phase_lnmod(const float* src, float* X, bf16_t* H, bool do_ln, bool do_mod, const float* lng, const float* lnb,
                                            const float* sc, const float* sh, int sk_mode, const float* skW, const float* skB, float* sk_out, float* stats,
                                            unsigned char* lds, int tid, int wid, int lane) {
    MK_GRID_VARS;
    if (sk_mode) {
        f32x4* Wl = (f32x4*)lds;
        for (int idx = tid; idx < 8192; idx += 512) { const int ln = idx & 63, q = (idx >> 6) & 3, i = (idx >> 8) & 3, j = idx >> 10;
            Wl[idx] = *(const f32x4*)(skW + (size_t)(256 * j + 4 * ln + i) * 16 + 4 * q); }
        __syncthreads();
    }
    if (stats && BID == 0) for (int i = tid; i < DM; i += 512) { stats[2 * MTOK + i] = DN_ALPHA * (do_ln ? lng[i] : 1.f); stats[2 * MTOK + DM + i] = DN_ALPHA * (do_ln ? lnb[i] : 0.f); }
    const int nw = NBLK * 8, gw = BID * 8 + wid, R = (MTOK + nw - 1) / nw, row_begin = gw * R, row_end = (row_begin + R < MTOK) ? row_begin + R : MTOK;
    if (row_begin < row_end) {
        f32x4 g4[8], b4[8], s1[8], s0[8], vn[8];
        if (do_ln) {
#pragma unroll
            for (int j = 0; j < 8; ++j) { g4[j] = ((const f32x4*)lng)[64 * j + lane]; b4[j] = ((const f32x4*)lnb)[64 * j + lane]; } }
        int cur_b = -1;
        { const f32x4* xr = (const f32x4*)(src + (size_t)row_begin * DM) + lane;
#pragma unroll
          for (int j = 0; j < 8; ++j) vn[j] = __builtin_nontemporal_load(xr + 64 * j); }
        for (int row = row_begin; row < row_end; ++row) {
            f32x4 v[8]; float s = 0.f;
#pragma unroll
            for (int j = 0; j < 8; ++j) { v[j] = vn[j]; s += (v[j][0] + v[j][1]) + (v[j][2] + v[j][3]); }
            if (row + 1 < row_end) { const f32x4* xr = (const f32x4*)(src + (size_t)(row + 1) * DM) + lane;
#pragma unroll
                for (int j = 0; j < 8; ++j) vn[j] = __builtin_nontemporal_load(xr + 64 * j); }
            if (do_mod && (row >> 12) != cur_b) { cur_b = row >> 12;
                const f32x4* sc4 = (const f32x4*)(sc + (size_t)cur_b * 12288) + lane; const f32x4* sh4 = (const f32x4*)(sh + (size_t)cur_b * 12288) + lane;
#pragma unroll
                for (int j = 0; j < 8; ++j) { s1[j] = 1.f + sc4[64 * j]; s0[j] = sh4[64 * j]; } }
            float mean = 0.f, rstd = 1.f;
            if (do_ln) {
                mean = wave_sum(s) * (1.f / DM); float s2 = 0.f;
#pragma unroll
                for (int j = 0; j < 8; ++j) { v[j] = v[j] - mean; s2 += (v[j][0] * v[j][0] + v[j][1] * v[j][1]) + (v[j][2] * v[j][2] + v[j][3] * v[j][3]); }
                rstd = 1.f / sqrtf(wave_sum(s2) * (1.f / DM) + LN_EPS);
#pragma unroll
                for (int j = 0; j < 8; ++j) v[j] = v[j] * rstd * g4[j] + b4[j];
            }
            if (stats) { if (lane == 0) { f32x2 st; st[0] = mean; st[1] = rstd; *(f32x2*)(stats + (size_t)row * 2) = st; } }
            else { f32x4* xo = (f32x4*)(X + (size_t)row * DM) + lane;
#pragma unroll
                for (int j = 0; j < 8; ++j) xo[64 * j] = v[j]; }
            if (do_mod) {
                u32x2* ho = (u32x2*)(H + (size_t)row * DM) + lane;
#pragma unroll
                for (int j = 0; j < 8; ++j) { v[j] = v[j] * s1[j] + s0[j]; u32x2 w; w.x = pk2(v[j][0], v[j][1]); w.y = pk2(v[j][2], v[j][3]); ho[64 * j] = w; }
                if (sk_mode) {
                    const f32x4* Wl = (const f32x4*)lds + lane;
                    float acc[16];
#pragma unroll
                    for (int n = 0; n < 16; ++n) acc[n] = 0.f;
#pragma unroll
                    for (int j = 0; j < 8; ++j)
#pragma unroll
                        for (int i = 0; i < 4; ++i) { const float hv = v[j][i];
#pragma unroll
                            for (int q = 0; q < 4; ++q) { const f32x4 w = Wl[((j * 4 + i) * 4 + q) * 64];
                                acc[4 * q + 0] += hv * w[0]; acc[4 * q + 1] += hv * w[1]; acc[4 * q + 2] += hv * w[2]; acc[4 * q + 3] += hv * w[3]; }
                            if (i == 3) __builtin_amdgcn_sched_barrier(0); }
                    float mine = 0.f;
#pragma unroll
                    for (int n = 0; n < 16; ++n) { const float t = wave_sum(acc[n]); mine = (lane == n) ? t : mine; }
                    if (lane < 16) { if (sk_mode == 1) mine = log_sigmoid(mine + skB[lane]); sk_out[(size_t)row * 16 + lane] = mine; }
                }
            }
        }
    }
}

__device__ __forceinline__ void fox_cumsum(const float* logf  , float* FB  , int wid, int lane) {
    MK_GRID_VARS;
    for (int u = BID * 8 + wid; u < 64; u += NBLK * 8) {
        const int b = u >> 4, hh = u & 15;
        const float* lf = logf + ((size_t)b * SEQ + lane * 64) * 16 + hh;
        float v[64]; float s = 0.f;
#pragma unroll
        for (int t = 0; t < 64; ++t) v[t] = lf[t * 16];
#pragma unroll
        for (int t = 0; t < 64; ++t) { s += v[t]; v[t] = s; }
        float pre = s;
#pragma unroll
        for (int o = 1; o < 64; o <<= 1) { const float t = __shfl_up(pre, o); if (lane >= o) pre += t; }
        const float excl = pre - s;
        float* out = FB + (size_t)u * SEQ + lane * 64;
#pragma unroll
        for (int t = 0; t < 64; t += 4) { f32x4 o4; o4[0] = -(excl + v[t]) * 11.313708499f; o4[1] = -(excl + v[t + 1]) * 11.313708499f; o4[2] = -(excl + v[t + 2]) * 11.313708499f; o4[3] = -(excl + v[t + 3]) * 11.313708499f;
            *(f32x4*)(out + t) = o4; }
    }
}

constexpr float T_SKIP = 32.f;
__device__ __forceinline__ void phase_fox_attn(const bf16_t* PROJ, const float* FB, const float* N2P, bf16_t* O, char* lds, int tid) {
    MK_GRID_VARS;
    using namespace fx;
    typedef BlockRef<bf16, bf16> Ref;
    const int total = 512, stride = NBLK, lane = tid & 63, wid = __builtin_amdgcn_readfirstlane(tid >> 6);
    float* kmx = (float*)(lds + 2 * SHM_V + 2 * SHM_K);
    float* qmx = kmx + 64;
    int* jlo_l = (int*)(lds + LDS_BYTES);
    {   int idx = 0;
        for (int Lx = BID; Lx < total; Lx += stride, ++idx) {
            const int xcd = Lx & 7, k = Lx >> 3, gi = k >> 3, r = (gi & 4) ? 7 - (k & 7) : (k & 7), bh = (gi * 8 + xcd) ^ ((gi & 4) ? 8 : 0);
            const f32x4* kn = (const f32x4*)(N2P + ((size_t)(64 + bh) * SEQ) * 4);
            const f32x4* qn = (const f32x4*)(N2P + ((size_t)bh * SEQ) * 4);
            float km = 0.f;
#pragma unroll
            for (int e = 0; e < 8; ++e) { const f32x4 v = kn[tid * 8 + e]; km = fmaxf(km, (v[0] + v[1]) + (v[2] + v[3])); }
            km = fmaxf(km, __shfl_xor(km, 1)); km = fmaxf(km, __shfl_xor(km, 2)); km = fmaxf(km, __shfl_xor(km, 4));
            if ((tid & 7) == 0) kmx[tid >> 3] = km;
            for (int pass = 0; pass < 2; ++pass) {
                const int qb = pass ? 15 - r : r, P0 = qb * QB;
                __syncthreads();
                float qm = 0.f;
                if (tid < 256) { const f32x4 v = qn[P0 + tid]; qm = (v[0] + v[1]) + (v[2] + v[3]); }
#pragma unroll
                for (int o = 1; o < 64; o <<= 1) qm = fmaxf(qm, __shfl_xor(qm, o));
                if (lane == 0) qmx[wid] = qm;
                __syncthreads();
                if (wid == 0) {
                    const float Q = sqrtf(fmaxf(fmaxf(qmx[0], qmx[1]), fmaxf(qmx[2], qmx[3])));
                    const int jd = P0 / KVBLK;
                    const float Kd = sqrtf(fmaxf(fmaxf(kmx[jd], kmx[jd + 1]), fmaxf(kmx[jd + 2], kmx[jd + 3])));
                    const float* fb = FB + (size_t)bh * SEQ;
                    const float bound = 1.02f * Q * (sqrtf(kmx[lane]) + Kd) + (fb[lane * KVBLK + KVBLK - 1] - fb[P0]);
                    const bool keep = lane < jd && !(bound < -T_SKIP / SCALE);
                    const unsigned long long mask = __ballot(keep);
                    const int jlo = mask ? (int)__builtin_ctzll(mask) : jd;
                    if (lane == 0) jlo_l[idx * 2 + pass] = jlo;
                }
            }
            __syncthreads();
        }
    }
    int L = BID;
    if (L < total) {
        auto mkref = [&](int Lx, int pass, int slot) -> Ref {
            const int xcd = Lx & 7, k = Lx >> 3, gi = k >> 3, r = (gi & 4) ? 7 - (k & 7) : (k & 7), bh = (gi * 8 + xcd) ^ ((gi & 4) ? 8 : 0), qb = pass ? 15 - r : r;
            const int b = bh >> 4, h = bh & 15; const size_t row0 = (size_t)b * SEQ + (size_t)qb * QB;
            Ref rf; const bf16* P = (const bf16*)PROJ; const size_t TS = (size_t)64 * SEQ * D, hb = (size_t)bh * SEQ * D;
            rf.Q = P + hb + (size_t)qb * QB * D; rf.K = P + TS + hb; rf.V = P + 2 * TS + hb; rf.G = P + 3 * TS + hb + (size_t)qb * QB * D;
            rf.O = (bf16*)O + row0 * OS + h * D; rf.Bias = FB + (size_t)bh * SEQ; rf.P0 = qb * QB; rf.JLO = __builtin_amdgcn_readfirstlane(jlo_l[slot * 2 + pass]); return rf; };
        int pass = 0, slot = 0; Ref cur = mkref(L, 0, 0);
        Seam<bf16> S;
        causal_swa_prime<bf16, bf16>(cur, SEQ, lds, S, tid);
        for (;;) {
            const bool more_pass = pass == 0, more_item = L + stride < total, last = !more_pass && !more_item;
            int passn = pass + 1, Ln = L, slotn = slot;
            if (!more_pass) { passn = 0; Ln = more_item ? L + stride : L; slotn = more_item ? slot + 1 : slot; }
            const Ref nxt = last ? cur : mkref(Ln, passn, slotn);
            causal_swa_block<bf16, bf16>(cur, nxt, SEQ, SEQ, lds, S, tid);
            if (last) break;
            cur = nxt; pass = passn; L = Ln; slot = slotn;
        }
    }
}

__device__ __forceinline__ void phase_gla_prep(const bf16_t* PROJ, const float* A1, const float* wa2, const float* ba, bf16_t* QD, bf16_t* QDF, bf16_t* KI, bf16_t* KDT, bf16_t* VT, float* ELAST,
                                               unsigned char* lds, int tid) {
    MK_GRID_VARS;
    float* a1l = (float*)lds;
    for (int u = BID; u < 512; u += NBLK) {
        const int b = u >> 7, n = (u >> 1) & 63, p = u & 1; const size_t row0 = (size_t)b * SEQ + n * 64;
        __syncthreads();
        for (int i = tid; i < 1024; i += 512) a1l[i] = A1[row0 * 16 + i];
        __syncthreads();
        { const int hh = 2 * p + (tid >> 8), d = tid & 255, col = hh * 256 + d, bh = b * 4 + hh;
          float w2[16];
#pragma unroll
          for (int r = 0; r < 16; ++r) w2[r] = wa2[r * 1024 + col];
          const float bav = ba[col];
          const bf16_t* qp = PROJ + row0 * 6144 + col; const bf16_t* kp = qp + 1024;
          bf16_t* qdp = QD + row0 * 1024 + col; bf16_t* kip = KI + row0 * 1024 + col;
          bf16_t* qfp; { const int dkl = d & 31, x = dkl & 15; qfp = QDF + ((((((size_t)bh * 64 + n) * 8 + (d >> 5)) * 2) * 2 + (dkl >> 4)) * 64 + ((x >> 2) & 1) * 32) * 8 + 4 * (x >> 3) + (x & 3); }
          float kif[64]; float cb = 0.f;
#pragma unroll
          for (int jj = 0; jj < 64; ++jj) {
              const f32x4* ar = (const f32x4*)(a1l + jj * 16); float ga = bav;
#pragma unroll
              for (int q = 0; q < 4; ++q) { const f32x4 av = ar[q]; ga += av[0] * w2[4 * q] + av[1] * w2[4 * q + 1] + av[2] * w2[4 * q + 2] + av[3] * w2[4 * q + 3]; }
              cb += log_sigmoid(ga) * 0.0625f;
              const float qv = bf2f(qp[(size_t)jj * 6144]) * 0.0625f, kv = bf2f(kp[(size_t)jj * 6144]);
              const float e = __expf(cb), ei = __expf(-cb), kin = kv * ei;
              const unsigned short qb = f2bf(qv * e); qdp[(size_t)jj * 1024] = qb; qfp[((jj >> 5) * 128 + (jj & 31)) * 8] = qb; kip[(size_t)jj * 1024] = f2bf(kin); kif[jj] = kin;
          }
          const float el = __expf(cb);
          ELAST[((size_t)bh * 64 + n) * 256 + d] = el;
          u32x4* kd = (u32x4*)KDT + ((((size_t)bh * 64 + n) * 8 + (d >> 5)) * 4) * 64 + (d & 31);
#pragma unroll
          for (int g = 0; g < 8; ++g) { u32x4 w; w.x = pk2(kif[8 * g] * el, kif[8 * g + 1] * el); w.y = pk2(kif[8 * g + 2] * el, kif[8 * g + 3] * el);
              w.z = pk2(kif[8 * g + 4] * el, kif[8 * g + 5] * el); w.w = pk2(kif[8 * g + 6] * el, kif[8 * g + 7] * el); kd[(g >> 1) * 64 + (g & 1) * 32] = w; } }
        { const int c2 = 2 * tid, hh = 2 * p + (c2 >> 9), dv = c2 & 511, bh = b * 4 + hh;
          const unsigned* vp = (const unsigned*)(PROJ + row0 * 6144 + 2048 + hh * 512 + dv);
          unsigned vv[64];
#pragma unroll
          for (int jj = 0; jj < 64; ++jj) vv[jj] = vp[(size_t)jj * 3072];
          u32x4* vt0 = (u32x4*)VT + ((((size_t)bh * 64 + n) * 16 + (dv >> 5)) * 4) * 64 + (dv & 31); u32x4* vt1 = vt0 + 1;
#pragma unroll
          for (int g = 0; g < 8; ++g) { u32x4 lo, hi;
              lo.x = (vv[8 * g] & 0xffffu) | (vv[8 * g + 1] << 16); lo.y = (vv[8 * g + 2] & 0xffffu) | (vv[8 * g + 3] << 16); lo.z = (vv[8 * g + 4] & 0xffffu) | (vv[8 * g + 5] << 16); lo.w = (vv[8 * g + 6] & 0xffffu) | (vv[8 * g + 7] << 16);
              hi.x = (vv[8 * g] >> 16) | (vv[8 * g + 1] & 0xffff0000u); hi.y = (vv[8 * g + 2] >> 16) | (vv[8 * g + 3] & 0xffff0000u); hi.z = (vv[8 * g + 4] >> 16) | (vv[8 * g + 5] & 0xffff0000u); hi.w = (vv[8 * g + 6] >> 16) | (vv[8 * g + 7] & 0xffff0000u);
              vt0[(g >> 1) * 64 + (g & 1) * 32] = lo; vt1[(g >> 1) * 64 + (g & 1) * 32] = hi; } }
    }
}
struct ScanOps { bf16x8 qa[2][2], ka[4], vb[4]; f32x4 ev[4]; };
__device__ __forceinline__ void scan_load(ScanOps& o, const char* qd_u, const char* kdt_u, const char* vt_u, const char* el_u, unsigned qoff, unsigned koff, unsigned eoff) {
#pragma unroll
    for (int mb = 0; mb < 2; ++mb)
#pragma unroll
        for (int ks = 0; ks < 2; ++ks) o.qa[mb][ks] = *(const bf16x8*)(qd_u + (mb * 2 + ks) * 1024 + qoff);
#pragma unroll
    for (int ks = 0; ks < 4; ++ks) { o.ka[ks] = *(const bf16x8*)(kdt_u + ks * 1024 + koff); o.vb[ks] = *(const bf16x8*)(vt_u + ks * 1024 + koff); }
#pragma unroll
    for (int g = 0; g < 4; ++g) o.ev[g] = *(const f32x4*)(el_u + g * 32 + eoff);
}
__device__ __forceinline__ void phase_gla_scan(const bf16_t* QDF, const bf16_t* KDT, const bf16_t* VT, const float* ELAST, float* OINT, unsigned char* lds, int tid, int wid, int lane) {
    MK_GRID_VARS;
    const int l32 = lane & 31, hi = lane >> 5;
    float* buf = (float*)lds;
    for (int u = BID; u < 256; u += NBLK) {
        const int xcd = u & 7, kk = u >> 3, bh = xcd * 2 + (kk >> 4), s = kk & 15, b = bh >> 2, hh = bh & 3;
        f32x16 S;
#pragma unroll
        for (int r = 0; r < 16; ++r) S[r] = 0.f;
        const char* qd_u0 = (const char*)((const u32x4*)QDF + ((((size_t)bh * 64 * 8 + wid) * 2) * 2) * 64);
        const char* kdt_u0 = (const char*)((const u32x4*)KDT + (((size_t)bh * 64 * 8 + wid) * 4) * 64);
        const char* vt_u0 = (const char*)((const u32x4*)VT + (((size_t)bh * 64 * 16 + s) * 4) * 64);
        const char* el_u0 = (const char*)(ELAST + (size_t)bh * 64 * 256 + 32 * wid);
        const unsigned koff = (unsigned)lane * 16u, qoff = koff, eoff = (unsigned)(4 * hi) * 4u;
#define SCAN_LOAD(c, n_) scan_load((c), qd_u0 + (size_t)(n_) * 8 * 4096, kdt_u0 + (size_t)(n_) * 256 * 64 * 2, vt_u0 + (size_t)(n_) * 512 * 64 * 2, el_u0 + (size_t)(n_) * 256 * 4, qoff, koff, eoff)
#define SCAN_STEP(c, n_) do { bf16x8 sb[2];                                                                                                                   \
            _Pragma("unroll") for (int ks = 0; ks < 2; ++ks) { u32x4 w; w.x = pk2(S[8 * ks], S[8 * ks + 1]); w.y = pk2(S[8 * ks + 2], S[8 * ks + 3]); w.z = pk2(S[8 * ks + 4], S[8 * ks + 5]); w.w = pk2(S[8 * ks + 6], S[8 * ks + 7]); \
                sb[ks] = *reinterpret_cast<bf16x8*>(&w); }                                                                                                     \
            f32x16 op[2];                                                                                                                                      \
            _Pragma("unroll") for (int mb = 0; mb < 2; ++mb) {                                                                                                 \
                _Pragma("unroll") for (int r = 0; r < 16; ++r) op[mb][r] = 0.f;                                                                                \
                _Pragma("unroll") for (int ks = 0; ks < 2; ++ks) op[mb] = __builtin_amdgcn_mfma_f32_32x32x16_bf16((c).qa[mb][ks], sb[ks], op[mb], 0, 0, 0); }  \
            _Pragma("unroll") for (int r = 0; r < 16; ++r) S[r] *= (c).ev[r >> 2][r & 3];                                                                      \
            _Pragma("unroll") for (int ks = 0; ks < 4; ++ks) S = __builtin_amdgcn_mfma_f32_32x32x16_bf16((c).ka[ks], (c).vb[ks], S, 0, 0, 0);                   \
            asm volatile("" : "+v"(S), "+v"(op[0]), "+v"(op[1]));     \
            __builtin_amdgcn_sched_barrier(0); SCAN_LOAD((c), (n_) + 2 < 64 ? (n_) + 2 : 63); __builtin_amdgcn_sched_barrier(0);                                                                 \
            float* pb = buf + ((size_t)((n_) & 1) * 8 + wid) * 2048 + (4 * hi) * 32 + l32;                                                                     \
            _Pragma("unroll") for (int mb = 0; mb < 2; ++mb)                                                                                                   \
                _Pragma("unroll") for (int r = 0; r < 16; ++r) pb[(32 * mb + (r & 3) + 8 * (r >> 2)) * 32] = op[mb][r];                                        \
            asm volatile("s_waitcnt lgkmcnt(0)" ::: "memory"); __builtin_amdgcn_s_barrier(); asm volatile("" ::: "memory");     \
            { const float* rb = buf + (size_t)((n_) & 1) * 8 * 2048 + tid * 4; f32x4 acc = *(const f32x4*)rb;                                                  \
              _Pragma("unroll") for (int w = 1; w < 8; ++w) acc += *(const f32x4*)(rb + w * 2048);                                                             \
              const int tok = tid >> 3, dv = (tid & 7) * 4;                                                                                                    \
              *(f32x4*)(OINT + ((size_t)b * SEQ + (n_) * 64 + tok) * DM + hh * 512 + 32 * s + dv) = acc; } } while (0)
        ScanOps oa, ob; SCAN_LOAD(oa, 0); SCAN_LOAD(ob, 1);
        for (int n = 0; n < 64; n += 2) { SCAN_STEP(oa, n); SCAN_STEP(ob, n + 1); }
#undef SCAN_STEP
#undef SCAN_LOAD
        __syncthreads();
    }
}
#define MK_LASU __attribute__((address_space(3))) unsigned
__device__ __forceinline__ void phase_gla_intra(const bf16_t* PROJ, const bf16_t* QD, const bf16_t* KI, const bf16_t* VT, const float* OINT, const float* normg, bf16_t* OG,
                                                unsigned char* lds, int tid, int wid, int lane) {
    MK_GRID_VARS;
    bf16_t* attl = (bf16_t*)lds;
    float* rss = (float*)(lds + 64 * 72 * 2);
    float* rstdl = rss + 8 * 64;
    constexpr int RG_OFF = 16384;
    const int l16 = lane & 15, q4 = lane >> 4, l32 = lane & 31, hi = lane >> 5;
    for (int u = BID; u < 1024; u += NBLK) {
        const int b = u >> 8, n = (u >> 2) & 63, hh = u & 3, bh = b * 4 + hh; const size_t row0 = (size_t)b * SEQ + n * 64;
        { const char* src = (const char*)(PROJ + (row0 + wid) * 6144 + 4096 + hh * 512 + lane * 8);
#pragma unroll
          for (int i = 0; i < 8; ++i) __builtin_amdgcn_global_load_lds((const unsigned*)(src + (size_t)i * 8 * 6144 * 2), (MK_LASU*)(lds + RG_OFF + (i * 512 + wid * 64) * 16), 16, 0, 0); }
        f32x16 acc[2][2];
        { const float* oil = OINT + (row0 + 4 * hi) * DM + hh * 512 + 64 * wid + l32;
#pragma unroll
          for (int mb = 0; mb < 2; ++mb)
#pragma unroll
              for (int nb = 0; nb < 2; ++nb)
#pragma unroll
                  for (int r = 0; r < 16; ++r) acc[mb][nb][r] = oil[(size_t)(32 * mb + (r & 3) + 8 * (r >> 2)) * DM + 32 * nb]; }
        bf16x8 vb0[4], vb1[4];
        { const bf16x8* vtp = (const bf16x8*)VT + ((((size_t)bh * 64 + n) * 16 + 2 * wid) * 4) * 64 + lane;
#pragma unroll
          for (int ks = 0; ks < 4; ++ks) { vb0[ks] = vtp[ks * 64]; vb1[ks] = vtp[(4 + ks) * 64]; } }
        const int ti = wid >> 1;
#pragma unroll
        for (int t2 = 0; t2 < 2; ++t2) { const int tj = 2 * (wid & 1) + t2;
            f32x4 c = {0.f, 0.f, 0.f, 0.f};
            if (tj <= ti) {
                const bf16_t* ap = QD + (row0 + 16 * ti + l16) * 1024 + hh * 256 + 8 * q4;
                const bf16_t* bp = KI + (row0 + 16 * tj + l16) * 1024 + hh * 256 + 8 * q4;
#pragma unroll
                for (int st = 0; st < 8; ++st) c = __builtin_amdgcn_mfma_f32_16x16x32_bf16(*(const bf16x8*)(ap + 32 * st), *(const bf16x8*)(bp + 32 * st), c, 0, 0, 0);
            }
#pragma unroll
            for (int r = 0; r < 4; ++r) { const int i = 16 * ti + 4 * q4 + r, jx = 16 * tj + l16; attl[i * 72 + jx] = f2bf(jx <= i ? c[r] : 0.f); } }
        __syncthreads();
#pragma unroll
        for (int ks = 0; ks < 4; ++ks) {
            const bf16x8 a0 = *(const bf16x8*)(attl + l32 * 72 + 16 * ks + 8 * hi), a1 = *(const bf16x8*)(attl + (32 + l32) * 72 + 16 * ks + 8 * hi);
            const bf16x8 b0 = vb0[ks], b1 = vb1[ks];
            acc[0][0] = __builtin_amdgcn_mfma_f32_32x32x16_bf16(a0, b0, acc[0][0], 0, 0, 0); acc[0][1] = __builtin_amdgcn_mfma_f32_32x32x16_bf16(a0, b1, acc[0][1], 0, 0, 0);
            acc[1][0] = __builtin_amdgcn_mfma_f32_32x32x16_bf16(a1, b0, acc[1][0], 0, 0, 0); acc[1][1] = __builtin_amdgcn_mfma_f32_32x32x16_bf16(a1, b1, acc[1][1], 0, 0, 0); }
        float* rssl = rss + wid * 64 + 4 * hi;
#pragma unroll
        for (int mb = 0; mb < 2; ++mb)
#pragma unroll
            for (int r = 0; r < 16; ++r) { const float x0 = acc[mb][0][r], x1 = acc[mb][1][r]; float ss = x0 * x0 + x1 * x1;
                ss += __builtin_bit_cast(float, __builtin_amdgcn_update_dpp(0, __builtin_bit_cast(int, ss), 0x128, 0xf, 0xf, false));
                ss += __builtin_bit_cast(float, __builtin_amdgcn_update_dpp(0, __builtin_bit_cast(int, ss), 0x124, 0xf, 0xf, false));
                ss += __builtin_bit_cast(float, __builtin_amdgcn_update_dpp(0, __builtin_bit_cast(int, ss), 0x122, 0xf, 0xf, false));
                ss += __builtin_bit_cast(float, __builtin_amdgcn_update_dpp(0, __builtin_bit_cast(int, ss), 0x121, 0xf, 0xf, false));
                ss += __shfl_xor(ss, 16);
                if (l32 == 0) rssl[32 * mb + (r & 3) + 8 * (r >> 2)] = ss; }
        asm volatile("s_waitcnt vmcnt(0)" ::: "memory");
        __syncthreads();
        if (tid < 64) { float tot = 0.f;
#pragma unroll
            for (int w = 0; w < 8; ++w) tot += rss[w * 64 + tid];
            rstdl[tid] = 1.f / sqrtf(tot * (1.f / 512.f) + RMS_EPS); }
        __syncthreads();
        const float g0 = normg[64 * wid + l32], g1 = normg[64 * wid + 32 + l32];
        const bf16_t* rgl = (const bf16_t*)(lds + RG_OFF) + (4 * hi) * 512 + 64 * wid + l32;
        const float* rsr = rstdl + 4 * hi;
        bf16_t* ogl = OG + (row0 + 4 * hi) * DM + hh * 512 + 64 * wid + l32;
#pragma unroll
        for (int mb = 0; mb < 2; ++mb)
#pragma unroll
            for (int r = 0; r < 16; ++r) { const int rc = 32 * mb + (r & 3) + 8 * (r >> 2);
                const float rstd = rsr[rc];
                const float r0 = bf2f(rgl[rc * 512]), r1 = bf2f(rgl[rc * 512 + 32]);
                ogl[(size_t)rc * DM] = f2bf(acc[mb][0][r] * rstd * g0 * silu_f(r0)); ogl[(size_t)rc * DM + 32] = f2bf(acc[mb][1][r] * rstd * g1 * silu_f(r1)); }
        __syncthreads();
    }
}

__device__ __forceinline__ void phase_conv_core(const bf16_t* PROJ, const float* cw  , bf16_t* OG, int tid) {
    MK_GRID_VARS;
    for (int u = BID; u < MTOK / 64; u += NBLK) {
        const int cg = tid & 255, c0 = 8 * cg, row_start = u * 64 + 32 * (tid >> 8);
        float w[3][8];
#pragma unroll
        for (int k = 0; k < 3; ++k) { const f32x4 a = *(const f32x4*)(cw + k * DM + c0), b = *(const f32x4*)(cw + k * DM + c0 + 4);
#pragma unroll
            for (int e = 0; e < 4; ++e) { w[k][e] = a[e]; w[k][4 + e] = b[e]; } }
        float p2[8], p1[8];
#pragma unroll
        for (int e = 0; e < 8; ++e) { p2[e] = 0.f; p1[e] = 0.f; }
        if ((row_start & (SEQ - 1)) != 0) {
            float c[8], uu[8];
            cvt8(*(const u32x4*)(PROJ + (size_t)(row_start - 2) * 6144 + 2048 + c0), c); cvt8(*(const u32x4*)(PROJ + (size_t)(row_start - 2) * 6144 + 4096 + c0), uu);
#pragma unroll
            for (int e = 0; e < 8; ++e) p2[e] = c[e] * uu[e];
            cvt8(*(const u32x4*)(PROJ + (size_t)(row_start - 1) * 6144 + 2048 + c0), c); cvt8(*(const u32x4*)(PROJ + (size_t)(row_start - 1) * 6144 + 4096 + c0), uu);
#pragma unroll
            for (int e = 0; e < 8; ++e) p1[e] = c[e] * uu[e];
        }
#pragma unroll 4
        for (int r = 0; r < 32; ++r) { const size_t row = (size_t)(row_start + r);
            float gb[8], c[8], uu[8], y[8];
            cvt8(*(const u32x4*)(PROJ + row * 6144 + c0), gb); cvt8(*(const u32x4*)(PROJ + row * 6144 + 2048 + c0), c); cvt8(*(const u32x4*)(PROJ + row * 6144 + 4096 + c0), uu);
#pragma unroll
            for (int e = 0; e < 8; ++e) { const float cu = c[e] * uu[e]; y[e] = gb[e] * (w[0][e] * p2[e] + w[1][e] * p1[e] + w[2][e] * cu); p2[e] = p1[e]; p1[e] = cu; }
            *(u32x4*)(OG + row * DM + c0) = pack8f(y); }
    }
}
__device__ __forceinline__ void phase_ffn_fix(const float* ZH, const float* cw  , const float* cb  , bf16_t* ACT, int tid) {
    MK_GRID_VARS;
    constexpr int NCG = DFF / 8, NIT = (MTOK / 64) * 2 * NCG;
    for (int it = BID * 512 + tid; it < NIT; it += NBLK * 512) {
        const int cg = it % NCG, r = (it / NCG) & 1, blk = it / (2 * NCG), c0 = 8 * cg;
        const bool first = (blk & 63) == 0;
        const float* zb = ZH + (size_t)blk * 4 * 2 * 5632 + c0;
        float y[8];
#pragma unroll
        for (int hq = 0; hq < 2; ++hq) {
            f32x4 za[3], zu[3];
#pragma unroll
            for (int k = 0; k < 3; ++k) { const int s = r + k;
                const bool zero = first && s < 2;
                za[k] = zero ? (f32x4){0.f, 0.f, 0.f, 0.f} : *(const f32x4*)(zb + (size_t)(s * 2) * 5632 + 4 * hq);
                zu[k] = zero ? (f32x4){0.f, 0.f, 0.f, 0.f} : *(const f32x4*)(zb + (size_t)(s * 2 + 1) * 5632 + 4 * hq); }
            f32x4 ya = *(const f32x4*)(cb + c0 + 4 * hq), yu = *(const f32x4*)(cb + DFF + c0 + 4 * hq);
#pragma unroll
            for (int k = 0; k < 3; ++k) { ya += *(const f32x4*)(cw + k * 11264 + c0 + 4 * hq) * za[k]; yu += *(const f32x4*)(cw + k * 11264 + DFF + c0 + 4 * hq) * zu[k]; }
#pragma unroll
            for (int e = 0; e < 4; ++e) y[4 * hq + e] = silu_f(ya[e]) * yu[e]; }
        *(u32x4*)(ACT + (size_t)(blk * 64 + r) * DFF + c0) = pack8f(y);
    }
}

constexpr int PH_FINAL = 65, PH_END = 66;
#ifndef MK_DUP
#define MK_DUP 0
#endif
constexpr size_t WS_XD = WS_END, WS_HD = WS_END + 128 * MiB, WS_SKD = WS_END + 192 * MiB, WS_STD = WS_END + 194 * MiB;
__global__ void __launch_bounds__(512, 2) mk_fwd(Args args_) {
    extern __shared__ __attribute__((aligned(16))) unsigned char lds[];
    const int tid0 = threadIdx.x, wid0 = __builtin_amdgcn_readfirstlane(tid0 >> 6);
    const __attribute__((address_space(4))) Args* argp = (const __attribute__((address_space(4))) Args*)__builtin_amdgcn_kernarg_segment_ptr();
    asm volatile("" : "+s"(argp));
#define args (*argp)
    unsigned char* ws = args.ws;
    const int lo = args.ph_lo, hi = args.ph_hi, dummy = args.flags;
    volatile LAS unsigned* MISC = (volatile LAS unsigned*)((LAS unsigned char*)lds + MISC_OFF);
    if (tid0 < 16) MISC[tid0] = 0u;
    __syncthreads();
    XcdBarrier bar; bar.bar = (unsigned*)(ws + WS_CTL) + CW_BAR; bar.x = 0; bar.st = nullptr;
    if (hi - lo > 1) bar = xcd_barrier_post((unsigned*)(ws + WS_CTL) + CW_BAR, MISC, tid0);
#define IN(k) (lo <= (k) && (k) < hi)
#define SEAM(k) do { if ((k) + 1 < hi) { XcdBarrier b_ = bar; asm volatile("" : "+s"(b_.bar), "+s"(b_.x)); xcd_barrier(b_, tid); } } while (0)
#define LOCALS() unsigned char* w = ws; asm volatile("" : "+s"(w)); int wid_ = wid0; asm volatile("" : "+s"(wid_)); int lane_ = __builtin_amdgcn_mbcnt_hi(~0u, __builtin_amdgcn_mbcnt_lo(~0u, 0u)); asm volatile("" : "+v"(lane_)); const int wid = wid_, lane = lane_, tid = wid * 64 + lane; (void)lane; (void)wid; (void)tid; int BID = blockIdx.x, NBLK = gridDim.x; asm volatile("" : "+s"(BID), "+s"(NBLK)); float* X = args.out; float* MOD = (float*)(w + WS_MOD); float* SK16 = (float*)(w + WS_SK16); float* FB = (float*)(w + WS_FB); float* ELAST = (float*)(w + WS_ELAST); \
    bf16_t* H = (bf16_t*)(w + WS_H); bf16_t* PROJ = (bf16_t*)(w + WS_PROJ); bf16_t* ACT = (bf16_t*)(w + WS_ACT); \
    bf16_t* QD = (bf16_t*)(w + WS_QD); bf16_t* KI = (bf16_t*)(w + WS_KI); bf16_t* KDT = (bf16_t*)(w + WS_KDT); bf16_t* VT = (bf16_t*)(w + WS_VT); float* OINT = (float*)(w + WS_OINT); bf16_t* QDF = (bf16_t*)(w + WS_QDF); (void)QDF; \
    (void)X; (void)MOD; (void)SK16; (void)FB; (void)ELAST; (void)H; (void)PROJ; (void)ACT; (void)QD; (void)KI; (void)KDT; (void)VT; (void)OINT

    if (IN(0)) { LOCALS(); phase_prologue(argp, lds, tid, wid, lane); SEAM(0); }

    for (int sub = 0; sub < 8; ++sub) {
        const int layer = sub >> 1, is_ffn = sub & 1, kind = is_ffn ? 3 : layer % 3, j = layer / 3, base = 1 + 8 * sub;
        if (IN(base + 0)) {
            LOCALS(); const float* modl = MOD + (size_t)layer * 4 * 12288;
            const float* lng = is_ffn ? args.in[4] + layer * DM : args.in[6] + (layer - 1) * DM;
            const float* lnb = is_ffn ? args.in[5] + layer * DM : args.in[7] + (layer - 1) * DM;
            const float* sc = modl + (is_ffn ? 8192 : 2048); const float* sh = modl + (is_ffn ? 6144 : 0);
            const int sk = kind == 0 ? 1 : (kind == 1 ? 2 : 0);
            const float* skW = kind == 0 ? args.in[12] + (size_t)j * DM * 16 : args.in[18]; const float* skB = args.in[13] + j * 16;
            const int rep = dummy; phase_lnmod(sub == 0 ? args.in[0] : X, nullptr, rep ? (bf16_t*)(w + WS_HD) : H, sub != 0, true, lng, lnb, sc, sh, sk, skW, skB, rep ? (float*)(w + WS_SKD) : SK16, (float*)(w + (rep ? WS_STD : WS_ST)), lds, tid, wid, lane);
            SEAM(base + 0);
        }
        if (IN(base + 1)) {
            LOCALS();
            const bf16_t* Bt; int N;
            if (kind == 0) { Bt = (const bf16_t*)(w + WS_WFOX + (size_t)j * 40 * MiB); N = 8192; fox_cumsum(SK16, FB, wid, lane); }
            else if (kind == 1) { Bt = (const bf16_t*)(w + WS_WGLA); N = 6144; }
            else if (kind == 2) { Bt = (const bf16_t*)(w + WS_WCONV); N = 6144; }
            else { Bt = (const bf16_t*)(w + WS_WUP) + (size_t)layer * 11264 * DM; N = 11264; }
            pg8::Gemm g{H, Bt, MTOK, N, DM}; pg8::StaticOrder S; S.init(MTOK, N, NBLK, BID);
            if (kind == 3) { pg8::EpiFfn E{ACT, (float*)PROJ, args.in[28] + (size_t)layer * 3 * 11264, args.in[29] + (size_t)layer * 11264};
                pg8::gemm_phase<pg8::EpiFfn, pg8::StaticOrder, true, true>((LAS unsigned char*)lds, g, S, E, tid); }
            else { pg8::EpiStore E{PROJ, N, kind == 0 ? 1 : 0, (float*)(w + WS_N2P)};
                pg8::gemm_phase<pg8::EpiStore, pg8::StaticOrder, true, true>((LAS unsigned char*)lds, g, S, E, tid); }
            SEAM(base + 1);
        }
        if (kind == 0) {
            if (IN(base + 2)) { LOCALS(); phase_fox_attn(PROJ, FB, (const float*)(w + WS_N2P), ACT, (char*)lds, tid); SEAM(base + 2); }
        } else if (kind == 1) {
            if (IN(base + 2)) { LOCALS(); phase_gla_prep(PROJ, SK16, args.in[19], args.in[20], QD, QDF, KI, KDT, VT, ELAST, lds, tid); SEAM(base + 2); }
            if (IN(base + 3)) { LOCALS(); phase_gla_scan(QDF, KDT, VT, ELAST, OINT, lds, tid, wid, lane); SEAM(base + 3); }
            if (IN(base + 4)) { LOCALS(); phase_gla_intra(PROJ, QD, KI, VT, OINT, args.in[22], ACT, lds, tid, wid, lane); SEAM(base + 4); }
        } else if (kind == 2) {
            if (IN(base + 2)) { LOCALS(); phase_conv_core(PROJ, args.in[25], ACT, tid); SEAM(base + 2); }
        } else {
            if (IN(base + 2)) { LOCALS(); phase_ffn_fix((const float*)PROJ, args.in[28] + (size_t)layer * 3 * 11264, args.in[29] + (size_t)layer * 11264, ACT, tid); SEAM(base + 2); }
        }
        if (IN(base + 5)) {
            LOCALS(); const float* modl = MOD + (size_t)layer * 4 * 12288;
            const bf16_t* Bt; int K;
            if (kind == 0) { Bt = (const bf16_t*)(w + WS_WFOX + (size_t)j * 40 * MiB) + (size_t)8192 * DM; K = DM; }
            else if (kind == 1) { Bt = (const bf16_t*)(w + WS_WGLA) + (size_t)6144 * DM; K = DM; }
            else if (kind == 2) { Bt = (const bf16_t*)(w + WS_WCONV) + (size_t)6144 * DM; K = DM; }
            else { Bt = (const bf16_t*)(w + WS_WDOWN) + (size_t)layer * DM * DFF; K = DFF; }
            pg8::Gemm g{ACT, Bt, MTOK, DM, K}; pg8::StaticOrder S; S.init(MTOK, DM, NBLK, BID);
            { pg8::EpiResid E{sub == 0 ? args.in[0] : X, dummy ? (float*)(w + WS_XD) : X, modl + (is_ffn ? 10240 : 4096), 12288, (const float*)(w + WS_ST)};
                pg8::gemm_phase<pg8::EpiResid, pg8::StaticOrder, true, true>((LAS unsigned char*)lds, g, S, E, tid); }
            SEAM(base + 5);
        }
    }
    if (IN(PH_FINAL)) { LOCALS(); phase_lnmod(X, dummy ? (float*)(w + WS_XD) : X, H, true, false, args.in[6] + 3 * DM, args.in[7] + 3 * DM, nullptr, nullptr, 0, nullptr, nullptr, nullptr, nullptr, lds, tid, wid, lane); }
#undef LOCALS
#undef IN
#undef SEAM
#undef args
}

extern "C" void kernel_launch(void* const* d_in, const int* in_sizes, int n_in, void* d_out, int out_size, void* d_ws, size_t ws_size, hipStream_t stream) {
    static int grid = 0;
    if (grid == 0) {
        if (n_in != 31 || in_sizes[0] != MTOK * DM || out_size != MTOK * DM || ws_size < WS_END + (MK_DUP ? 200 * MiB : 0)) {
            fprintf(stderr, "kernel_launch: built for 31 inputs, x/out of %d floats, >= %zu bytes of workspace; got n_in %d, in0 %d, out %d, ws %zu; nothing launched\n", MTOK * DM, (size_t)WS_END, n_in, n_in > 0 ? in_sizes[0] : -1, out_size, ws_size);
            grid = -1; return; }
        int dev = 0, cus = 0, per_cu = 0;
        if (hipGetDevice(&dev) != hipSuccess || hipDeviceGetAttribute(&cus, hipDeviceAttributeMultiprocessorCount, dev) != hipSuccess) { fprintf(stderr, "kernel_launch: device query failed\n"); grid = -1; return; }
        if (hipFuncSetAttribute((const void*)mk_fwd, hipFuncAttributeMaxDynamicSharedMemorySize, LDS_TOTAL) != hipSuccess) { fprintf(stderr, "kernel_launch: hipFuncSetAttribute(%d B LDS) failed\n", LDS_TOTAL); grid = -1; return; }
        if (hipOccupancyMaxActiveBlocksPerMultiprocessor(&per_cu, (const void*)mk_fwd, 512, LDS_TOTAL) != hipSuccess || per_cu < 1)
            fprintf(stderr, "kernel_launch: note: occupancy query reports %d workgroups per CU\n", per_cu);
        (void)hipGetLastError();
        grid = cus;
    }
    if (grid < 0) return;
    if (hipMemsetAsync((char*)d_ws + WS_CTL, 0, CTL_ZERO_BYTES, stream) != hipSuccess) { fprintf(stderr, "kernel_launch: memset failed\n"); return; }
    Args a{};
    for (int i = 0; i < 31; ++i) a.in[i] = (const float*)d_in[i];
    a.out = (float*)d_out; a.ws = (unsigned char*)d_ws;
#if MK_PER_PHASE
    for (int ph = 0; ph < PH_END; ++ph) {
        int group = 64;
        if (ph > 0 && ph < PH_FINAL) { const int sub = (ph - 1) >> 3, loc = (ph - 1) & 7, kind = (sub & 1) ? 3 : (sub >> 1) % 3;
            const bool exists = loc <= 2 || loc == 5 || (kind == 1 && loc <= 4); if (!exists) continue;
            group = loc == 0 ? 4 : loc == 1 ? (1 | (kind == 3 ? 512 : 1024)) : loc == 5 ? (2 | (kind == 3 ? 128 : 256)) : (kind == 0 ? 8 : kind == 1 ? (16 | (loc == 2 ? 2048 : loc == 3 ? 4096 : 8192)) : 32); }
        if (ph == PH_FINAL) group = 4;
        a.ph_lo = ph; a.ph_hi = ph + 1; a.flags = 0;
        hipLaunchKernelGGL(mk_fwd, dim3(grid), dim3(512), LDS_TOTAL, stream, a);
        if ((MK_DUP & group) == (MK_DUP & -MK_DUP) && (MK_DUP & group)) { a.flags = 1; hipLaunchKernelGGL(mk_fwd, dim3(grid), dim3(512), LDS_TOTAL, stream, a); }
    }
#else
    a.ph_lo = 0; a.ph_hi = PH_END;
    hipLaunchKernelGGL(mk_fwd, dim3(grid), dim3(512), LDS_TOTAL, stream, a);
#endif
    const hipError_t le = hipPeekAtLastError();
    if (le != hipSuccess) fprintf(stderr, "kernel_launch: launch failed: %s (grid %d)\n", hipGetErrorName(le), grid);
}
```

```cpp
#include <hip/hip_runtime.h>
#include <hip/hip_bf16.h>
#include <cstdio>
#include <cstdint>

#ifndef MK_PER_PHASE
#define MK_PER_PHASE 0
#endif

__device__ __forceinline__ int mk_lane() { int l; asm volatile("v_mbcnt_lo_u32_b32 %0, -1, 0\n\tv_mbcnt_hi_u32_b32 %0, -1, %0" : "=&v"(l)); return l; }
__device__ __forceinline__ float mk_shfl_xor(float v, int m) { return __builtin_bit_cast(float, __builtin_amdgcn_ds_bpermute((mk_lane() ^ m) << 2, __builtin_bit_cast(int, v))); }
__device__ __forceinline__ float mk_shfl_up(float v, int o) { return __builtin_bit_cast(float, __builtin_amdgcn_ds_bpermute(((mk_lane() - o) & 63) << 2, __builtin_bit_cast(int, v))); }
__device__ __forceinline__ float mk_sum_xor16(float v) { auto rr = __builtin_amdgcn_permlane16_swap(__float_as_uint(v), __float_as_uint(v), false, false); return __uint_as_float(rr[0]) + __uint_as_float(rr[1]); }
__device__ __forceinline__ float mk_sum_xor32(float v) { auto rr = __builtin_amdgcn_permlane32_swap(__float_as_uint(v), __float_as_uint(v), false, false); return __uint_as_float(rr[0]) + __uint_as_float(rr[1]); }
__device__ __forceinline__ float mk_xor1(float v) { return __builtin_bit_cast(float, __builtin_amdgcn_update_dpp(0, __builtin_bit_cast(int, v), 0xB1  , 0xf, 0xf, false)); }

namespace pg8 {
#define PG8_LAS __attribute__((address_space(3)))
typedef unsigned short bf16_t;
typedef short bf16x8 __attribute__((ext_vector_type(8)));
typedef float f32x4 __attribute__((ext_vector_type(4)));
typedef unsigned u32x4 __attribute__((ext_vector_type(4)));
constexpr int BM = 256, BK = 64, HALF = 128, HTB = HALF * BK * 2  , STAGE_BYTES = 8 * HTB, NXCD = 8, WGM = 8;

__host__ __device__ __forceinline__ int lds_byte(int r, int c) { const int st = (r >> 4) * 2 + (c >> 5), rr = r & 15, cc = c & 31, ob = rr * 64 + cc * 2; return st * 1024 + (ob ^ (((ob >> 9) & 1) << 5)); }
__host__ __device__ __forceinline__ void stage_rc(int b, int& R, int& C) { const int st = b / 1024, sb = b % 1024, swz = sb ^ (((sb >> 9) & 1) << 5); R = (st >> 1) * 16 + swz / 64; C = (st & 1) * 32 + (swz % 64) / 2; }
__host__ __device__ __forceinline__ int perm32(int rho) { const int n = rho >> 4, i = rho & 15; return 8 * (i >> 2) + 4 * n + (i & 3); }

struct Unit { int pm, pn; };
struct Gemm { const bf16_t* A; const bf16_t* Bt; int M, N, K; };

struct StaticOrder {
    int nM, nN, nwg, G, c;
    __host__ __device__ void init(int M, int N, int G_, int c_) { nM = M / BM; nN = N / BM; nwg = nM * nN; G = G_; c = c_; }
    __host__ __device__ bool next(int i, Unit& u) const {
        const long L = (long)i * G + c; if (L >= nwg) return false;
        int wgid = (int)L; { const int q = nwg / NXCD, r = nwg % NXCD, xcd = wgid % NXCD, off = wgid / NXCD; wgid = (xcd < r ? xcd * (q + 1) : r * (q + 1) + (xcd - r) * q) + off; }
        const int nig = WGM * nN, gid = wgid / nig, fm = gid * WGM, gsz = (nM - fm) < WGM ? (nM - fm) : WGM;
        u.pm = fm + ((wgid % nig) % gsz); u.pn = (wgid % nig) / gsz; return true;
    }
    __device__ __forceinline__ void a_ready(const Unit&) const {}
    __device__ __forceinline__ void done(const Unit&) const {}
};

__device__ __forceinline__ unsigned cvt_pk_bf16(float lo, float hi) { unsigned r; asm volatile("v_cvt_pk_bf16_f32 %0, %1, %2" : "=v"(r) : "v"(lo), "v"(hi)); return r; }
typedef float f32x2 __attribute__((ext_vector_type(2)));
template <class Epi, class Sched, bool ALIGN_EPI = false, bool SP2 = false>
__device__ __forceinline__ void gemm_phase(PG8_LAS unsigned char* lds, const Gemm g, const Sched& S, const Epi& E, int tid_in) {
    int tid_ = tid_in; asm volatile("" : "+v"(tid_));
    const int tid = tid_, wid = __builtin_amdgcn_readfirstlane(tid >> 6), lane = tid & 63, wr = wid >> 2, wc = wid & 3, fr = lane & 15, fq = lane >> 4;
    const int K = g.K, nt = K / BK;
    unsigned voffA[2], voffB[2];
#pragma unroll
    for (int i = 0; i < 2; ++i) { int R, C; stage_rc(tid * 16 + i * 8192, R, C); const int Rb = Epi::PERM ? ((R & ~31) + perm32(R & 31)) : R;
        voffA[i] = (unsigned)(R * K + C) * 2u; voffB[i] = (unsigned)(Rb * K + C) * 2u; }
    const size_t kstep = (size_t)(BK * 2);
    const size_t hstep = (size_t)HALF * K * 2;
    const size_t tstep = 2 * hstep;
    const unsigned ldsw = (unsigned)wid * 1024u;
    const int aoff = lds_byte(wr * 64 + fr, fq * 8), boff = lds_byte(wc * 32 + fr, fq * 8);
#define PG8_SA(b, h) (((b) * 2 + (h)) * HTB)
#define PG8_SB(b, h) ((4 + (b) * 2 + (h)) * HTB)
#define PG8_STAGE(bufoff, gbase, voff) do { _Pragma("unroll") for (int _i = 0; _i < 2; ++_i) \
        __builtin_amdgcn_global_load_lds((const unsigned*)((const char*)(gbase) + (voff)[_i]), (PG8_LAS unsigned*)(lds + (bufoff) + ldsw + _i * 8192), 16, 0, 0); } while (0)
#define PG8_LDA(dst, b, h) do { _Pragma("unroll") for (int m = 0; m < 4; ++m) _Pragma("unroll") for (int k = 0; k < 2; ++k) dst[m][k] = *(const PG8_LAS bf16x8*)(lds + PG8_SA(b, h) + aoff + m * 2048 + k * 1024); } while (0)
#define PG8_LDB(dst, b, h) do { _Pragma("unroll") for (int n = 0; n < 2; ++n) _Pragma("unroll") for (int k = 0; k < 2; ++k) dst[n][k] = *(const PG8_LAS bf16x8*)(lds + PG8_SB(b, h) + boff + n * 2048 + k * 1024); } while (0)
#define PG8_MMA(ai, bj, At, Bt) do { __builtin_amdgcn_s_setprio(1); _Pragma("unroll") for (int m = 0; m < 4; ++m) _Pragma("unroll") for (int n = 0; n < 2; ++n) _Pragma("unroll") for (int k = 0; k < 2; ++k) \
        acc[ai][bj][m][n] = __builtin_amdgcn_mfma_f32_16x16x32_bf16(Bt[n][k], At[m][k], acc[ai][bj][m][n], 0, 0, 0); __builtin_amdgcn_s_setprio(0); } while (0)
#define PG8_WAIT_V(n) asm volatile("s_waitcnt vmcnt(" #n ")" ::: "memory")
#define PG8_WAIT_L(n) asm volatile("s_waitcnt lgkmcnt(" #n ")" ::: "memory")
#define PG8_BAR __builtin_amdgcn_s_barrier()
#define PG8_SCHED __builtin_amdgcn_sched_barrier(0)
    Unit cur, nxt; int ui = 0;
    if (!S.next(0, cur)) return;
    f32x4 acc[2][2][4][2];
#pragma unroll
    for (int a = 0; a < 2; ++a)
#pragma unroll
        for (int b = 0; b < 2; ++b)
#pragma unroll
            for (int m = 0; m < 4; ++m)
#pragma unroll
                for (int n = 0; n < 2; ++n) acc[a][b][m][n] = (f32x4){0.f, 0.f, 0.f, 0.f};
    bf16x8 At[4][2], B0[2][2], B1[2][2];
    const char* cA = (const char*)g.A + (size_t)cur.pm * tstep; const char* cB = (const char*)g.Bt + (size_t)cur.pn * tstep;
    S.a_ready(cur);
    if constexpr (SP2) {
        PG8_STAGE(PG8_SB(0, 0), cB, voffB); PG8_STAGE(PG8_SB(0, 1), cB + hstep, voffB); PG8_STAGE(PG8_SA(0, 0), cA, voffA); PG8_STAGE(PG8_SA(0, 1), cA + hstep, voffA);
        if (wr == 1) PG8_BAR;
        PG8_WAIT_V(2); PG8_BAR;
        PG8_STAGE(PG8_SB(1, 0), cB + kstep, voffB); PG8_STAGE(PG8_SA(1, 0), cA + kstep, voffA); PG8_STAGE(PG8_SB(1, 1), cB + hstep + kstep, voffB);
        PG8_WAIT_V(6); PG8_BAR;
    } else {
        PG8_STAGE(PG8_SB(0, 0), cB, voffB); PG8_STAGE(PG8_SA(0, 0), cA, voffA); PG8_STAGE(PG8_SB(0, 1), cB + hstep, voffB); PG8_STAGE(PG8_SA(0, 1), cA + hstep, voffA);
        if (wr == 1) PG8_BAR;
        PG8_WAIT_V(4); PG8_BAR;
        PG8_STAGE(PG8_SB(1, 0), cB + kstep, voffB); PG8_STAGE(PG8_SA(1, 0), cA + kstep, voffA); PG8_STAGE(PG8_SB(1, 1), cB + hstep + kstep, voffB);
        PG8_WAIT_V(6); PG8_BAR;
    }
    for (;;) {
        E.unit_begin(lds, cur, ui, wid, lane);
        const bool has_next = S.next(ui + 1, nxt);
        const char* nA = has_next ? (const char*)g.A + (size_t)nxt.pm * tstep : cA; const char* nB = has_next ? (const char*)g.Bt + (size_t)nxt.pn * tstep : cB;
        for (int t = 0; t < nt; t += 2) {
            const bool last = (t == nt - 2);
            const char* a1 = cA + (size_t)(t + 1) * kstep;
            const char* a2 = last ? nA : cA + (size_t)(t + 2) * kstep; const char* b2 = last ? nB : cB + (size_t)(t + 2) * kstep;
            const char* a3 = a2 + kstep; const char* b3 = b2 + kstep;
            if (last && has_next) S.a_ready(nxt);
            if constexpr (SP2) {
            PG8_LDB(B0, 0, 0); PG8_LDB(B1, 0, 1); PG8_SCHED; PG8_LDA(At, 0, 0); PG8_STAGE(PG8_SA(1, 1), a1 + hstep, voffA);
            PG8_WAIT_V(8); PG8_WAIT_L(0); PG8_BAR; PG8_MMA(0, 0, At, B0); PG8_MMA(0, 1, At, B1); PG8_BAR; PG8_SCHED;
            PG8_LDA(At, 0, 1); PG8_STAGE(PG8_SB(0, 0), b2, voffB); PG8_STAGE(PG8_SB(0, 1), b2 + hstep, voffB); PG8_STAGE(PG8_SA(0, 0), a2, voffA);
            PG8_WAIT_V(8); PG8_WAIT_L(0); PG8_BAR; PG8_MMA(1, 0, At, B0); PG8_MMA(1, 1, At, B1); PG8_BAR; PG8_SCHED;
            PG8_LDB(B0, 1, 0); PG8_LDB(B1, 1, 1); PG8_SCHED; PG8_LDA(At, 1, 0); PG8_STAGE(PG8_SA(0, 1), a2 + hstep, voffA);
            PG8_WAIT_V(8); PG8_WAIT_L(0); PG8_BAR; PG8_MMA(0, 0, At, B0); PG8_MMA(0, 1, At, B1); PG8_BAR; PG8_SCHED;
            PG8_LDA(At, 1, 1); PG8_STAGE(PG8_SB(1, 0), b3, voffB); PG8_STAGE(PG8_SB(1, 1), b3 + hstep, voffB); PG8_STAGE(PG8_SA(1, 0), a3, voffA);
            PG8_WAIT_V(8); PG8_WAIT_L(0); PG8_BAR; PG8_MMA(1, 0, At, B0); PG8_MMA(1, 1, At, B1); PG8_BAR; PG8_SCHED;
            } else {
            PG8_LDB(B0, 0, 0); PG8_SCHED; PG8_LDA(At, 0, 0); PG8_STAGE(PG8_SA(1, 1), a1 + hstep, voffA);
            PG8_WAIT_L(8); PG8_BAR; PG8_WAIT_L(0); PG8_MMA(0, 0, At, B0); PG8_BAR; PG8_SCHED;
            PG8_LDB(B1, 0, 1); PG8_STAGE(PG8_SB(0, 0), b2, voffB);
            PG8_BAR; PG8_WAIT_L(0); PG8_MMA(0, 1, At, B1); PG8_BAR;
            PG8_LDA(At, 0, 1); PG8_STAGE(PG8_SA(0, 0), a2, voffA);
            PG8_BAR; PG8_WAIT_L(0); PG8_MMA(1, 0, At, B0); PG8_BAR; PG8_SCHED;
            PG8_STAGE(PG8_SB(0, 1), b2 + hstep, voffB);
            PG8_WAIT_V(6); PG8_BAR; PG8_MMA(1, 1, At, B1); PG8_BAR;
            PG8_LDB(B0, 1, 0); PG8_SCHED; PG8_LDA(At, 1, 0); PG8_STAGE(PG8_SA(0, 1), a2 + hstep, voffA);
            PG8_WAIT_L(8); PG8_BAR; PG8_WAIT_L(0); PG8_MMA(0, 0, At, B0); PG8_BAR; PG8_SCHED;
            PG8_LDB(B1, 1, 1); PG8_STAGE(PG8_SB(1, 0), b3, voffB);
            PG8_BAR; PG8_WAIT_L(0); PG8_MMA(0, 1, At, B1); PG8_BAR;
            PG8_LDA(At, 1, 1); PG8_STAGE(PG8_SA(1, 0), a3, voffA);
            PG8_BAR; PG8_WAIT_L(0); PG8_MMA(1, 0, At, B0); PG8_BAR; PG8_SCHED;
            PG8_STAGE(PG8_SB(1, 1), b3 + hstep, voffB);
            PG8_WAIT_V(6); PG8_BAR; PG8_MMA(1, 1, At, B1); PG8_BAR;
            }
        }
        if constexpr (ALIGN_EPI) { if (wr == 0) PG8_BAR; }
        if constexpr (!Epi::AFTER_DRAIN) { E(acc, cur, wr, wc, fr, fq, lds, ui); S.done(cur); }
        if (!has_next) break;
#pragma unroll
        for (int a = 0; a < 2; ++a)
#pragma unroll
            for (int b = 0; b < 2; ++b)
#pragma unroll
                for (int m = 0; m < 4; ++m)
#pragma unroll
                    for (int n = 0; n < 2; ++n) acc[a][b][m][n] = (f32x4){0.f, 0.f, 0.f, 0.f};
        cur = nxt; cA = nA; cB = nB; ++ui;
        if constexpr (ALIGN_EPI) { if (wr == 1) PG8_BAR; }
    }
    PG8_WAIT_V(0);
    if constexpr (!ALIGN_EPI) { if (wr == 0) PG8_BAR; }
    PG8_BAR;
    if constexpr (Epi::AFTER_DRAIN) { E.fused(acc, cur, wr, wc, fr, fq, lds, wid, lane); S.done(cur); }
#undef PG8_SA
#undef PG8_SB
#undef PG8_STAGE
#undef PG8_LDA
#undef PG8_LDB
#undef PG8_MMA
#undef PG8_WAIT_V
#undef PG8_WAIT_L
#undef PG8_BAR
#undef PG8_SCHED
}
}

namespace pg8 {
constexpr int EPI_LDS_OFF = 131072, EPI_LDS_PAR = 8192;
struct EpiStore {
    static constexpr bool PERM = true, AFTER_DRAIN = false;
    bf16_t* O; int ldc; int hm; float* n2p;
    __device__ __forceinline__ void unit_begin(PG8_LAS unsigned char*, const Unit&, int, int, int) const {}
    __device__ __forceinline__ void operator()(const f32x4 (&acc)[2][2][4][2], const Unit& u, int wr, int wc, int fr, int fq, PG8_LAS unsigned char* lds, int ui) const {
        const int row0 = u.pm * BM + wr * 64 + fr, col0 = u.pn * BM + wc * 32 + 8 * fq;
        size_t base[2]; size_t rstride;
        if (hm) { const int b = row0 >> 12, s = row0 & 4095;
#pragma unroll
            for (int bj = 0; bj < 2; ++bj) { const int c = col0 + bj * HALF, t = c >> 11, h = (c >> 7) & 15, d = c & 127; base[bj] = ((size_t)((t * 4 + b) * 16 + h) * 4096 + s) * 128 + d; }
            rstride = 128;
            if (u.pn < 16) {
#pragma unroll
                for (int bj = 0; bj < 2; ++bj) { const int c = col0 + bj * HALF, t = c >> 11, h = (c >> 7) & 15;
                    float* np = n2p + ((size_t)((t * 4 + b) * 16 + h) * 4096 + s) * 4 + wc;
#pragma unroll
                    for (int ai = 0; ai < 2; ++ai)
#pragma unroll
                        for (int m = 0; m < 4; ++m) { const f32x4 v0 = acc[ai][bj][m][0], v1 = acc[ai][bj][m][1];
                            float q = (v0[0] * v0[0] + v0[1] * v0[1]) + (v0[2] * v0[2] + v0[3] * v0[3]) + (v1[0] * v1[0] + v1[1] * v1[1]) + (v1[2] * v1[2] + v1[3] * v1[3]);
                            q = mk_sum_xor32(mk_sum_xor16(q));
                            if (fq == 0) np[(size_t)(ai * HALF + m * 16) * 4] = q; } } }
        }
        else { base[0] = (size_t)row0 * ldc + col0; base[1] = base[0] + HALF; rstride = (size_t)ldc; }
#pragma unroll
        for (int ai = 0; ai < 2; ++ai)
#pragma unroll
            for (int m = 0; m < 4; ++m) {
#pragma unroll
                for (int bj = 0; bj < 2; ++bj) { const f32x4 v0 = acc[ai][bj][m][0], v1 = acc[ai][bj][m][1];
                    u32x4 w; w.x = cvt_pk_bf16(v0[0], v0[1]); w.y = cvt_pk_bf16(v0[2], v0[3]); w.z = cvt_pk_bf16(v1[0], v1[1]); w.w = cvt_pk_bf16(v1[2], v1[3]);
                    *(u32x4*)(O + base[bj] + (size_t)(ai * HALF + m * 16) * rstride) = w; } }
    }
};
struct EpiResid {
    static constexpr bool PERM = true, AFTER_DRAIN = false;
    const void* Xs; bf16_t* Xd; const float* gate; int src_f32; const float* stats;
    __device__ __forceinline__ void unit_begin(PG8_LAS unsigned char* lds, const Unit& u, int ui, int wid, int) const {
        if (wid < 5) { int lane; asm volatile("v_mbcnt_lo_u32_b32 %0, -1, 0\n\tv_mbcnt_hi_u32_b32 %0, -1, %0" : "=&v"(lane));
            const float* src = wid < 3 ? (wid == 0 ? gate + (size_t)((u.pm * BM) >> 12) * 12288 : stats + 2 * 16384 + (wid - 1) * 2048) + u.pn * BM + lane * 4
                                       : stats + (size_t)(u.pm * BM + (wid - 3) * 128) * 2 + lane * 4;
            __builtin_amdgcn_global_load_lds((const unsigned*)src, (PG8_LAS unsigned*)(lds + EPI_LDS_OFF + (ui & 1) * EPI_LDS_PAR + wid * 1024), 16, 0, 0); }
    }
    __device__ __forceinline__ void operator()(const f32x4 (&acc)[2][2][4][2], const Unit& u, int wr, int wc, int fr, int fq, PG8_LAS unsigned char* lds, int ui) const {
        const int row0 = u.pm * BM + wr * 64 + fr, col0 = u.pn * BM + wc * 32 + 8 * fq;
        const PG8_LAS float* lv = (const PG8_LAS float*)(lds + EPI_LDS_OFF + (ui & 1) * EPI_LDS_PAR) + wc * 32 + 8 * fq;
        if (src_f32) {
            f32x4 gv[2][2], av[2][2], bv[2][2];
#pragma unroll
            for (int bj = 0; bj < 2; ++bj)
#pragma unroll
                for (int n = 0; n < 2; ++n) { gv[bj][n] = *(const PG8_LAS f32x4*)(lv + bj * HALF + n * 4); av[bj][n] = *(const PG8_LAS f32x4*)(lv + 256 + bj * HALF + n * 4); bv[bj][n] = *(const PG8_LAS f32x4*)(lv + 512 + bj * HALF + n * 4); }
#pragma unroll
            for (int ai = 0; ai < 2; ++ai)
#pragma unroll
                for (int mp = 0; mp < 2; ++mp) {
                    f32x4 xv[2][2][2]; f32x2 st[2];
#pragma unroll
                    for (int mm = 0; mm < 2; ++mm) { const size_t row = (size_t)(row0 + ai * HALF + (2 * mp + mm) * 16); st[mm] = *(const f32x2*)(stats + row * 2); const float* rowp = (const float*)Xs + row * 2048 + col0;
#pragma unroll
                        for (int bj = 0; bj < 2; ++bj)
#pragma unroll
                            for (int n = 0; n < 2; ++n) xv[mm][bj][n] = *(const f32x4*)(rowp + bj * HALF + n * 4); }
#pragma unroll
                    for (int mm = 0; mm < 2; ++mm) { bf16_t* rowp = Xd + (size_t)(row0 + ai * HALF + (2 * mp + mm) * 16) * 2048 + col0; const float mean = st[mm][0], rstd = st[mm][1];
#pragma unroll
                        for (int bj = 0; bj < 2; ++bj) {
                            const f32x4 r0 = (xv[mm][bj][0] - mean) * rstd * av[bj][0] + bv[bj][0] + gv[bj][0] * acc[ai][bj][2 * mp + mm][0];
                            const f32x4 r1 = (xv[mm][bj][1] - mean) * rstd * av[bj][1] + bv[bj][1] + gv[bj][1] * acc[ai][bj][2 * mp + mm][1];
                            u32x4 w; w.x = cvt_pk_bf16(r0[0], r0[1]); w.y = cvt_pk_bf16(r0[2], r0[3]); w.z = cvt_pk_bf16(r1[0], r1[1]); w.w = cvt_pk_bf16(r1[2], r1[3]);
                            *(u32x4*)(rowp + bj * HALF) = w; } } }
        } else {
#pragma unroll
            for (int ai = 0; ai < 2; ++ai) {
                u32x4 xb[4][2]; f32x2 st[4];
#pragma unroll
                for (int m = 0; m < 4; ++m) { const size_t row = (size_t)(row0 + ai * HALF + m * 16); const bf16_t* rowp = (const bf16_t*)Xs + row * 2048 + col0;
                    xb[m][0] = *(const u32x4*)(rowp); xb[m][1] = *(const u32x4*)(rowp + HALF); }
                __builtin_amdgcn_sched_barrier(0);
#pragma unroll
                for (int m = 0; m < 4; ++m) st[m] = ((const PG8_LAS f32x2*)(lds + EPI_LDS_OFF + (ui & 1) * EPI_LDS_PAR + 3072))[ai * HALF + wr * 64 + m * 16 + fr];
#pragma unroll
                for (int bj = 0; bj < 2; ++bj) {
                    const f32x4 g0 = *(const PG8_LAS f32x4*)(lv + bj * HALF), g1 = *(const PG8_LAS f32x4*)(lv + bj * HALF + 4);
                    const f32x4 a0 = *(const PG8_LAS f32x4*)(lv + 256 + bj * HALF), a1 = *(const PG8_LAS f32x4*)(lv + 256 + bj * HALF + 4);
                    const f32x4 b0 = *(const PG8_LAS f32x4*)(lv + 512 + bj * HALF), b1 = *(const PG8_LAS f32x4*)(lv + 512 + bj * HALF + 4);
#pragma unroll
                    for (int m = 0; m < 4; ++m) {
                        bf16_t* rowp = Xd + (size_t)(row0 + ai * HALF + m * 16) * 2048 + col0 + bj * HALF; const float mean = st[m][0], rstd = st[m][1];
                        const u32x4 xw = xb[m][bj]; f32x4 x0, x1;
                        x0[0] = __uint_as_float(xw.x << 16); x0[1] = __uint_as_float(xw.x & 0xffff0000u); x0[2] = __uint_as_float(xw.y << 16); x0[3] = __uint_as_float(xw.y & 0xffff0000u);
                        x1[0] = __uint_as_float(xw.z << 16); x1[1] = __uint_as_float(xw.z & 0xffff0000u); x1[2] = __uint_as_float(xw.w << 16); x1[3] = __uint_as_float(xw.w & 0xffff0000u);
                        const f32x4 r0 = (x0 - mean) * rstd * a0 + b0 + g0 * acc[ai][bj][m][0];
                        const f32x4 r1 = (x1 - mean) * rstd * a1 + b1 + g1 * acc[ai][bj][m][1];
                        u32x4 w; w.x = cvt_pk_bf16(r0[0], r0[1]); w.y = cvt_pk_bf16(r0[2], r0[3]); w.z = cvt_pk_bf16(r1[0], r1[1]); w.w = cvt_pk_bf16(r1[2], r1[3]);
                        *(u32x4*)rowp = w; } }
                __builtin_amdgcn_sched_barrier(0); }
        }
    }
};
template <int CTRL> __device__ __forceinline__ float dppf(float v) { return __builtin_bit_cast(float, __builtin_amdgcn_update_dpp(0, __builtin_bit_cast(int, v), CTRL, 0xf, 0xf, true)); }
typedef unsigned u32x2v __attribute__((ext_vector_type(2)));
struct EpiFfn {
    static constexpr bool PERM = true, AFTER_DRAIN = false;
    bf16_t* ACT; float* ZH; const float* cw; const float* cb;
    __device__ __forceinline__ void unit_begin(PG8_LAS unsigned char* lds, const Unit& u, int ui, int wid, int) const {
        if (wid < 4) { int lane; asm volatile("v_mbcnt_lo_u32_b32 %0, -1, 0\n\tv_mbcnt_hi_u32_b32 %0, -1, %0" : "=&v"(lane));
            const float* src = (wid < 3 ? cw + wid * 11264 : cb) + (lane < 32 ? 0 : 5632) + u.pn * 128 + (lane & 31) * 4;
            __builtin_amdgcn_global_load_lds((const unsigned*)src, (PG8_LAS unsigned*)(lds + EPI_LDS_OFF + (ui & 1) * EPI_LDS_PAR + wid * 1024), 16, 0, 0); }
    }
    __device__ __forceinline__ void operator()(const f32x4 (&acc)[2][2][4][2], const Unit& u, int wr, int wc, int fr, int fq, PG8_LAS unsigned char* lds, int ui) const {
#pragma unroll
        for (int n = 0; n < 2; ++n) {
            const int ch0 = u.pn * 128 + wc * 32 + 8 * fq + 4 * n;
            f32x4 wa[3], wu[3];
            const PG8_LAS float* lw = (const PG8_LAS float*)(lds + EPI_LDS_OFF + (ui & 1) * EPI_LDS_PAR) + wc * 32 + 8 * fq + 4 * n;
#pragma unroll
            for (int k = 0; k < 3; ++k) { wa[k] = *(const PG8_LAS f32x4*)(lw + k * 256); wu[k] = *(const PG8_LAS f32x4*)(lw + k * 256 + 128); }
            const f32x4 ba = *(const PG8_LAS f32x4*)(lw + 3 * 256), bu = *(const PG8_LAS f32x4*)(lw + 3 * 256 + 128);
#pragma unroll
            for (int ai = 0; ai < 2; ++ai) { const int blk = u.pm * 4 + ai * 2 + wr;
                if (fr < 2) { float* zp = ZH + ((size_t)(blk * 4 + 2 + fr) * 2) * 5632 + ch0; *(f32x4*)zp = acc[ai][0][0][n]; *(f32x4*)(zp + 5632) = acc[ai][1][0][n]; }
                if (fr >= 14) { float* zp = ZH + ((size_t)((blk + 1) * 4 + fr - 14) * 2) * 5632 + ch0; *(f32x4*)zp = acc[ai][0][3][n]; *(f32x4*)(zp + 5632) = acc[ai][1][3][n]; }
                f32x4 q1a = {0.f, 0.f, 0.f, 0.f}, q0a = q1a, q1u = q1a, q0u = q1a;
#pragma unroll
                for (int m = 0; m < 4; ++m) { float o[4];
                    const f32x4 va = acc[ai][0][m][n], vu = acc[ai][1][m][n];
                    f32x4 t1a = wa[1] * va, t0a = wa[0] * va, t1u = wu[1] * vu, t0u = wu[0] * vu;
                    f32x4 ya = ba + wa[2] * va, yu = bu + wu[2] * vu;
#define FFN_DPP4(Y, T, CTRL) asm volatile("s_nop 1\n\tv_add_f32_dpp %0, %4, %0 " CTRL " row_mask:0xf bank_mask:0xf bound_ctrl:1\n\tv_add_f32_dpp %1, %5, %1 " CTRL " row_mask:0xf bank_mask:0xf bound_ctrl:1\n\t" \
                                          "v_add_f32_dpp %2, %6, %2 " CTRL " row_mask:0xf bank_mask:0xf bound_ctrl:1\n\tv_add_f32_dpp %3, %7, %3 " CTRL " row_mask:0xf bank_mask:0xf bound_ctrl:1" \
                                          : "+v"(Y[0]), "+v"(Y[1]), "+v"(Y[2]), "+v"(Y[3]) : "v"(T[0]), "v"(T[1]), "v"(T[2]), "v"(T[3]))
                    asm volatile("s_nop 4" : "+v"(t1a), "+v"(t0a), "+v"(t1u), "+v"(t0u), "+v"(q1a), "+v"(q0a), "+v"(q1u), "+v"(q0u));
                    FFN_DPP4(ya, t1a, "row_shr:1"); FFN_DPP4(yu, t1u, "row_shr:1"); FFN_DPP4(ya, t0a, "row_shr:2"); FFN_DPP4(yu, t0u, "row_shr:2");
                    if (m) { FFN_DPP4(ya, q1a, "row_shl:15"); FFN_DPP4(yu, q1u, "row_shl:15"); FFN_DPP4(ya, q0a, "row_shl:14"); FFN_DPP4(yu, q0u, "row_shl:14"); }
#undef FFN_DPP4
#pragma unroll
                    for (int e = 0; e < 4; e += 2) {
                        const f32x2 a2 = {ya[e], ya[e + 1]}, u2 = {yu[e], yu[e + 1]}, x2 = a2 * (-1.4426950408889634f);
                        f32x2 d2; d2.x = __builtin_amdgcn_exp2f(x2.x); d2.y = __builtin_amdgcn_exp2f(x2.y); d2 = d2 + 1.0f;
                        f32x2 r2; r2.x = __builtin_amdgcn_rcpf(d2.x); r2.y = __builtin_amdgcn_rcpf(d2.y);
                        const f32x2 o2 = (a2 * u2) * r2; o[e] = o2.x; o[e + 1] = o2.y; }
                    q1a = t1a; q0a = t0a; q1u = t1u; q0u = t0u;
                    if (m > 0 || fr >= 2) { u32x2v w; w.x = cvt_pk_bf16(o[0], o[1]); w.y = cvt_pk_bf16(o[2], o[3]); *(u32x2v*)(ACT + (size_t)(blk * 64 + m * 16 + fr) * 5632 + ch0) = w; }
                    __builtin_amdgcn_sched_barrier(0); } } }
    }
};
}
namespace fx {
using bf16 = __hip_bfloat16;
constexpr int D = 128, RS = 128  , OS = 2048  ;
constexpr float THR = 24.f;     constexpr bool WSKIP = false; constexpr float T_DEAD = 24.f;
constexpr float SCALE = 0.08838834764831845f;
constexpr int NW = 8, QBLK = 32, KVBLK = 64, QB = NW * QBLK;
constexpr int SHM_V = KVBLK * D * 2, SHM_K = KVBLK * D * 2;
constexpr int BIAS_OFF = 2 * SHM_V + 2 * SHM_K + NW * 64 * 4;
constexpr int GATE_OFF = BIAS_OFF + 4096 * 4;
constexpr int LDS_BYTES = GATE_OFF + 8 * 8192;
typedef short bf16x8 __attribute__((ext_vector_type(8)));
typedef short s16x4 __attribute__((ext_vector_type(4)));
typedef float f32x16 __attribute__((ext_vector_type(16)));
typedef float f32x4 __attribute__((ext_vector_type(4)));
typedef unsigned u32x4 __attribute__((ext_vector_type(4)));
template <class A, class Bt> struct same_t { static constexpr bool v = false; };
template <class A> struct same_t<A, A> { static constexpr bool v = true; };
#define KSWZ(row, colB) ((row) * 256 + ((colB) ^ (((row) & 7) << 4)))
#define SBAR() __builtin_amdgcn_sched_barrier(0)
__device__ __forceinline__ int v_st(int k, int c) { const int kk = (k & ~0xC) | ((k & 4) << 1) | ((k & 8) >> 1); return ((kk >> 3) * 4 + (c >> 5)) * 512 + ((kk & 7) * 32 + (c & 31)) * 2; }
__device__ __forceinline__ int v_rd_base(int lane) { return ((lane & 3) << 3) | (((lane >> 2) & 3) << 6) | (((lane >> 4) & 1) << 5) | (((lane >> 5) & 1) << 8); }
constexpr int v_rd_off(int d0, int ks, int half) { return d0 * 512 + ks * 4096 + half * 2048; }
__device__ __forceinline__ int crow(int r, int hi) { return (r & 3) + 8 * (r >> 2) + 4 * hi; }
__device__ __forceinline__ unsigned cvtpk(float lo, float hi) {
    unsigned r; asm volatile("v_cvt_pk_bf16_f32 %0, %1, %2" : "=v"(r) : "v"(lo), "v"(hi)); return r;
}
__device__ __forceinline__ bf16x8 pack8(f32x4 a, f32x4 b) {
    u32x4 w = {cvtpk(a[0], a[1]), cvtpk(a[2], a[3]), cvtpk(b[0], b[1]), cvtpk(b[2], b[3])};
    return *reinterpret_cast<bf16x8*>(&w);
}
template <class T> __device__ __forceinline__ bf16x8 load8(const T* p) {
    if constexpr (same_t<T, float>::v) { return pack8(*(const f32x4*)p, *(const f32x4*)(p + 4)); }
    else { return *(const __attribute__((address_space(1))) bf16x8*)(p); }
}
__device__ __forceinline__ bf16x8 ldg16(const char* sbase, unsigned voff) { return *(const __attribute__((address_space(1))) bf16x8*)((const __attribute__((address_space(1))) char*)sbase + voff); }
__device__ __forceinline__ void mask_tile(f32x16& p0, f32x16& p1, int dq, unsigned W) {
    const float NEG = -__builtin_inff();
#pragma unroll
    for (int r = 0; r < 16; ++r) {
        const int c = (r & 3) + 8 * (r >> 2);
        if ((unsigned)(dq - c) >= W) p0[r] = NEG;
        if ((unsigned)(dq - c - 32) >= W) p1[r] = NEG;
    }
}
__device__ __forceinline__ void partialSM(f32x16& p0, f32x16& p1, float& m_reg, float& mn, float& alpha, bool& dead) {
    float pmax = p0[0]; for (int r = 1; r < 16; ++r) pmax = fmaxf(pmax, p0[r]); for (int r = 0; r < 16; ++r) pmax = fmaxf(pmax, p1[r]);
    { auto rr = __builtin_amdgcn_permlane32_swap(__float_as_uint(pmax), __float_as_uint(pmax), false, false);
      pmax = fmaxf(__uint_as_float(rr[0]), __uint_as_float(rr[1])); }
    constexpr float C2 = 1.4426950408889634f * SCALE;
    dead = __all((pmax - m_reg) * SCALE < -T_DEAD);
    if (dead) { mn = m_reg; alpha = 1.f; return; }
    if (__builtin_expect(__all((pmax - m_reg) * SCALE <= THR), 1)) { mn = m_reg; alpha = 1.f; }
    else { mn = fmaxf(m_reg, pmax); alpha = __builtin_amdgcn_exp2f((m_reg - mn) * C2); m_reg = mn; }
    const float mnL = -mn * C2;
    for (int r = 0; r < 16; ++r) p0[r] = fmaf(p0[r], C2, mnL); for (int r = 0; r < 16; ++r) p1[r] = fmaf(p1[r], C2, mnL);
    for (int r = 0; r < 16; ++r) p0[r] = __builtin_amdgcn_exp2f(p0[r]);
}
__device__ __forceinline__ void finishSM(f32x16& p0, f32x16& p1, float alpha, float& l_reg, bf16x8& pa0, bf16x8& pa1, bf16x8& pa2, bf16x8& pa3) {
    for (int r = 0; r < 16; ++r) p1[r] = __builtin_amdgcn_exp2f(p1[r]);
    float ps = 0; for (int r = 0; r < 16; ++r) ps += p0[r]; for (int r = 0; r < 16; ++r) ps += p1[r];
    { auto rr = __builtin_amdgcn_permlane32_swap(__float_as_uint(ps), __float_as_uint(ps), false, false);
      ps = __uint_as_float(rr[0]) + __uint_as_float(rr[1]); }
    l_reg = l_reg * alpha + ps;
#define PK4(P, B_, OUT) do { unsigned a0 = cvtpk(P[B_+0], P[B_+1]), a1 = cvtpk(P[B_+2], P[B_+3]);                          \
        unsigned b0 = cvtpk(P[B_+4], P[B_+5]), b1 = cvtpk(P[B_+6], P[B_+7]);                                             \
        auto r0 = __builtin_amdgcn_permlane32_swap(a0, b0, false, false); auto r1 = __builtin_amdgcn_permlane32_swap(a1, b1, false, false); \
        u32x4 w = {r0[0], r1[0], r0[1], r1[1]}; OUT = *reinterpret_cast<bf16x8*>(&w); } while (0)
    PK4(p0, 0, pa0); PK4(p0, 8, pa1); PK4(p1, 0, pa2); PK4(p1, 8, pa3);
#undef PK4
}
template <int KB, bool SK>
__device__ __forceinline__ void qkt(f32x16& p0, f32x16& p1, const char* K_lds, int r32, int hi, const bf16x8* qr, bool act, const float* bl) {
    if (SK && !act) { const float NEG = -__builtin_inff();
#pragma unroll
        for (int r = 0; r < 16; ++r) { p0[r] = NEG; p1[r] = NEG; } return; }
#pragma unroll
    for (int g_ = 0; g_ < 4; ++g_) { const f32x4 t0 = *(const f32x4*)(bl + 8 * g_), t1 = *(const f32x4*)(bl + 32 + 8 * g_);
#pragma unroll
        for (int e_ = 0; e_ < 4; ++e_) { p0[4 * g_ + e_] = t0[e_]; p1[4 * g_ + e_] = t1[e_]; } }
    const char* kb[4];
#pragma unroll
    for (int dd = 0; dd < 4; ++dd) kb[dd] = K_lds + KB * SHM_K + KSWZ(r32, (dd * 16 + hi * 8) * 2);
#pragma unroll
    for (int d0 = 0; d0 < 8; ++d0) { const char* a = kb[d0 & 3] + (d0 >> 2) * 128;
        bf16x8 b0 = *reinterpret_cast<const bf16x8*>(a);
        bf16x8 b1 = *reinterpret_cast<const bf16x8*>(a + 32 * 256);
        p0 = __builtin_amdgcn_mfma_f32_32x32x16_bf16(b0, qr[d0], p0, 0, 0, 0);
        p1 = __builtin_amdgcn_mfma_f32_32x32x16_bf16(b1, qr[d0], p1, 0, 0, 0); }
}
template <int VB, bool SK>
__device__ __forceinline__ void pv_tile(f32x16* o, int vb0, bf16x8 pa0, bf16x8 pa1, bf16x8 pa2, bf16x8 pa3, bool act) {
    if (SK && !act) return;
#define TRRD(dst, off) asm volatile("ds_read_b64_tr_b16 %0, %1 offset:%2" : "=&v"(dst) : "v"(vb0), "i"(off) : "memory")
#define PV_D0(d0) do { s16x4 l0, l1, l2, l3, h0, h1, h2, h3; constexpr int b_ = VB * SHM_V + v_rd_off(d0, 0, 0);     \
        TRRD(l0, b_); TRRD(h0, b_ + 2048); TRRD(l1, b_ + 4096); TRRD(h1, b_ + 6144); TRRD(l2, b_ + 8192); TRRD(h2, b_ + 10240); TRRD(l3, b_ + 12288); TRRD(h3, b_ + 14336); \
        asm volatile("s_waitcnt lgkmcnt(0)" ::: "memory"); SBAR();                 \
        o[d0] = __builtin_amdgcn_mfma_f32_32x32x16_bf16(pa0, (bf16x8){l0[0], l0[1], l0[2], l0[3], h0[0], h0[1], h0[2], h0[3]}, o[d0], 0, 0, 0);   \
        o[d0] = __builtin_amdgcn_mfma_f32_32x32x16_bf16(pa1, (bf16x8){l1[0], l1[1], l1[2], l1[3], h1[0], h1[1], h1[2], h1[3]}, o[d0], 0, 0, 0);   \
        o[d0] = __builtin_amdgcn_mfma_f32_32x32x16_bf16(pa2, (bf16x8){l2[0], l2[1], l2[2], l2[3], h2[0], h2[1], h2[2], h2[3]}, o[d0], 0, 0, 0);   \
        o[d0] = __builtin_amdgcn_mfma_f32_32x32x16_bf16(pa3, (bf16x8){l3[0], l3[1], l3[2], l3[3], h3[0], h3[1], h3[2], h3[3]}, o[d0], 0, 0, 0); } while (0)
    PV_D0(0); PV_D0(1); PV_D0(2); PV_D0(3);
#undef PV_D0
#undef TRRD
}

template <class TIn, class TOut> struct BlockRef { const TIn* Q; const TIn* K; const TIn* V; TOut* O; const float* Bias; const TIn* G; int P0; int JLO; };
#define FX_LASU __attribute__((address_space(3))) unsigned
#define BIAS_DMA(ref) do { _Pragma("unroll") for (int i_ = 0; i_ < 2; ++i_) __builtin_amdgcn_global_load_lds((const unsigned*)((ref).Bias + (size_t)(i_ * 512 + tid) * 4), (FX_LASU*)(lds + BIAS_OFF + i_ * 8192 + wid * 1024), 16, 0, 0); } while (0)
template <class TIn> struct Seam {
    bf16x8 qr[8];
    bf16x8 st_v0, st_v1, st_k0, st_k1; f32x4 sf0, sf1, sf2, sf3;
    bf16x8 sb_v0, sb_v1, sb_k0, sb_k1;
    f32x4 tq[16];
};
__device__ __forceinline__ int swa_jlo(int P0, int W) { const int lowk = P0 - W + 1; return lowk > 0 ? lowk / KVBLK : 0; }
#define ROW(p, k0, rr) ((p) + (size_t)((k0) + (rr)) * RS + sc)
#define VMW() asm volatile("s_waitcnt vmcnt(0)" ::: "memory")
#define VMWN(n) asm volatile("s_waitcnt vmcnt(%0)" :: "i"(n) : "memory")
#define SLOAD_H(Kp, Vp, k0) do { const char* kb_ = (const char*)(Kp) + (size_t)(k0) * (RS * 2); const char* vb_ = (const char*)(Vp) + (size_t)(k0) * (RS * 2);     \
                         S.st_v0 = ldg16(vb_, stoff); S.st_v1 = ldg16(vb_ + 32 * RS * 2, stoff); S.st_k0 = ldg16(kb_, stoff); S.st_k1 = ldg16(kb_ + 32 * RS * 2, stoff); } while (0)
#define SWRITE_HK(bf) do { *(bf16x8*)(K_lds + (bf) * SHM_K + kws) = S.st_k0; *(bf16x8*)(K_lds + (bf) * SHM_K + kws + 32 * 256) = S.st_k1; } while (0)
#define SWRITE_HV(bf) do { *(bf16x8*)(V_lds + (bf) * SHM_V + vst0) = S.st_v0; *(bf16x8*)(V_lds + (bf) * SHM_V + vst1) = S.st_v1; } while (0)
#define SWRITE_H(bf) do { SWRITE_HV(bf); SWRITE_HK(bf); } while (0)
#define SLOAD_HB(Kp, Vp, k0) do { const char* kb_ = (const char*)(Kp) + (size_t)(k0) * (RS * 2); const char* vb_ = (const char*)(Vp) + (size_t)(k0) * (RS * 2);   \
                          S.sb_v0 = ldg16(vb_, stoff); S.sb_v1 = ldg16(vb_ + 32 * RS * 2, stoff); S.sb_k0 = ldg16(kb_, stoff); S.sb_k1 = ldg16(kb_ + 32 * RS * 2, stoff); } while (0)
#define SWRITE_HB(bf) do { *(bf16x8*)(V_lds + (bf) * SHM_V + vst0) = S.sb_v0; *(bf16x8*)(V_lds + (bf) * SHM_V + vst1) = S.sb_v1;   \
                           *(bf16x8*)(K_lds + (bf) * SHM_K + kws) = S.sb_k0; *(bf16x8*)(K_lds + (bf) * SHM_K + kws + 32 * 256) = S.sb_k1; } while (0)
#define TCL(t) ((t) < NT ? (t) : NT - 1)
#define SLOAD_F(p, k0) do { S.sf0 = *(const f32x4*)ROW(p, k0, sr); S.sf1 = *(const f32x4*)(ROW(p, k0, sr) + 4);                \
                            S.sf2 = *(const f32x4*)ROW(p, k0, 32 + sr); S.sf3 = *(const f32x4*)(ROW(p, k0, 32 + sr) + 4); } while (0)
#define SWRITE_KF(bf) do { *(bf16x8*)(K_lds + (bf) * SHM_K + kws) = pack8(S.sf0, S.sf1); *(bf16x8*)(K_lds + (bf) * SHM_K + kws + 32 * 256) = pack8(S.sf2, S.sf3); } while (0)
#define SWRITE_VF(bf) do { *(bf16x8*)(V_lds + (bf) * SHM_V + vst0) = pack8(S.sf0, S.sf1); *(bf16x8*)(V_lds + (bf) * SHM_V + vst1) = pack8(S.sf2, S.sf3); } while (0)
template <class TIn, class TOut>
__device__ __forceinline__ void causal_swa_prime(const BlockRef<TIn, TOut>& cur, int W, char* lds, Seam<TIn>& S, int tid_in) {
    constexpr bool F32 = same_t<TIn, float>::v;
    int tid_l_ = tid_in; asm volatile("" : "+v"(tid_l_));
    const int tid = tid_l_, wid = __builtin_amdgcn_readfirstlane(tid >> 6), lane = tid & 63, r32 = lane & 31, hi = lane >> 5;
    const int sr = tid >> 4, sc = (tid & 15) * 8, kws = KSWZ(sr, sc * 2); char* K_lds = lds + 2 * SHM_V;
    const unsigned stoff = (unsigned)(sr * RS + sc) * 2u;
    const int kb0 = ((cur.P0 + QB - 1) / KVBLK) * KVBLK;
    for (int d0 = 0; d0 < 8; ++d0) S.qr[d0] = load8<TIn>(cur.Q + (size_t)(wid * QBLK + r32) * RS + d0 * 16 + hi * 8);
    BIAS_DMA(cur);
    if constexpr (F32) { SLOAD_F((const float*)cur.K, kb0); VMW(); SWRITE_KF(0); SBAR(); SLOAD_F((const float*)cur.V, kb0); }
    else { SLOAD_H(cur.K, cur.V, kb0); VMW(); SWRITE_HK(0); }
    __syncthreads();
}
template <class TIn, class TOut>
__device__ __forceinline__ void causal_swa_block(const BlockRef<TIn, TOut>& cur, const BlockRef<TIn, TOut>& nxt, int skv, int W, char* lds, Seam<TIn>& S, int tid_in) {
    constexpr bool F32 = same_t<TIn, float>::v;
    int tid_l_ = tid_in; asm volatile("" : "+v"(tid_l_));
    const int tid = tid_l_, wid = __builtin_amdgcn_readfirstlane(tid >> 6), lane = tid & 63, r32 = lane & 31, hi = lane >> 5;
    const int j_lo = cur.JLO;
    int j_hi = (cur.P0 + QB - 1) / KVBLK + 1; if (j_hi > skv / KVBLK) j_hi = skv / KVBLK;
    const int NT = j_hi - j_lo;
    const int kbn = ((nxt.P0 + QB - 1) / KVBLK) * KVBLK;
    const int qlo = cur.P0 + wid * QBLK, qm = qlo + r32 - 4 * hi;
    char* V_lds = lds; char* K_lds = lds + 2 * SHM_V; const float* bias_l = (const float*)(lds + BIAS_OFF) + 4 * hi;
    float* ws = (float*)(lds + 2 * SHM_V + 2 * SHM_K) + wid * 64; float* li_l = ws, * al_l = ws + 32;
    float m_reg = -1e30f, l_reg = 0; f32x16 o[4] = {};
    const int sr = tid >> 4, sc = (tid & 15) * 8, vst0 = v_st(sr, sc), vst1 = v_st(32 + sr, sc), kws = KSWZ(sr, sc * 2);
    const unsigned stoff = (unsigned)(sr * RS + sc) * 2u;
    const int vb0 = (int)(uintptr_t)V_lds + v_rd_base(lane);
    const TIn* Kh = cur.K; const TIn* Vh = cur.V;
#define RESC(a) do { if (__any((a) < 1.f)) { if (hi == 0) al_l[r32] = (a); asm volatile("s_waitcnt lgkmcnt(0)" ::: "memory");              \
                     for (int d_ = 0; d_ < 4; ++d_) for (int r = 0; r < 16; ++r) o[d_][r] *= al_l[crow(r, hi)]; } } while (0)
#define KBASE(t) ((j_hi - 1 - (t)) * KVBLK)
#define ACT(t) (KBASE(t) <= qlo + QBLK - 1 && KBASE(t) + KVBLK - 1 >= qlo - W + 1)
#define MASKT(P0_, P1_, t) do { const int kb_ = KBASE(t); if ((!SK || ACT(t)) && (kb_ + KVBLK - 1 > qlo || kb_ <= qlo + QBLK - 1 - W)) mask_tile(P0_, P1_, qm - kb_, (unsigned)W); } while (0)
    constexpr int NQL = F32 ? 16 : 8;
    constexpr bool SK = WSKIP && !F32;
#define SEAM_K0() do { if constexpr (F32) { VMWN(NQL); SWRITE_KF(0); SBAR(); SLOAD_F((const float*)nxt.V, kbn); } else { VMW(); SWRITE_HK(0); } SBAR(); } while (0)
    f32x16 pA0, pA1, pB0, pB1; float mnA, mnB, alA, alB; bf16x8 pa0, pa1, pa2, pa3;
    if constexpr (F32) { VMW(); SWRITE_VF(0); SBAR(); } else { SWRITE_HV(0); SBAR(); }
    if constexpr (F32) { if (NT > 1) SLOAD_F((const float*)Kh, KBASE(1)); } else { SLOAD_HB(Kh, Vh, KBASE(TCL(1))); SLOAD_H(Kh, Vh, KBASE(TCL(2))); }
    SBAR(); qkt<0, SK>(pA0, pA1, K_lds, r32, hi, S.qr, ACT(0), bias_l + KBASE(0));
    if constexpr (F32) { if (NT > 1) { VMW(); SWRITE_KF(1); SBAR(); SLOAD_F((const float*)Vh, KBASE(1)); } }
    bool dA = false, dB = false;
    MASKT(pA0, pA1, 0); partialSM(pA0, pA1, m_reg, mnA, alA, dA);
    if constexpr (F32) { if (NT > 1) { VMW(); SWRITE_VF(1); SBAR(); if (NT > 2) SLOAD_F((const float*)Kh, KBASE(2)); } } else { if (NT > 1) { VMWN(4); SWRITE_HB(1); } }
    __syncthreads();
#define HALF_STEP(PX0, PX1, mnX, alX, dX, PY0, PY1, alY, dY, t, KB, VB, SB) do {                                                      \
        if constexpr (!F32) { if (((t) & 1) != 0) SLOAD_HB(Kh, Vh, KBASE(TCL((t) + 2))); else SLOAD_H(Kh, Vh, KBASE(TCL((t) + 2))); }     \
        SBAR(); qkt<KB, SK>(PX0, PX1, K_lds, r32, hi, S.qr, ACT(t), bias_l + KBASE(t));                                             \
        if (!(dY)) finishSM(PY0, PY1, alY, l_reg, pa0, pa1, pa2, pa3); SBAR();                                                \
        if ((t) + 1 < NT) { if constexpr (F32) { VMW(); SWRITE_KF(SB); SBAR(); SLOAD_F((const float*)Vh, KBASE((t) + 1)); }  \
                            SBAR(); }                                                                                        \
        if (!(dY)) pv_tile<VB, SK>(o, vb0, pa0, pa1, pa2, pa3, ACT((t) - 1)); MASKT(PX0, PX1, (t)); partialSM(PX0, PX1, m_reg, mnX, alX, dX);                                        \
        __syncthreads();                                                                                                      \
        if constexpr (F32) { if ((t) + 1 < NT) { VMW(); SWRITE_VF(SB); SBAR(); if ((t) + 2 < NT) SLOAD_F((const float*)Kh, KBASE((t) + 2)); } } \
        else { if ((t) + 1 < NT) { VMWN(4); if (((t) & 1) != 0) SWRITE_H(SB); else SWRITE_HB(SB); } }     \
        RESC(alX); __syncthreads(); } while (0)
    for (int t = 1; t + 1 < NT; t += 2) {
        HALF_STEP(pB0, pB1, mnB, alB, dB, pA0, pA1, alA, dA, t, 1, 0, 0);
        HALF_STEP(pA0, pA1, mnA, alA, dA, pB0, pB1, alB, dB, t + 1, 0, 1, 1);
    }
    const bool even = (NT & 1) == 0;
    if (even) { SBAR(); qkt<1, SK>(pB0, pB1, K_lds, r32, hi, S.qr, ACT(NT - 1), bias_l + KBASE(NT - 1)); SBAR(); } else { BIAS_DMA(nxt); }
    { const char* gsrc_ = (const char*)(cur.G + (size_t)(wid * QBLK + (lane >> 4)) * RS + (lane & 15) * 8);
      _Pragma("unroll") for (int i_ = 0; i_ < 8; ++i_) __builtin_amdgcn_global_load_lds((const unsigned*)(gsrc_ + (size_t)i_ * 4 * RS * 2), (FX_LASU*)(lds + GATE_OFF + wid * 8192 + i_ * 1024), 16, 0, 0); }
#define QROW(e) (nxt.Q + (size_t)(wid * QBLK + r32) * RS + ((e) >> 1) * 16 + hi * 8 + ((e) & 1) * 4)
    if constexpr (F32) { SLOAD_F((const float*)nxt.K, kbn); SBAR();
#pragma unroll
        for (int e = 0; e < 8; ++e) S.tq[e] = *(const f32x4*)QROW(e); }
    else { SLOAD_H(nxt.K, nxt.V, kbn); SBAR();
#pragma unroll
        for (int d0 = 0; d0 < 8; ++d0) S.qr[d0] = load8<TIn>(nxt.Q + (size_t)(wid * QBLK + r32) * RS + d0 * 16 + hi * 8); }
    SBAR();
    if (!dA) finishSM(pA0, pA1, alA, l_reg, pa0, pa1, pa2, pa3); SBAR();
    if constexpr (F32) {
#pragma unroll
        for (int e = 8; e < 16; ++e) S.tq[e] = *(const f32x4*)QROW(e); SBAR(); }
#undef QROW
    if (!dA) pv_tile<0, SK>(o, vb0, pa0, pa1, pa2, pa3, ACT(even ? NT - 2 : NT - 1));
    if (even) { MASKT(pB0, pB1, NT - 1); partialSM(pB0, pB1, m_reg, mnB, alB, dB); __syncthreads(); BIAS_DMA(nxt); RESC(alB);
        if (!dB) { finishSM(pB0, pB1, alB, l_reg, pa0, pa1, pa2, pa3); SBAR(); pv_tile<1, SK>(o, vb0, pa0, pa1, pa2, pa3, ACT(NT - 1)); } }
    SBAR(); SEAM_K0();
    if (hi == 0) li_l[r32] = l_reg; asm volatile("s_waitcnt lgkmcnt(0)" ::: "memory");
    float rli[16];
#pragma unroll
    for (int r = 0; r < 16; ++r) rli[r] = __builtin_amdgcn_rcpf(li_l[crow(r, hi)]);
    TOut* Owl = cur.O + (size_t)(wid * QBLK + 4 * hi) * OS + r32; const char* gll = lds + GATE_OFF + wid * 8192 + hi * 1024 + r32 * 2;
#pragma unroll
    for (int r = 0; r < 16; ++r) { constexpr int dummy_ = 0; const int rc = (r & 3) + 8 * (r >> 2);
#pragma unroll
        for (int d0 = 0; d0 < 4; ++d0) { const float v = o[d0][r] * rli[r];
            const float vn = mk_xor1(v);
            if ((r32 & 1) == 0) { const unsigned gg = *(const unsigned*)(gll + rc * 256 + d0 * 64);
                const float g0 = __uint_as_float(gg << 16), g1 = __uint_as_float(gg & 0xffff0000u);
                const float s0 = __builtin_amdgcn_rcpf(1.f + __expf(-g0)), s1 = __builtin_amdgcn_rcpf(1.f + __expf(-g1));
                *(__attribute__((address_space(1))) unsigned*)(Owl + (size_t)rc * OS + d0 * 32) = cvtpk(v * s0, vn * s1); } }
        SBAR(); }
    if constexpr (F32) {
#pragma unroll
        for (int d0 = 0; d0 < 8; ++d0) S.qr[d0] = pack8(S.tq[2 * d0], S.tq[2 * d0 + 1]); }
    __syncthreads();
#undef RESC
#undef KBASE
#undef ACT
#undef MASKT
#undef SEAM_K0
#undef HALF_STEP
}
#undef ROW
#undef VMW
#undef VMWN
#undef SLOAD_H
#undef SWRITE_HK
#undef SWRITE_HV
#undef SWRITE_H
#undef SLOAD_HB
#undef SWRITE_HB
#undef TCL
#undef SLOAD_F
#undef SWRITE_KF
#undef SWRITE_VF

}

typedef unsigned short bf16_t;
typedef float f32x4 __attribute__((ext_vector_type(4)));
typedef float f32x16 __attribute__((ext_vector_type(16)));
typedef float f32x2 __attribute__((ext_vector_type(2)));
typedef short bf16x8 __attribute__((ext_vector_type(8)));
typedef short bf16x4 __attribute__((ext_vector_type(4)));
typedef unsigned u32x4 __attribute__((ext_vector_type(4)));
typedef unsigned u32x2 __attribute__((ext_vector_type(2)));
constexpr int DM = 2048, NBATCH = 4, SEQ = 4096, MTOK = NBATCH * SEQ, DFF = 5632;
constexpr float LN_EPS = 1e-5f, RMS_EPS = 1e-5f, DN_ALPHA = 1.6817928305074290f;
constexpr size_t MiB = 1u << 20;
constexpr size_t WS_CTL = 0, CTL_ZERO_BYTES = 1 * MiB;
constexpr size_t WS_MOD = 1 * MiB;
constexpr size_t WS_SK16 = 2 * MiB;
constexpr size_t WS_FB = 3 * MiB;
constexpr size_t WS_ELAST = 4 * MiB;
constexpr size_t WS_ST = 5 * MiB;
constexpr size_t WS_ID = 5 * MiB + 512 * 1024;
constexpr size_t WS_WFOX = 8 * MiB;
constexpr size_t WS_WGLA = 88 * MiB;
constexpr size_t WS_WCONV = 120 * MiB;
constexpr size_t WS_WUP = 152 * MiB;
constexpr size_t WS_WDOWN = 328 * MiB;
constexpr size_t WS_H = 416 * MiB;
constexpr size_t WS_PROJ = 480 * MiB;
constexpr size_t WS_ACT = 832 * MiB;
constexpr size_t WS_QD = 1008 * MiB, WS_KI = 1040 * MiB, WS_KDT = 1072 * MiB, WS_VT = 1104 * MiB;
constexpr size_t WS_OINT = 1168 * MiB;
constexpr size_t WS_QDF = 1296 * MiB;
constexpr size_t WS_N2P = 1328 * MiB;
constexpr size_t WS_XB = 1336 * MiB;
constexpr size_t WS_END = 1400 * MiB;
constexpr int LDS_TOTAL = 163840, MISC_OFF = LDS_TOTAL - 64;
constexpr int CW_BAR = 4096;

__device__ __forceinline__ float bf2f(unsigned short b) { return __uint_as_float(((unsigned)b) << 16); }
__device__ __forceinline__ unsigned pk2(float lo, float hi) { return pg8::cvt_pk_bf16(lo, hi); }
__device__ __forceinline__ unsigned short f2bf(float f) { return (unsigned short)(pk2(f, 0.f) & 0xffffu); }
template <int CTRL> __device__ __forceinline__ float dpp_rot(float v) { return __builtin_bit_cast(float, __builtin_amdgcn_update_dpp(0, __builtin_bit_cast(int, v), CTRL, 0xf, 0xf, false)); }
__device__ __forceinline__ float wave_sum(float v) {
    v += dpp_rot<0x128>(v); v += dpp_rot<0x124>(v); v += dpp_rot<0x122>(v); v += dpp_rot<0x121>(v);
    { auto rr = __builtin_amdgcn_permlane16_swap(__float_as_uint(v), __float_as_uint(v), false, false); v = __uint_as_float(rr[0]) + __uint_as_float(rr[1]); }
    { auto rr = __builtin_amdgcn_permlane32_swap(__float_as_uint(v), __float_as_uint(v), false, false); v = __uint_as_float(rr[0]) + __uint_as_float(rr[1]); }
    return v;
}
__device__ __forceinline__ float log_sigmoid(float x) { return fminf(x, 0.f) - __logf(1.f + __expf(-fabsf(x))); }
__device__ __forceinline__ float silu_f(float x) { return x * __builtin_amdgcn_rcpf(1.f + __expf(-x)); }
__device__ __forceinline__ int crow(int r, int hi) { return (r & 3) + 8 * (r >> 2) + 4 * hi; }
__device__ __forceinline__ void cvt8(const u32x4 w, float (&f)[8]) {
    f[0] = __uint_as_float(w.x << 16); f[1] = __uint_as_float(w.x & 0xffff0000u); f[2] = __uint_as_float(w.y << 16); f[3] = __uint_as_float(w.y & 0xffff0000u);
    f[4] = __uint_as_float(w.z << 16); f[5] = __uint_as_float(w.z & 0xffff0000u); f[6] = __uint_as_float(w.w << 16); f[7] = __uint_as_float(w.w & 0xffff0000u);
}
__device__ __forceinline__ u32x4 pack8f(const float (&f)[8]) { u32x4 w; w.x = pk2(f[0], f[1]); w.y = pk2(f[2], f[3]); w.z = pk2(f[4], f[5]); w.w = pk2(f[6], f[7]); return w; }

#define XB_TMO      128
#define XB_XCNT(j)  (256  + 64 * (j))
#define XB_XSUB(j)  (1280 + 64 * (j))
#define XB_XGEN(j)  (2304 + 64 * (j))
#define XB_TOP      3328
#define XB_TOPGEN   3392
#define XCD_BAR_WORDS 3456
#define XB_SPIN_CAP (1u << 18)
#define LAS __attribute__((address_space(3)))

__device__ __forceinline__ unsigned xb_ld(unsigned* p)              { return __hip_atomic_load(p, __ATOMIC_RELAXED, __HIP_MEMORY_SCOPE_AGENT); }
__device__ __forceinline__ unsigned xb_add(unsigned* p, unsigned v) { return __hip_atomic_fetch_add(p, v, __ATOMIC_RELAXED, __HIP_MEMORY_SCOPE_AGENT); }
__device__ __forceinline__ unsigned xb_xcc_id() { return (unsigned)__builtin_amdgcn_s_getreg((3 << 11) | 20) & 0xFu; }
#define XB_SPIN(cond, bar) do { unsigned _sp = 0; while (cond) { __builtin_amdgcn_s_sleep(1); \
    if ((++_sp & 255u) == 0u) { if (xb_ld(&(bar)[XB_TMO])) break; if (_sp > XB_SPIN_CAP) { atomicAdd(&(bar)[XB_TMO], 1u); break; } } } } while (0)

struct XcdBarrier {
    unsigned* bar; unsigned x;
    volatile LAS unsigned* st;
};

__device__ __forceinline__ XcdBarrier xcd_barrier_post(unsigned* bar, volatile LAS unsigned* st, int xb_tid) {
    XcdBarrier b; b.bar = bar; b.x = xb_xcc_id(); b.st = st;
    if (xb_tid == 0) (void)xb_add(&bar[XB_XCNT(b.x)], 1u);
    return b;
}
__device__ __forceinline__ void xcd_barrier_complete(unsigned* bar, unsigned x, unsigned& nloc, unsigned& nx) {
    const unsigned G = gridDim.x * gridDim.y * gridDim.z;
    unsigned sum, cnt, mine, sp = 0u;
    for (;;) {
        sum = 0u; cnt = 0u; mine = 0u;
#pragma unroll
        for (unsigned j = 0; j < 16; ++j) { const unsigned c = xb_ld(&bar[XB_XCNT(j)]); sum += c; cnt += (c > 0u) ? 1u : 0u; mine = (j == x) ? c : mine; }
        if (sum == G) break;
        __builtin_amdgcn_s_sleep(1);
        if ((++sp & 255u) == 0u) { if (xb_ld(&bar[XB_TMO])) break; if (sp > XB_SPIN_CAP) { atomicAdd(&bar[XB_TMO], 1u); break; } }
    }
    nloc = mine > 0u ? mine : 1u; nx = cnt > 0u ? cnt : 1u;
}

__device__ __forceinline__ void xcd_barrier(const XcdBarrier& b, int xb_tid) {
    asm volatile("s_waitcnt vmcnt(0)" ::: "memory");
    __syncthreads();
    if (xb_tid == 0) {
        unsigned* bar = b.bar;
        __builtin_amdgcn_s_waitcnt(0);
        unsigned nloc = b.st[0], nx = b.st[1];
        if (nloc == 0u) { xcd_barrier_complete(bar, b.x, nloc, nx); b.st[0] = nloc; b.st[1] = nx; }
        const unsigned old = xb_add(&bar[XB_XSUB(b.x)], 1u);
        const unsigned gen = old / nloc;
        if (old + 1u == (gen + 1u) * nloc) {
            __builtin_amdgcn_fence(__ATOMIC_RELEASE, "agent");
            asm volatile("s_waitcnt vmcnt(0)" ::: "memory");
            const unsigned og = xb_add(&bar[XB_TOP], 1u);
            const unsigned tg = og / nx;
            if (og + 1u == (tg + 1u) * nx) xb_add(&bar[XB_TOPGEN], 1u);
            else XB_SPIN(xb_ld(&bar[XB_TOPGEN]) == tg, bar);
            __builtin_amdgcn_fence(__ATOMIC_ACQUIRE, "agent");
            xb_add(&bar[XB_XGEN(b.x)], 1u);
            asm volatile("s_waitcnt vmcnt(0)" ::: "memory");
        } else {
            XB_SPIN(xb_ld(&bar[XB_XGEN(b.x)]) == gen, bar);
            __builtin_amdgcn_fence(__ATOMIC_ACQUIRE, "agent");
            asm volatile("s_waitcnt vmcnt(0)" ::: "memory");
        }
    }
    __syncthreads();
}


#define MK_GRID_VARS int BID = blockIdx.x, NBLK = gridDim.x; asm volatile("" : "+s"(BID), "+s"(NBLK))
#define MK_AS1 __attribute__((address_space(1)))
struct Args { const MK_AS1 float* in[31]; MK_AS1 float* out; MK_AS1 unsigned char* ws; int ph_lo, ph_hi, flags, pad; };

__device__ __forceinline__ void p0_transpose_item(const float* W, int K, int N, bf16_t* WT, int row_off, LAS float* scr, int item, int lane) {
    const int nblk = N / 32, kb = item / nblk, nb = item % nblk, k0 = 64 * kb, n0 = 32 * nb;
    int rbase = row_off + n0; if (row_off < 0) { const int half = n0 >= DFF ? 1 : 0, ch = n0 - half * DFF; rbase = 256 * (ch >> 7) + 128 * half + (ch & 127); }
#pragma unroll 8
    for (int i = 0; i < 32; ++i) { const int kk = 2 * i + (lane >> 5); scr[kk * 33 + (lane & 31)] = W[(size_t)(k0 + kk) * N + n0 + (lane & 31)]; }
    asm volatile("s_waitcnt lgkmcnt(0)" ::: "memory");
    const int c = lane & 7;
#pragma unroll
    for (int j = 0; j < 4; ++j) { const int n = (lane >> 3) + 8 * j; const LAS float* s = scr + (8 * c) * 33 + n;
        u32x4 o; o.x = pk2(s[0 * 33], s[1 * 33]); o.y = pk2(s[2 * 33], s[3 * 33]); o.z = pk2(s[4 * 33], s[5 * 33]); o.w = pk2(s[6 * 33], s[7 * 33]);
        *(u32x4*)(WT + (size_t)(rbase + n) * K + k0 + 8 * c) = o; }
    asm volatile("s_waitcnt lgkmcnt(0)" ::: "memory");
}
typedef const __attribute__((address_space(4))) Args CArgs;
__device__ __forceinline__ void phase_prologue(CArgs* ap, unsigned char* lds, int tid, int wid, int lane) {
    MK_GRID_VARS;
    unsigned char* ws = (unsigned char*)(__attribute__((address_space(1))) unsigned char*)ap->ws;
    for (int t = BID; t < 192; t += NBLK) {
        float* cond = (float*)lds;
        for (int i = tid; i < 4 * DM; i += 512) { const float c = ((const float*)(const __attribute__((address_space(1))) float*)ap->in[1])[i]; cond[i] = c / (1.f + __expf(-c)); }
        __syncthreads();
        const int l = t / 48, col0 = (t % 48) * 256;
        const float* wp = ((const float*)(const __attribute__((address_space(1))) float*)ap->in[2]) + ((size_t)l * DM + wid * 256) * 12288 + col0 + 4 * lane;
        f32x4 acc[4] = {{0.f, 0.f, 0.f, 0.f}, {0.f, 0.f, 0.f, 0.f}, {0.f, 0.f, 0.f, 0.f}, {0.f, 0.f, 0.f, 0.f}};
#pragma unroll 8
        for (int k = 0; k < 256; ++k) { const f32x4 wv = *(const f32x4*)(wp + (size_t)k * 12288); const int kk = wid * 256 + k;
#pragma unroll
            for (int b = 0; b < 4; ++b) acc[b] += cond[b * DM + kk] * wv; }
        float* red = (float*)(lds + 32768);
#pragma unroll
        for (int b = 0; b < 4; ++b) *(f32x4*)(red + ((wid * 4 + b) * 256 + 4 * lane)) = acc[b];
        __syncthreads();
        float* mod = (float*)(ws + WS_MOD);
        for (int idx = tid; idx < 1024; idx += 512) { const int b = idx >> 8, col = idx & 255; float s = ((const float*)(const __attribute__((address_space(1))) float*)ap->in[3])[l * 12288 + col0 + col];
#pragma unroll
            for (int w = 0; w < 8; ++w) s += red[(w * 4 + b) * 256 + col];
            mod[(size_t)(l * 4 + b) * 12288 + col0 + col] = s; }
        __syncthreads();
    }
    LAS float* scr = (LAS float*)((LAS unsigned char*)lds + wid * 16384);
    const int gw = BID * 8 + wid, NGW = NBLK * 8;
    bf16_t* wfox0 = (bf16_t*)(ws + WS_WFOX); bf16_t* wfox1 = (bf16_t*)(ws + WS_WFOX + 40 * MiB);
    bf16_t* wgla = (bf16_t*)(ws + WS_WGLA); bf16_t* wconv = (bf16_t*)(ws + WS_WCONV);
    bf16_t* wup = (bf16_t*)(ws + WS_WUP); bf16_t* wdn = (bf16_t*)(ws + WS_WDOWN);
    constexpr int I_DD = (DM / 64) * (DM / 32), I_DH = (DM / 64) * (1024 / 32), I_D3 = (DM / 64) * (6144 / 32), I_UP = (DM / 64) * (11264 / 32), I_DN = (DFF / 64) * (DM / 32);
    constexpr int NITEMS = 10 * I_DD + 2 * I_DH + 3 * I_DD + I_D3 + I_DD + 4 * I_UP + 4 * I_DN;
    constexpr size_t DD = (size_t)DM * DM;
#define TJOB(SRC, KK, NN, DST, ROFF, CNT) { if (r < (CNT)) { p0_transpose_item((SRC), (KK), (NN), (DST), (ROFF), scr, r, lane); continue; } r -= (CNT); }
    for (int it = gw; it < NITEMS; it += NGW) {
        int r = it;
        TJOB(((const float*)(const __attribute__((address_space(1))) float*)ap->in[8]), DM, DM, wfox0, 0, I_DD) TJOB(((const float*)(const __attribute__((address_space(1))) float*)ap->in[9]), DM, DM, wfox0, 2048, I_DD) TJOB(((const float*)(const __attribute__((address_space(1))) float*)ap->in[10]), DM, DM, wfox0, 4096, I_DD) TJOB(((const float*)(const __attribute__((address_space(1))) float*)ap->in[11]), DM, DM, wfox0, 6144, I_DD)
        TJOB(((const float*)(const __attribute__((address_space(1))) float*)ap->in[14]), DM, DM, wfox0 + (size_t)8192 * DM, 0, I_DD)
        TJOB(((const float*)(const __attribute__((address_space(1))) float*)ap->in[8]) + DD, DM, DM, wfox1, 0, I_DD) TJOB(((const float*)(const __attribute__((address_space(1))) float*)ap->in[9]) + DD, DM, DM, wfox1, 2048, I_DD) TJOB(((const float*)(const __attribute__((address_space(1))) float*)ap->in[10]) + DD, DM, DM, wfox1, 4096, I_DD) TJOB(((const float*)(const __attribute__((address_space(1))) float*)ap->in[11]) + DD, DM, DM, wfox1, 6144, I_DD)
        TJOB(((const float*)(const __attribute__((address_space(1))) float*)ap->in[14]) + DD, DM, DM, wfox1 + (size_t)8192 * DM, 0, I_DD)
        TJOB(((const float*)(const __attribute__((address_space(1))) float*)ap->in[15]), DM, 1024, wgla, 0, I_DH) TJOB(((const float*)(const __attribute__((address_space(1))) float*)ap->in[16]), DM, 1024, wgla, 1024, I_DH) TJOB(((const float*)(const __attribute__((address_space(1))) float*)ap->in[17]), DM, DM, wgla, 2048, I_DD) TJOB(((const float*)(const __attribute__((address_space(1))) float*)ap->in[21]), DM, DM, wgla, 4096, I_DD)
        TJOB(((const float*)(const __attribute__((address_space(1))) float*)ap->in[23]), DM, DM, wgla + (size_t)6144 * DM, 0, I_DD)
        TJOB(((const float*)(const __attribute__((address_space(1))) float*)ap->in[24]), DM, 6144, wconv, 0, I_D3) TJOB(((const float*)(const __attribute__((address_space(1))) float*)ap->in[26]), DM, DM, wconv + (size_t)6144 * DM, 0, I_DD)
        TJOB(((const float*)(const __attribute__((address_space(1))) float*)ap->in[27]), DM, 11264, wup, -1, I_UP) TJOB(((const float*)(const __attribute__((address_space(1))) float*)ap->in[27]) + (size_t)1 * DM * 11264, DM, 11264, wup + (size_t)1 * 11264 * DM, -1, I_UP)
        TJOB(((const float*)(const __attribute__((address_space(1))) float*)ap->in[27]) + (size_t)2 * DM * 11264, DM, 11264, wup + (size_t)2 * 11264 * DM, -1, I_UP) TJOB(((const float*)(const __attribute__((address_space(1))) float*)ap->in[27]) + (size_t)3 * DM * 11264, DM, 11264, wup + (size_t)3 * 11264 * DM, -1, I_UP)
        TJOB(((const float*)(const __attribute__((address_space(1))) float*)ap->in[30]), DFF, DM, wdn, 0, I_DN) TJOB(((const float*)(const __attribute__((address_space(1))) float*)ap->in[30]) + (size_t)1 * DFF * DM, DFF, DM, wdn + (size_t)1 * DM * DFF, 0, I_DN)
        TJOB(((const float*)(const __attribute__((address_space(1))) float*)ap->in[30]) + (size_t)2 * DFF * DM, DFF, DM, wdn + (size_t)2 * DM * DFF, 0, I_DN) TJOB(((const float*)(const __attribute__((address_space(1))) float*)ap->in[30]) + (size_t)3 * DFF * DM, DFF, DM, wdn + (size_t)3 * DM * DFF, 0, I_DN)
    }
#undef TJOB
}

template <bool SRC_BF, bool SK>
__device__ __forceinline__ void phase_lnmod(const void* src, float* X, bf16_t* H, bool do_ln, bool do_mod, const float* lng, const float* lnb,
                                            const float* sc, const float* sh, int sk_mode, const float* skW, const float* skB, float* sk_out, float* stats,
                                            unsigned char* lds, int tid, int wid, int lane) {
    MK_GRID_VARS;
    if constexpr (SK) {
        f32x4* Wl = (f32x4*)lds;
        for (int idx = tid; idx < 8192; idx += 512) { const int ln = idx & 63, q = (idx >> 6) & 3, i = (idx >> 8) & 3, j = idx >> 10;
            Wl[idx] = *(const f32x4*)(skW + (size_t)(256 * j + 4 * ln + i) * 16 + 4 * q); }
        __syncthreads();
    }
    if (stats && BID == 0) for (int i = tid; i < DM; i += 512) { stats[2 * MTOK + i] = DN_ALPHA * (do_ln ? lng[i] : 1.f); stats[2 * MTOK + DM + i] = DN_ALPHA * (do_ln ? lnb[i] : 0.f); }
    const int nw = NBLK * 8, gw = BID * 8 + wid, R = (MTOK + nw - 1) / nw, row_begin = gw * R, row_end = (row_begin + R < MTOK) ? row_begin + R : MTOK;
    if (row_begin < row_end) {
        constexpr bool DIST2 = SRC_BF && !SK;
        f32x4 gs[8], bs[8]; f32x4 vn[8]; u32x2 vbA[8], vbB[8];
#define LN_LOAD_ROW(r, VB) do { if constexpr (SRC_BF) { const u32x2* xr = (const u32x2*)((const bf16_t*)src + (size_t)(r) * DM) + lane; _Pragma("unroll") for (int j = 0; j < 8; ++j) VB[j] = xr[64 * j]; } \
                            else { const f32x4* xr = (const f32x4*)((const float*)src + (size_t)(r) * DM) + lane; _Pragma("unroll") for (int j = 0; j < 8; ++j) vn[j] = xr[64 * j]; } } while (0)
#define LN_ROW(row_, v, VB) do { float s_ = 0.f;                                                                                                                     \
            _Pragma("unroll") for (int j = 0; j < 8; ++j) {                                                                                                      \
                if constexpr (SRC_BF) { v[j][0] = __uint_as_float(VB[j].x << 16); v[j][1] = __uint_as_float(VB[j].x & 0xffff0000u); v[j][2] = __uint_as_float(VB[j].y << 16); v[j][3] = __uint_as_float(VB[j].y & 0xffff0000u); } \
                else v[j] = vn[j];                                                                                                                               \
                s_ += (v[j][0] + v[j][1]) + (v[j][2] + v[j][3]); }                                                                                               \
            if constexpr (DIST2) { if ((row_) + 2 < row_lim) LN_LOAD_ROW((row_) + 2, VB); } else { if ((row_) + 1 < row_lim) LN_LOAD_ROW((row_) + 1, VB); }                                                                                                   \
            float mean_ = 0.f, rstd_ = 1.f;                                                                                                                      \
            if (do_ln) {                                                                                                                                         \
                mean_ = wave_sum(s_) * (1.f / DM); float s2_ = 0.f;                                                                                              \
                _Pragma("unroll") for (int j = 0; j < 8; ++j) { v[j] = v[j] - mean_; s2_ += (v[j][0] * v[j][0] + v[j][1] * v[j][1]) + (v[j][2] * v[j][2] + v[j][3] * v[j][3]); } \
                rstd_ = 1.f / sqrtf(wave_sum(s2_) * (1.f / DM) + LN_EPS);                                                                                        \
                _Pragma("unroll") for (int j = 0; j < 8; ++j) v[j] = (v[j] * rstd_) * gs[j] + bs[j];                                                             \
            } else {                                                                                                                                             \
                _Pragma("unroll") for (int j = 0; j < 8; ++j) v[j] = v[j] * gs[j] + bs[j];                                                                       \
            }                                                                                                                                                    \
            if (stats) { if (lane == 0) { f32x2 st; st[0] = mean_; st[1] = rstd_; *(f32x2*)(stats + (size_t)(row_) * 2) = st; } }                                \
            else { f32x4* xo = (f32x4*)(X + (size_t)(row_) * DM) + lane; _Pragma("unroll") for (int j = 0; j < 8; ++j) xo[64 * j] = v[j]; }                      \
            if (do_mod) { u32x2* ho = (u32x2*)(H + (size_t)(row_) * DM) + lane;                                                                                  \
                _Pragma("unroll") for (int j = 0; j < 8; ++j) { u32x2 w; w.x = pk2(v[j][0], v[j][1]); w.y = pk2(v[j][2], v[j][3]); ho[64 * j] = w; } } } while (0)
        if (!do_mod) {
#pragma unroll
            for (int j = 0; j < 8; ++j) { gs[j] = ((const f32x4*)lng)[64 * j + lane]; bs[j] = ((const f32x4*)lnb)[64 * j + lane]; } }
        for (int seg = row_begin; seg < row_end; ) {
            const int cur_b = seg >> 12, seg_lim = (cur_b + 1) << 12, row_lim = seg_lim < row_end ? seg_lim : row_end;
            if (do_mod) {
                const f32x4* sc4 = (const f32x4*)(sc + (size_t)cur_b * 12288) + lane; const f32x4* sh4 = (const f32x4*)(sh + (size_t)cur_b * 12288) + lane;
#pragma unroll
                for (int j = 0; j < 8; ++j) { const f32x4 s1 = 1.f + sc4[64 * j], s0 = sh4[64 * j];
                    if (do_ln) { gs[j] = ((const f32x4*)lng)[64 * j + lane] * s1; bs[j] = ((const f32x4*)lnb)[64 * j + lane] * s1 + s0; } else { gs[j] = s1; bs[j] = s0; } } }
            LN_LOAD_ROW(seg, vbA);
            if constexpr (DIST2) { if (seg + 1 < row_lim) LN_LOAD_ROW(seg + 1, vbB); }
            if constexpr (!SK) {
                for (int row = seg; row < row_lim; row += 2) { f32x4 v[8]; LN_ROW(row, v, vbA); if (row + 1 < row_lim) { if constexpr (DIST2) { LN_ROW(row + 1, v, vbB); } else { LN_ROW(row + 1, v, vbA); } } }
            } else {
                for (int row = seg; row < row_lim; row += 2) {
                    f32x4 va[8], vc[8];
                    LN_ROW(row, va, vbA);
                    const bool two = row + 1 < row_lim;
                    if (two) { LN_ROW(row + 1, vc, vbA); }
                    else {
#pragma unroll
                        for (int j = 0; j < 8; ++j) vc[j] = va[j]; }
                    const f32x4* Wl = (const f32x4*)lds + lane;
                    f32x2 aa[8], ac[8];
#pragma unroll
                    for (int n = 0; n < 8; ++n) { aa[n][0] = 0.f; aa[n][1] = 0.f; ac[n] = aa[n]; }
#pragma unroll
                    for (int j = 0; j < 8; ++j)
#pragma unroll
                        for (int i = 0; i < 4; ++i) { f32x2 ha, hc; ha[0] = va[j][i]; ha[1] = va[j][i]; hc[0] = vc[j][i]; hc[1] = vc[j][i];
#pragma unroll
                            for (int q = 0; q < 4; ++q) { const f32x4 w = Wl[((j * 4 + i) * 4 + q) * 64]; f32x2 w01, w23; w01[0] = w[0]; w01[1] = w[1]; w23[0] = w[2]; w23[1] = w[3];
                                aa[2 * q] = __builtin_elementwise_fma(ha, w01, aa[2 * q]); aa[2 * q + 1] = __builtin_elementwise_fma(ha, w23, aa[2 * q + 1]);
                                ac[2 * q] = __builtin_elementwise_fma(hc, w01, ac[2 * q]); ac[2 * q + 1] = __builtin_elementwise_fma(hc, w23, ac[2 * q + 1]); }
                            if (i == 3) __builtin_amdgcn_sched_barrier(0); }
                    float mine_a = 0.f, mine_c = 0.f;
#pragma unroll
                    for (int n = 0; n < 16; ++n) { const float ta = wave_sum(aa[n >> 1][n & 1]), tc = wave_sum(ac[n >> 1][n & 1]); mine_a = (lane == n) ? ta : mine_a; mine_c = (lane == n) ? tc : mine_c; }
                    if (lane < 16) { float bias = 0.f; if (sk_mode == 1) { bias = skB[lane]; mine_a = log_sigmoid(mine_a + bias); mine_c = log_sigmoid(mine_c + bias); }
                        if (sk_mode == 1) { float* so = sk_out + ((size_t)((row >> 12) * 16 + lane) << 12) + (row & 4095);
                            so[0] = mine_a; if (two) so[1] = mine_c; }
                        else { sk_out[(size_t)row * 16 + lane] = mine_a; if (two) sk_out[(size_t)(row + 1) * 16 + lane] = mine_c; } }
                }
            }
            seg = row_lim;
        }
#undef LN_ROW
    }
}

#undef LN_LOAD_ROW
__device__ __forceinline__ void fox_cumsum(const float* logf  , float* FB  , int wid, int lane) {
    MK_GRID_VARS;
    for (int u = BID * 8 + wid; u < 64; u += NBLK * 8) {
        const int b = u >> 4, hh = u & 15;
        const float* lf = logf + (size_t)u * SEQ + lane * 64; (void)b; (void)hh;
        float v[64]; float s = 0.f;
#pragma unroll
        for (int t = 0; t < 64; t += 4) { const f32x4 x = *(const f32x4*)(lf + t); v[t] = x[0]; v[t + 1] = x[1]; v[t + 2] = x[2]; v[t + 3] = x[3]; }
#pragma unroll
        for (int t = 0; t < 64; ++t) { s += v[t]; v[t] = s; }
        float pre = s;
#pragma unroll
        for (int o = 1; o < 64; o <<= 1) { const float t = mk_shfl_up(pre, o); if (lane >= o) pre += t; }
        const float excl = pre - s;
        float* out = FB + (size_t)u * SEQ + lane * 64;
#pragma unroll
        for (int t = 0; t < 64; t += 4) { f32x4 o4; o4[0] = -(excl + v[t]) * 11.313708499f; o4[1] = -(excl + v[t + 1]) * 11.313708499f; o4[2] = -(excl + v[t + 2]) * 11.313708499f; o4[3] = -(excl + v[t + 3]) * 11.313708499f;
            *(f32x4*)(out + t) = o4; }
    }
}

constexpr float T_SKIP = 24.f;
__device__ __forceinline__ void phase_fox_attn(const bf16_t* PROJ, const float* FB, const float* N2P, bf16_t* O, char* lds, int tid) {
    MK_GRID_VARS;
    using namespace fx;
    typedef BlockRef<bf16, bf16> Ref;
    const int total = 512, stride = NBLK, lane = tid & 63, wid = __builtin_amdgcn_readfirstlane(tid >> 6);
    float* kmx = (float*)(lds + 2 * SHM_V + 2 * SHM_K);
    float* qmx = kmx + 64;
    int* jlo_l = (int*)(lds + LDS_BYTES);
    int* tab = (int*)(lds + LDS_BYTES + 64);
    const bool use_tab = NBLK == 256;
    if (use_tab) {
        if (wid == 0) {
            const float wv = FB[(size_t)lane * SEQ + SEQ - 1];
            const float Wh = mk_sum_xor32(mk_sum_xor16(wv));
            int rank = 0;
#pragma unroll
            for (int hp = 0; hp < 16; ++hp) { const float o = __uint_as_float(__builtin_amdgcn_readlane(__float_as_uint(Wh), hp)); rank += (o < Wh || (o == Wh && hp < (lane & 15))) ? 1 : 0; }
            const int x = BID & 7;
            const unsigned long long mA = __ballot(rank == x && lane < 16), mB = __ballot(rank == 15 - x && lane < 16);
            const int hA = (int)__builtin_ctzll(mA), hB = (int)__builtin_ctzll(mB);
            const int r = lane & 7, bh = ((lane >> 3) & 3) * 16 + ((lane >> 5) ? hB : hA);
            const float wi = __builtin_bit_cast(float, __builtin_amdgcn_ds_bpermute(bh << 2, __builtin_bit_cast(int, wv)));
            const float Wt = (T_SKIP + 30.f) * (4095.f / 64.f) / (wi * SCALE);
            const float est = fminf(4.f * r, Wt) + fminf(4.f * (15 - r), Wt);
            int rk = 0;
#pragma unroll
            for (int o = 0; o < 64; ++o) { const float e = __uint_as_float(__builtin_amdgcn_readlane(__float_as_uint(est), o)); rk += (e > est || (e == est && o < lane)) ? 1 : 0; }
            const int j = BID >> 3;
            const int i1 = (int)__builtin_ctzll(__ballot(rk == j)), i2 = (int)__builtin_ctzll(__ballot(rk == 63 - j));
            const int t0 = __builtin_amdgcn_readlane(bh, i1), t1 = __builtin_amdgcn_readlane(r, i1), t2 = __builtin_amdgcn_readlane(bh, i2), t3 = __builtin_amdgcn_readlane(r, i2);
            if (lane == 0) { tab[0] = t0; tab[1] = t1; tab[2] = t2; tab[3] = t3; }
        }
        __syncthreads();
    }
    {   int idx = 0;
        for (int Lx = BID; Lx < total; Lx += stride, ++idx) {
            int r, bh;
            if (use_tab) { bh = tab[idx * 2]; r = tab[idx * 2 + 1]; }
            else { const int xcd = Lx & 7, k = Lx >> 3, gi = k >> 3; r = (gi & 4) ? 7 - (k & 7) : (k & 7); bh = (gi * 8 + xcd) ^ ((gi & 4) ? 8 : 0); }
            const f32x4* kn = (const f32x4*)(N2P + ((size_t)(64 + bh) * SEQ) * 4);
            const f32x4* qn = (const f32x4*)(N2P + ((size_t)bh * SEQ) * 4);
            float km = 0.f;
#pragma unroll
            for (int e = 0; e < 8; ++e) { const f32x4 v = kn[tid * 8 + e]; km = fmaxf(km, (v[0] + v[1]) + (v[2] + v[3])); }
            km = fmaxf(km, mk_shfl_xor(km, 1)); km = fmaxf(km, mk_shfl_xor(km, 2)); km = fmaxf(km, mk_shfl_xor(km, 4));
            if ((tid & 7) == 0) kmx[tid >> 3] = km;
            for (int pass = 0; pass < 2; ++pass) {
                const int qb = pass ? 15 - r : r, P0 = qb * QB;
                __syncthreads();
                float qm = 0.f;
                if (tid < 256) { const f32x4 v = qn[P0 + tid]; qm = (v[0] + v[1]) + (v[2] + v[3]); }
#pragma unroll
                for (int o = 1; o < 64; o <<= 1) qm = fmaxf(qm, mk_shfl_xor(qm, o));
                if (lane == 0) qmx[wid] = qm;
                __syncthreads();
                if (wid == 0) {
                    const float Q = sqrtf(fmaxf(fmaxf(qmx[0], qmx[1]), fmaxf(qmx[2], qmx[3])));
                    const int jd = P0 / KVBLK;
                    const float Kd = sqrtf(fmaxf(fmaxf(kmx[jd], kmx[jd + 1]), fmaxf(kmx[jd + 2], kmx[jd + 3])));
                    const float* fb = FB + (size_t)bh * SEQ;
                    const float bound = 1.02f * Q * (sqrtf(kmx[lane]) + Kd) + (fb[lane * KVBLK + KVBLK - 1] - fb[P0]);
                    const bool keep = lane < jd && !(bound < -T_SKIP / SCALE);
                    const unsigned long long mask = __ballot(keep);
                    const int jlo = mask ? (int)__builtin_ctzll(mask) : jd;
                    if (lane == 0) jlo_l[idx * 2 + pass] = jlo;
                }
            }
            __syncthreads();
        }
    }
    int L = BID;
    if (L < total) {
        auto mkref = [&](int Lx, int pass, int slot) -> Ref {
            int r, bh;
            if (use_tab) { bh = __builtin_amdgcn_readfirstlane(tab[slot * 2]); r = __builtin_amdgcn_readfirstlane(tab[slot * 2 + 1]); }
            else { const int xcd = Lx & 7, k = Lx >> 3, gi = k >> 3; r = (gi & 4) ? 7 - (k & 7) : (k & 7); bh = (gi * 8 + xcd) ^ ((gi & 4) ? 8 : 0); }
            const int qb = pass ? 15 - r : r;
            const int b = bh >> 4, h = bh & 15; const size_t row0 = (size_t)b * SEQ + (size_t)qb * QB;
            Ref rf; const bf16* P = (const bf16*)PROJ; const size_t TS = (size_t)64 * SEQ * D, hb = (size_t)bh * SEQ * D;
            rf.Q = P + hb + (size_t)qb * QB * D; rf.K = P + TS + hb; rf.V = P + 2 * TS + hb; rf.G = P + 3 * TS + hb + (size_t)qb * QB * D;
            rf.O = (bf16*)O + row0 * OS + h * D; rf.Bias = FB + (size_t)bh * SEQ; rf.P0 = qb * QB; rf.JLO = __builtin_amdgcn_readfirstlane(jlo_l[slot * 2 + pass]); return rf; };
        int pass = 0, slot = 0; Ref cur = mkref(L, 0, 0);
        Seam<bf16> S;
        causal_swa_prime<bf16, bf16>(cur, SEQ, lds, S, tid);
        for (;;) {
            const bool more_pass = pass == 0, more_item = L + stride < total, last = !more_pass && !more_item;
            int passn = pass + 1, Ln = L, slotn = slot;
            if (!more_pass) { passn = 0; Ln = more_item ? L + stride : L; slotn = more_item ? slot + 1 : slot; }
            const Ref nxt = last ? cur : mkref(Ln, passn, slotn);
            causal_swa_block<bf16, bf16>(cur, nxt, SEQ, SEQ, lds, S, tid);
            if (last) break;
            cur = nxt; pass = passn; L = Ln; slot = slotn;
        }
    }
}

__device__ __forceinline__ void phase_gla_prep(const bf16_t* PROJ, const float* A1, const float* wa2, const float* ba, bf16_t* QD, bf16_t* QDF, bf16_t* KI, bf16_t* KDT, bf16_t* VT, float* ELAST,
                                               unsigned char* lds, int tid) {
    MK_GRID_VARS;
    float* a1l = (float*)lds;
    for (int u = BID; u < 512; u += NBLK) {
        const int b = u >> 7, n = (u >> 1) & 63, p = u & 1; const size_t row0 = (size_t)b * SEQ + n * 64;
        __syncthreads();
        for (int i = tid; i < 1024; i += 512) a1l[i] = A1[row0 * 16 + i];
        __syncthreads();
        { const int hh = 2 * p + (tid >> 8), d = tid & 255, col = hh * 256 + d, bh = b * 4 + hh;
          float w2[16];
#pragma unroll
          for (int r = 0; r < 16; ++r) w2[r] = wa2[r * 1024 + col];
          const float bav = ba[col];
          const bf16_t* qp = PROJ + row0 * 6144 + col; const bf16_t* kp = qp + 1024;
          bf16_t* qdp = QD + row0 * 1024 + col; bf16_t* kip = KI + row0 * 1024 + col;
          bf16_t* qfp; { const int dkl = d & 31, x = dkl & 15; qfp = QDF + ((((((size_t)bh * 64 + n) * 8 + (d >> 5)) * 2) * 2 + (dkl >> 4)) * 64 + ((x >> 2) & 1) * 32) * 8 + 4 * (x >> 3) + (x & 3); }
          float kif[64]; float cb = 0.f;
#pragma unroll
          for (int jj = 0; jj < 64; ++jj) {
              const f32x4* ar = (const f32x4*)(a1l + jj * 16); float ga = bav;
#pragma unroll
              for (int q = 0; q < 4; ++q) { const f32x4 av = ar[q]; ga += av[0] * w2[4 * q] + av[1] * w2[4 * q + 1] + av[2] * w2[4 * q + 2] + av[3] * w2[4 * q + 3]; }
              cb += log_sigmoid(ga) * 0.0625f;
              const float qv = bf2f(qp[(size_t)jj * 6144]) * 0.0625f, kv = bf2f(kp[(size_t)jj * 6144]);
              const float e = __expf(cb), ei = __expf(-cb), kin = kv * ei;
              const unsigned short qb = f2bf(qv * e); qdp[(size_t)jj * 1024] = qb; qfp[((jj >> 5) * 128 + (jj & 31)) * 8] = qb; kip[(size_t)jj * 1024] = f2bf(kin); kif[jj] = kin;
          }
          const float el = __expf(cb);
          ELAST[((size_t)bh * 64 + n) * 256 + d] = el;
          u32x4* kd = (u32x4*)KDT + ((((size_t)bh * 64 + n) * 8 + (d >> 5)) * 4) * 64 + (d & 31);
#pragma unroll
          for (int g = 0; g < 8; ++g) { u32x4 w; w.x = pk2(kif[8 * g] * el, kif[8 * g + 1] * el); w.y = pk2(kif[8 * g + 2] * el, kif[8 * g + 3] * el);
              w.z = pk2(kif[8 * g + 4] * el, kif[8 * g + 5] * el); w.w = pk2(kif[8 * g + 6] * el, kif[8 * g + 7] * el); kd[(g >> 1) * 64 + (g & 1) * 32] = w; } }
        { const int c2 = 2 * tid, hh = 2 * p + (c2 >> 9), dv = c2 & 511, bh = b * 4 + hh;
          const unsigned* vp = (const unsigned*)(PROJ + row0 * 6144 + 2048 + hh * 512 + dv);
          unsigned vv[64];
#pragma unroll
          for (int jj = 0; jj < 64; ++jj) vv[jj] = vp[(size_t)jj * 3072];
          u32x4* vt0 = (u32x4*)VT + ((((size_t)bh * 64 + n) * 16 + (dv >> 5)) * 4) * 64 + (dv & 31); u32x4* vt1 = vt0 + 1;
#pragma unroll
          for (int g = 0; g < 8; ++g) { u32x4 lo, hi;
              lo.x = (vv[8 * g] & 0xffffu) | (vv[8 * g + 1] << 16); lo.y = (vv[8 * g + 2] & 0xffffu) | (vv[8 * g + 3] << 16); lo.z = (vv[8 * g + 4] & 0xffffu) | (vv[8 * g + 5] << 16); lo.w = (vv[8 * g + 6] & 0xffffu) | (vv[8 * g + 7] << 16);
              hi.x = (vv[8 * g] >> 16) | (vv[8 * g + 1] & 0xffff0000u); hi.y = (vv[8 * g + 2] >> 16) | (vv[8 * g + 3] & 0xffff0000u); hi.z = (vv[8 * g + 4] >> 16) | (vv[8 * g + 5] & 0xffff0000u); hi.w = (vv[8 * g + 6] >> 16) | (vv[8 * g + 7] & 0xffff0000u);
              vt0[(g >> 1) * 64 + (g & 1) * 32] = lo; vt1[(g >> 1) * 64 + (g & 1) * 32] = hi; } }
    }
}
struct ScanOps { bf16x8 qa[2][2], ka[4], vb[4]; f32x4 ev[4]; };
__device__ __forceinline__ void scan_load(ScanOps& o, const char* qd_u, const char* kdt_u, const char* vt_u, const char* el_u, unsigned qoff, unsigned koff, unsigned eoff) {
#pragma unroll
    for (int mb = 0; mb < 2; ++mb)
#pragma unroll
        for (int ks = 0; ks < 2; ++ks) o.qa[mb][ks] = *(const bf16x8*)(qd_u + (mb * 2 + ks) * 1024 + qoff);
#pragma unroll
    for (int ks = 0; ks < 4; ++ks) { o.ka[ks] = *(const bf16x8*)(kdt_u + ks * 1024 + koff); o.vb[ks] = *(const bf16x8*)(vt_u + ks * 1024 + koff); }
#pragma unroll
    for (int g = 0; g < 4; ++g) o.ev[g] = *(const f32x4*)(el_u + g * 32 + eoff);
}
__device__ __forceinline__ void phase_gla_scan(const bf16_t* QDF, const bf16_t* KDT, const bf16_t* VT, const float* ELAST, bf16_t* OINT, unsigned char* lds, int tid, int wid, int lane) {
    MK_GRID_VARS;
    const int l32 = lane & 31, hi = lane >> 5;
    float* buf = (float*)lds;
    for (int u = BID; u < 256; u += NBLK) {
        const int xcd = u & 7, kk = u >> 3, bh = xcd * 2 + (kk >> 4), s = kk & 15, b = bh >> 2, hh = bh & 3;
        f32x16 S;
#pragma unroll
        for (int r = 0; r < 16; ++r) S[r] = 0.f;
        const char* qd_u0 = (const char*)((const u32x4*)QDF + ((((size_t)bh * 64 * 8 + wid) * 2) * 2) * 64);
        const char* kdt_u0 = (const char*)((const u32x4*)KDT + (((size_t)bh * 64 * 8 + wid) * 4) * 64);
        const char* vt_u0 = (const char*)((const u32x4*)VT + (((size_t)bh * 64 * 16 + s) * 4) * 64);
        const char* el_u0 = (const char*)(ELAST + (size_t)bh * 64 * 256 + 32 * wid);
        const unsigned koff = (unsigned)lane * 16u, qoff = koff, eoff = (unsigned)(4 * hi) * 4u;
#define SCAN_LOAD(c, n_) scan_load((c), qd_u0 + (size_t)(n_) * 8 * 4096, kdt_u0 + (size_t)(n_) * 256 * 64 * 2, vt_u0 + (size_t)(n_) * 512 * 64 * 2, el_u0 + (size_t)(n_) * 256 * 4, qoff, koff, eoff)
#define SCAN_STEP(c, n_) do { bf16x8 sb[2];                                                                                                                   \
            _Pragma("unroll") for (int ks = 0; ks < 2; ++ks) { u32x4 w; w.x = pk2(S[8 * ks], S[8 * ks + 1]); w.y = pk2(S[8 * ks + 2], S[8 * ks + 3]); w.z = pk2(S[8 * ks + 4], S[8 * ks + 5]); w.w = pk2(S[8 * ks + 6], S[8 * ks + 7]); \
                sb[ks] = *reinterpret_cast<bf16x8*>(&w); }                                                                                                     \
            f32x16 op[2];                                                                                                                                      \
            _Pragma("unroll") for (int mb = 0; mb < 2; ++mb) {                                                                                                 \
                _Pragma("unroll") for (int r = 0; r < 16; ++r) op[mb][r] = 0.f;                                                                                \
                _Pragma("unroll") for (int ks = 0; ks < 2; ++ks) op[mb] = __builtin_amdgcn_mfma_f32_32x32x16_bf16((c).qa[mb][ks], sb[ks], op[mb], 0, 0, 0); }  \
            _Pragma("unroll") for (int r = 0; r < 16; ++r) S[r] *= (c).ev[r >> 2][r & 3];                                                                      \
            _Pragma("unroll") for (int ks = 0; ks < 4; ++ks) S = __builtin_amdgcn_mfma_f32_32x32x16_bf16((c).ka[ks], (c).vb[ks], S, 0, 0, 0);                   \
            asm volatile("" : "+v"(S), "+v"(op[0]), "+v"(op[1]));     \
            __builtin_amdgcn_sched_barrier(0); SCAN_LOAD((c), (n_) + 2 < 64 ? (n_) + 2 : 63); __builtin_amdgcn_sched_barrier(0);                                                                 \
            float* pb = buf + ((size_t)((n_) & 1) * 8 + wid) * 2048 + (4 * hi) * 32 + l32;     \
            float* pbe = pb + hi * 32; float* pbo = pb - hi * 32;                                                                                              \
            _Pragma("unroll") for (int mb = 0; mb < 2; ++mb)                                                                                                   \
                _Pragma("unroll") for (int r = 0; r < 16; ++r) ((r & 1) ? pbo : pbe)[(32 * mb + (r & 3) + 8 * (r >> 2)) * 32] = op[mb][r];                     \
            asm volatile("s_waitcnt lgkmcnt(0)" ::: "memory"); __builtin_amdgcn_s_barrier(); asm volatile("" ::: "memory");     \
            { const int tok = tid >> 3, dv = (tid & 7) * 4;                                                                                                    \
              const float* rb = buf + (size_t)((n_) & 1) * 8 * 2048 + (tok ^ ((tok >> 2) & 1)) * 32 + dv; f32x4 acc = *(const f32x4*)rb;                       \
              _Pragma("unroll") for (int w = 1; w < 8; ++w) acc += *(const f32x4*)(rb + w * 2048);                                                             \
              u32x2 ow; ow.x = pk2(acc[0], acc[1]); ow.y = pk2(acc[2], acc[3]);                                                                                      \
              *(u32x2*)(OINT + ((size_t)b * SEQ + (n_) * 64 + tok) * DM + hh * 512 + 32 * s + dv) = ow; } } while (0)
        ScanOps oa, ob; SCAN_LOAD(oa, 0); SCAN_LOAD(ob, 1);
        for (int n = 0; n < 64; n += 2) { SCAN_STEP(oa, n); SCAN_STEP(ob, n + 1); }
#undef SCAN_STEP
#undef SCAN_LOAD
        __syncthreads();
    }
}
#define MK_LASU __attribute__((address_space(3))) unsigned
__device__ __forceinline__ void phase_gla_intra(const bf16_t* PROJ, const bf16_t* QD, const bf16_t* KI, const bf16_t* VT, const bf16_t* OINT, const float* normg, bf16_t* OG,
                                                unsigned char* lds, int tid, int wid, int lane) {
    MK_GRID_VARS;
    bf16_t* attl = (bf16_t*)lds;
    float* rss = (float*)(lds + 64 * 72 * 2);
    float* rstdl = rss + 8 * 64;
    constexpr int RG_OFF = 16384;
    const int l16 = lane & 15, q4 = lane >> 4, l32 = lane & 31, hi = lane >> 5;
    for (int u = BID; u < 1024; u += NBLK) {
        const int b = u >> 8, n = (u >> 2) & 63, hh = u & 3, bh = b * 4 + hh; const size_t row0 = (size_t)b * SEQ + n * 64;
        { const char* src = (const char*)(PROJ + (row0 + wid) * 6144 + 4096 + hh * 512 + lane * 8);
#pragma unroll
          for (int i = 0; i < 8; ++i) __builtin_amdgcn_global_load_lds((const unsigned*)(src + (size_t)i * 8 * 6144 * 2), (MK_LASU*)(lds + RG_OFF + (i * 512 + wid * 64) * 16), 16, 0, 0); }
        f32x16 acc[2][2];
        { const bf16_t* oil = OINT + (row0 + 4 * hi) * DM + hh * 512 + 64 * wid + l32;
#pragma unroll
          for (int mb = 0; mb < 2; ++mb)
#pragma unroll
              for (int nb = 0; nb < 2; ++nb)
#pragma unroll
                  for (int r = 0; r < 16; ++r) acc[mb][nb][r] = bf2f(oil[(size_t)(32 * mb + (r & 3) + 8 * (r >> 2)) * DM + 32 * nb]); }
        bf16x8 vb0[4], vb1[4];
        { const bf16x8* vtp = (const bf16x8*)VT + ((((size_t)bh * 64 + n) * 16 + 2 * wid) * 4) * 64 + lane;
#pragma unroll
          for (int ks = 0; ks < 4; ++ks) { vb0[ks] = vtp[ks * 64]; vb1[ks] = vtp[(4 + ks) * 64]; } }
        const int ti = wid >> 1;
#pragma unroll
        for (int t2 = 0; t2 < 2; ++t2) { const int tj = 2 * (wid & 1) + t2;
            f32x4 c = {0.f, 0.f, 0.f, 0.f};
            if (tj <= ti) {
                const bf16_t* ap = QD + (row0 + 16 * ti + l16) * 1024 + hh * 256 + 8 * q4;
                const bf16_t* bp = KI + (row0 + 16 * tj + l16) * 1024 + hh * 256 + 8 * q4;
#pragma unroll
                for (int st = 0; st < 8; ++st) c = __builtin_amdgcn_mfma_f32_16x16x32_bf16(*(const bf16x8*)(ap + 32 * st), *(const bf16x8*)(bp + 32 * st), c, 0, 0, 0);
            }
#pragma unroll
            for (int r = 0; r < 4; ++r) { const int i = 16 * ti + 4 * q4 + r, jx = 16 * tj + l16; attl[i * 72 + jx] = f2bf(jx <= i ? c[r] : 0.f); } }
        __syncthreads();
#pragma unroll
        for (int ks = 0; ks < 4; ++ks) {
            const bf16x8 a0 = *(const bf16x8*)(attl + l32 * 72 + 16 * ks + 8 * hi), a1 = *(const bf16x8*)(attl + (32 + l32) * 72 + 16 * ks + 8 * hi);
            const bf16x8 b0 = vb0[ks], b1 = vb1[ks];
            acc[0][0] = __builtin_amdgcn_mfma_f32_32x32x16_bf16(a0, b0, acc[0][0], 0, 0, 0); acc[0][1] = __builtin_amdgcn_mfma_f32_32x32x16_bf16(a0, b1, acc[0][1], 0, 0, 0);
            acc[1][0] = __builtin_amdgcn_mfma_f32_32x32x16_bf16(a1, b0, acc[1][0], 0, 0, 0); acc[1][1] = __builtin_amdgcn_mfma_f32_32x32x16_bf16(a1, b1, acc[1][1], 0, 0, 0); }
        float* rssl = rss + wid * 64 + 4 * hi;
#pragma unroll
        for (int mb = 0; mb < 2; ++mb)
#pragma unroll
            for (int r = 0; r < 16; ++r) { const float x0 = acc[mb][0][r], x1 = acc[mb][1][r]; float ss = x0 * x0 + x1 * x1;
                ss += __builtin_bit_cast(float, __builtin_amdgcn_update_dpp(0, __builtin_bit_cast(int, ss), 0x128, 0xf, 0xf, false));
                ss += __builtin_bit_cast(float, __builtin_amdgcn_update_dpp(0, __builtin_bit_cast(int, ss), 0x124, 0xf, 0xf, false));
                ss += __builtin_bit_cast(float, __builtin_amdgcn_update_dpp(0, __builtin_bit_cast(int, ss), 0x122, 0xf, 0xf, false));
                ss += __builtin_bit_cast(float, __builtin_amdgcn_update_dpp(0, __builtin_bit_cast(int, ss), 0x121, 0xf, 0xf, false));
                ss = mk_sum_xor16(ss);
                if (l32 == 0) rssl[32 * mb + (r & 3) + 8 * (r >> 2)] = ss; }
        asm volatile("s_waitcnt vmcnt(0)" ::: "memory");
        __syncthreads();
        if (tid < 64) { float tot = 0.f;
#pragma unroll
            for (int w = 0; w < 8; ++w) tot += rss[w * 64 + tid];
            rstdl[tid] = 1.f / sqrtf(tot * (1.f / 512.f) + RMS_EPS); }
        __syncthreads();
        const float g0 = normg[64 * wid + l32], g1 = normg[64 * wid + 32 + l32];
        const bf16_t* rgl = (const bf16_t*)(lds + RG_OFF) + (4 * hi) * 512 + 64 * wid + l32;
        const float* rsr = rstdl + 4 * hi;
        bf16_t* ogl = OG + (row0 + 4 * hi) * DM + hh * 512 + 64 * wid + l32;
#pragma unroll
        for (int mb = 0; mb < 2; ++mb)
#pragma unroll
            for (int r = 0; r < 16; ++r) { const int rc = 32 * mb + (r & 3) + 8 * (r >> 2);
                const float rstd = rsr[rc];
                const float r0 = bf2f(rgl[rc * 512]), r1 = bf2f(rgl[rc * 512 + 32]);
                ogl[(size_t)rc * DM] = f2bf(acc[mb][0][r] * rstd * g0 * silu_f(r0)); ogl[(size_t)rc * DM + 32] = f2bf(acc[mb][1][r] * rstd * g1 * silu_f(r1)); }
        __syncthreads();
    }
}

__device__ __forceinline__ void phase_conv_core(const bf16_t* PROJ, const float* cw  , bf16_t* OG, int tid) {
    MK_GRID_VARS;
    for (int u = BID; u < MTOK / 64; u += NBLK) {
        const int cg = tid & 255, c0 = 8 * cg, row_start = u * 64 + 32 * (tid >> 8);
        float w[3][8];
#pragma unroll
        for (int k = 0; k < 3; ++k) { const f32x4 a = *(const f32x4*)(cw + k * DM + c0), b = *(const f32x4*)(cw + k * DM + c0 + 4);
#pragma unroll
            for (int e = 0; e < 4; ++e) { w[k][e] = a[e]; w[k][4 + e] = b[e]; } }
        float p2[8], p1[8];
#pragma unroll
        for (int e = 0; e < 8; ++e) { p2[e] = 0.f; p1[e] = 0.f; }
        if ((row_start & (SEQ - 1)) != 0) {
            float c[8], uu[8];
            cvt8(*(const u32x4*)(PROJ + (size_t)(row_start - 2) * 6144 + 2048 + c0), c); cvt8(*(const u32x4*)(PROJ + (size_t)(row_start - 2) * 6144 + 4096 + c0), uu);
#pragma unroll
            for (int e = 0; e < 8; ++e) p2[e] = c[e] * uu[e];
            cvt8(*(const u32x4*)(PROJ + (size_t)(row_start - 1) * 6144 + 2048 + c0), c); cvt8(*(const u32x4*)(PROJ + (size_t)(row_start - 1) * 6144 + 4096 + c0), uu);
#pragma unroll
            for (int e = 0; e < 8; ++e) p1[e] = c[e] * uu[e];
        }
#pragma unroll 4
        for (int r = 0; r < 32; ++r) { const size_t row = (size_t)(row_start + r);
            float gb[8], c[8], uu[8], y[8];
            cvt8(*(const u32x4*)(PROJ + row * 6144 + c0), gb); cvt8(*(const u32x4*)(PROJ + row * 6144 + 2048 + c0), c); cvt8(*(const u32x4*)(PROJ + row * 6144 + 4096 + c0), uu);
#pragma unroll
            for (int e = 0; e < 8; ++e) { const float cu = c[e] * uu[e]; y[e] = gb[e] * (w[0][e] * p2[e] + w[1][e] * p1[e] + w[2][e] * cu); p2[e] = p1[e]; p1[e] = cu; }
            *(u32x4*)(OG + row * DM + c0) = pack8f(y); }
    }
}
__device__ __forceinline__ void phase_ffn_fix(const float* ZH, const float* cw  , const float* cb  , bf16_t* ACT, int tid) {
    MK_GRID_VARS;
    constexpr int NCG = DFF / 8, NIT = (MTOK / 64) * 2 * NCG;
    for (int it = BID * 512 + tid; it < NIT; it += NBLK * 512) {
        const int cg = it % NCG, r = (it / NCG) & 1, blk = it / (2 * NCG), c0 = 8 * cg;
        const bool first = (blk & 63) == 0;
        const float* zb = ZH + (size_t)blk * 4 * 2 * 5632 + c0;
        float y[8];
#pragma unroll
        for (int hq = 0; hq < 2; ++hq) {
            f32x4 za[3], zu[3];
#pragma unroll
            for (int k = 0; k < 3; ++k) { const int s = r + k;
                const bool zero = first && s < 2;
                za[k] = zero ? (f32x4){0.f, 0.f, 0.f, 0.f} : *(const f32x4*)(zb + (size_t)(s * 2) * 5632 + 4 * hq);
                zu[k] = zero ? (f32x4){0.f, 0.f, 0.f, 0.f} : *(const f32x4*)(zb + (size_t)(s * 2 + 1) * 5632 + 4 * hq); }
            f32x4 ya = *(const f32x4*)(cb + c0 + 4 * hq), yu = *(const f32x4*)(cb + DFF + c0 + 4 * hq);
#pragma unroll
            for (int k = 0; k < 3; ++k) { ya += *(const f32x4*)(cw + k * 11264 + c0 + 4 * hq) * za[k]; yu += *(const f32x4*)(cw + k * 11264 + DFF + c0 + 4 * hq) * zu[k]; }
#pragma unroll
            for (int e = 0; e < 4; ++e) y[4 * hq + e] = silu_f(ya[e]) * yu[e]; }
        *(u32x4*)(ACT + (size_t)(blk * 64 + r) * DFF + c0) = pack8f(y);
    }
}

constexpr int PH_FINAL = 65, PH_END = 66;
#ifndef MK_DUP
#define MK_DUP 0
#endif
constexpr size_t WS_XD = WS_END, WS_HD = WS_END + 64 * MiB, WS_SKD = WS_END + 128 * MiB, WS_STD = WS_END + 130 * MiB;
__global__ void __launch_bounds__(512, 2) mk_fwd(Args args_) {
    extern __shared__ __attribute__((aligned(16))) unsigned char lds[];
    const int tid0 = threadIdx.x, wid0 = __builtin_amdgcn_readfirstlane(tid0 >> 6);
    const __attribute__((address_space(4))) Args* argp = (const __attribute__((address_space(4))) Args*)__builtin_amdgcn_kernarg_segment_ptr();
    asm volatile("" : "+s"(argp));
#define args (*argp)
    MK_AS1 unsigned char* ws = args.ws;
    const int lo = args.ph_lo, hi = args.ph_hi, dummy = args.flags;
    volatile LAS unsigned* MISC = (volatile LAS unsigned*)((LAS unsigned char*)lds + MISC_OFF);
    if (tid0 < 16) MISC[tid0] = 0u;
    __syncthreads();
    XcdBarrier bar; bar.bar = (unsigned*)(ws + WS_CTL) + CW_BAR; bar.x = 0; bar.st = nullptr;
    if (hi - lo > 1) bar = xcd_barrier_post((unsigned*)(ws + WS_CTL) + CW_BAR, MISC, tid0);
#define IN(k) (lo <= (k) && (k) < hi)
#define SEAM(k) do { if ((k) + 1 < hi) { XcdBarrier b_ = bar; asm volatile("" : "+s"(b_.bar), "+s"(b_.x)); xcd_barrier(b_, wid0 * 64 + mk_lane()); } } while (0)
#define AIN(k) ((const float*)args.in[k])
#define LOCALS() MK_AS1 unsigned char* w = ws; asm volatile("" : "+s"(w)); int wid_ = wid0; asm volatile("" : "+s"(wid_)); int lane_; asm volatile("v_mbcnt_lo_u32_b32 %0, -1, 0\n\tv_mbcnt_hi_u32_b32 %0, -1, %0" : "=&v"(lane_)); const int wid = wid_, lane = lane_, tid = wid * 64 + lane; (void)lane; (void)wid; (void)tid; int BID = blockIdx.x, NBLK = gridDim.x; asm volatile("" : "+s"(BID), "+s"(NBLK)); bf16_t* XB = (bf16_t*)(w + WS_XB); float* MOD = (float*)(w + WS_MOD); float* SK16 = (float*)(w + WS_SK16); float* FB = (float*)(w + WS_FB); float* ELAST = (float*)(w + WS_ELAST); \
    bf16_t* H = (bf16_t*)(w + WS_H); bf16_t* PROJ = (bf16_t*)(w + WS_PROJ); bf16_t* ACT = (bf16_t*)(w + WS_ACT); \
    bf16_t* QD = (bf16_t*)(w + WS_QD); bf16_t* KI = (bf16_t*)(w + WS_KI); bf16_t* KDT = (bf16_t*)(w + WS_KDT); bf16_t* VT = (bf16_t*)(w + WS_VT); bf16_t* OINT = (bf16_t*)(w + WS_OINT); bf16_t* QDF = (bf16_t*)(w + WS_QDF); (void)QDF; \
    (void)XB; (void)MOD; (void)SK16; (void)FB; (void)ELAST; (void)H; (void)PROJ; (void)ACT; (void)QD; (void)KI; (void)KDT; (void)VT; (void)OINT

    if (IN(0)) { LOCALS(); phase_prologue(argp, lds, tid, wid, lane); SEAM(0); }

    if (IN(1)) {
        LOCALS(); const float* modl = MOD;
        const int rep = dummy;
        phase_lnmod<false, true>(AIN(0), nullptr, rep ? (bf16_t*)(w + WS_HD) : H, false, true, AIN(6), AIN(7), modl + 2048, modl, 1, AIN(12), AIN(13), rep ? (float*)(w + WS_SKD) : SK16, (float*)(w + (rep ? WS_STD : WS_ST)), lds, tid, wid, lane);
        SEAM(1);
    }

    for (int sub = 0; sub < 8; ++sub) {
        const int layer = sub >> 1, is_ffn = sub & 1, kind = is_ffn ? 3 : layer % 3, j = layer / 3, base = 1 + 8 * sub;
        if (sub != 0 && IN(base + 0)) {
            LOCALS(); const float* modl = MOD + (size_t)layer * 4 * 12288;
            const float* lng = is_ffn ? AIN(4) + layer * DM : AIN(6) + (layer - 1) * DM;
            const float* lnb = is_ffn ? AIN(5) + layer * DM : AIN(7) + (layer - 1) * DM;
            const float* sc = modl + (is_ffn ? 8192 : 2048); const float* sh = modl + (is_ffn ? 6144 : 0);
            const int sk = kind == 0 ? 1 : (kind == 1 ? 2 : 0);
            const float* skW = kind == 0 ? AIN(12) + (size_t)j * DM * 16 : AIN(18); const float* skB = AIN(13) + j * 16;
            const int rep = dummy;
            if (sk) phase_lnmod<true, true>(XB, nullptr, rep ? (bf16_t*)(w + WS_HD) : H, true, true, lng, lnb, sc, sh, sk, skW, skB, rep ? (float*)(w + WS_SKD) : SK16, (float*)(w + (rep ? WS_STD : WS_ST)), lds, tid, wid, lane);
            else phase_lnmod<true, false>(XB, nullptr, rep ? (bf16_t*)(w + WS_HD) : H, true, true, lng, lnb, sc, sh, 0, skW, skB, rep ? (float*)(w + WS_SKD) : SK16, (float*)(w + (rep ? WS_STD : WS_ST)), lds, tid, wid, lane);
            SEAM(base + 0);
        }
        if (IN(base + 1)) {
            LOCALS();
            const bf16_t* Bt; int N;
            if (kind == 0) { Bt = (const bf16_t*)(w + WS_WFOX + (size_t)j * 40 * MiB); N = 8192; fox_cumsum(SK16, FB, wid, lane); }
            else if (kind == 1) { Bt = (const bf16_t*)(w + WS_WGLA); N = 6144; }
            else if (kind == 2) { Bt = (const bf16_t*)(w + WS_WCONV); N = 6144; }
            else { Bt = (const bf16_t*)(w + WS_WUP) + (size_t)layer * 11264 * DM; N = 11264; }
            pg8::Gemm g{H, Bt, MTOK, N, DM}; pg8::StaticOrder S; S.init(MTOK, N, NBLK, BID);
            if (kind == 3) { pg8::EpiFfn E{ACT, (float*)PROJ, AIN(28) + (size_t)layer * 3 * 11264, AIN(29) + (size_t)layer * 11264};
                pg8::gemm_phase<pg8::EpiFfn, pg8::StaticOrder, true, true>((LAS unsigned char*)lds, g, S, E, tid); }
            else { pg8::EpiStore E{PROJ, N, kind == 0 ? 1 : 0, (float*)(w + WS_N2P)};
                pg8::gemm_phase<pg8::EpiStore, pg8::StaticOrder, true, true>((LAS unsigned char*)lds, g, S, E, tid); }
            SEAM(base + 1);
        }
        if (kind == 0) {
            if (IN(base + 2)) { LOCALS(); phase_fox_attn(PROJ, FB, (const float*)(w + WS_N2P), ACT, (char*)lds, tid); SEAM(base + 2); }
        } else if (kind == 1) {
            if (IN(base + 2)) { LOCALS(); phase_gla_prep(PROJ, SK16, AIN(19), AIN(20), QD, QDF, KI, KDT, VT, ELAST, lds, tid); SEAM(base + 2); }
            if (IN(base + 3)) { LOCALS(); phase_gla_scan(QDF, KDT, VT, ELAST, OINT, lds, tid, wid, lane); SEAM(base + 3); }
            if (IN(base + 4)) { LOCALS(); phase_gla_intra(PROJ, QD, KI, VT, OINT, AIN(22), ACT, lds, tid, wid, lane); SEAM(base + 4); }
        } else if (kind == 2) {
            if (IN(base + 2)) { LOCALS(); phase_conv_core(PROJ, AIN(25), ACT, tid); SEAM(base + 2); }
        } else {
            if (IN(base + 2)) { LOCALS(); phase_ffn_fix((const float*)PROJ, AIN(28) + (size_t)layer * 3 * 11264, AIN(29) + (size_t)layer * 11264, ACT, tid); SEAM(base + 2); }
        }
        if (IN(base + 5)) {
            LOCALS(); const float* modl = MOD + (size_t)layer * 4 * 12288;
            const bf16_t* Bt; int K;
            if (kind == 0) { Bt = (const bf16_t*)(w + WS_WFOX + (size_t)j * 40 * MiB) + (size_t)8192 * DM; K = DM; }
            else if (kind == 1) { Bt = (const bf16_t*)(w + WS_WGLA) + (size_t)6144 * DM; K = DM; }
            else if (kind == 2) { Bt = (const bf16_t*)(w + WS_WCONV) + (size_t)6144 * DM; K = DM; }
            else { Bt = (const bf16_t*)(w + WS_WDOWN) + (size_t)layer * DM * DFF; K = DFF; }
            pg8::Gemm g{ACT, Bt, MTOK, DM, K}; pg8::StaticOrder S; S.init(MTOK, DM, NBLK, BID);
            { pg8::EpiResid E{sub == 0 ? (const void*)AIN(0) : (const void*)XB, dummy ? (bf16_t*)(w + WS_XD) : XB, modl + (is_ffn ? 10240 : 4096), sub == 0, (const float*)(w + WS_ST)};
                pg8::gemm_phase<pg8::EpiResid, pg8::StaticOrder, true, true>((LAS unsigned char*)lds, g, S, E, tid); }
            SEAM(base + 5);
        }
    }
    if (IN(PH_FINAL)) { LOCALS(); phase_lnmod<true, false>(XB, dummy ? (float*)(w + WS_PROJ) : (float*)args.out, H, true, false, AIN(6) + 3 * DM, AIN(7) + 3 * DM, nullptr, nullptr, 0, nullptr, nullptr, nullptr, nullptr, lds, tid, wid, lane); }
#undef LOCALS
#undef IN
#undef SEAM
#undef args
}

extern "C" void kernel_launch(void* const* d_in, const int* in_sizes, int n_in, void* d_out, int out_size, void* d_ws, size_t ws_size, hipStream_t stream) {
    static int grid = 0;
    if (grid == 0) {
        if (n_in != 31 || in_sizes[0] != MTOK * DM || out_size != MTOK * DM || ws_size < WS_END + (MK_DUP ? 136 * MiB : 0)) {
            fprintf(stderr, "kernel_launch: built for 31 inputs, x/out of %d floats, >= %zu bytes of workspace; got n_in %d, in0 %d, out %d, ws %zu; nothing launched\n", MTOK * DM, (size_t)WS_END, n_in, n_in > 0 ? in_sizes[0] : -1, out_size, ws_size);
            grid = -1; return; }
        int dev = 0, cus = 0, per_cu = 0;
        if (hipGetDevice(&dev) != hipSuccess || hipDeviceGetAttribute(&cus, hipDeviceAttributeMultiprocessorCount, dev) != hipSuccess) { fprintf(stderr, "kernel_launch: device query failed\n"); grid = -1; return; }
        if (hipFuncSetAttribute((const void*)mk_fwd, hipFuncAttributeMaxDynamicSharedMemorySize, LDS_TOTAL) != hipSuccess) { fprintf(stderr, "kernel_launch: hipFuncSetAttribute(%d B LDS) failed\n", LDS_TOTAL); grid = -1; return; }
        if (hipOccupancyMaxActiveBlocksPerMultiprocessor(&per_cu, (const void*)mk_fwd, 512, LDS_TOTAL) != hipSuccess || per_cu < 1)
            fprintf(stderr, "kernel_launch: note: occupancy query reports %d workgroups per CU\n", per_cu);
        (void)hipGetLastError();
        grid = cus;
    }
    if (grid < 0) return;
    if (hipMemsetAsync((char*)d_ws + WS_CTL, 0, CTL_ZERO_BYTES, stream) != hipSuccess) { fprintf(stderr, "kernel_launch: memset failed\n"); return; }
    Args a{};
    for (int i = 0; i < 31; ++i) a.in[i] = (const MK_AS1 float*)d_in[i];
    a.out = (MK_AS1 float*)d_out; a.ws = (MK_AS1 unsigned char*)d_ws;
#if MK_PER_PHASE
    for (int ph = 0; ph < PH_END; ++ph) {
        int group = 64;
        if (ph > 0 && ph < PH_FINAL) { const int sub = (ph - 1) >> 3, loc = (ph - 1) & 7, kind = (sub & 1) ? 3 : (sub >> 1) % 3;
            const bool exists = loc <= 2 || loc == 5 || (kind == 1 && loc <= 4); if (!exists) continue;
            group = loc == 0 ? 4 : loc == 1 ? (1 | (kind == 3 ? 512 : 1024)) : loc == 5 ? (2 | (kind == 3 ? 128 : 256)) : (kind == 0 ? 8 : kind == 1 ? (16 | (loc == 2 ? 2048 : loc == 3 ? 4096 : 8192)) : 32); }
        if (ph == PH_FINAL) group = 4;
        a.ph_lo = ph; a.ph_hi = ph + 1; a.flags = 0;
        hipLaunchKernelGGL(mk_fwd, dim3(grid), dim3(512), LDS_TOTAL, stream, a);
        if ((MK_DUP & group) == (MK_DUP & -MK_DUP) && (MK_DUP & group)) { a.flags = 1; hipLaunchKernelGGL(mk_fwd, dim3(grid), dim3(512), LDS_TOTAL, stream, a); }
    }
#else
    a.ph_lo = 0; a.ph_hi = PH_END;
    hipLaunchKernelGGL(mk_fwd, dim3(grid), dim3(512), LDS_TOTAL, stream, a);
#endif
    const hipError_t le = hipPeekAtLastError();
    if (le != hipSuccess) fprintf(stderr, "kernel_launch: launch failed: %s (grid %d)\n", hipGetErrorName(le), grid);
}
```

```cpp
#include <hip/hip_runtime.h>
#include <hip/hip_bf16.h>
#include <cstdio>
#include <cstdint>

#ifndef MK_PER_PHASE
#define MK_PER_PHASE 0
#endif

__device__ __forceinline__ int mk_lane() { int l; asm volatile("v_mbcnt_lo_u32_b32 %0, -1, 0\n\tv_mbcnt_hi_u32_b32 %0, -1, %0" : "=&v"(l)); return l; }
__device__ __forceinline__ float mk_shfl_xor(float v, int m) { return __builtin_bit_cast(float, __builtin_amdgcn_ds_bpermute((mk_lane() ^ m) << 2, __builtin_bit_cast(int, v))); }
__device__ __forceinline__ float mk_shfl_up(float v, int o) { return __builtin_bit_cast(float, __builtin_amdgcn_ds_bpermute(((mk_lane() - o) & 63) << 2, __builtin_bit_cast(int, v))); }
__device__ __forceinline__ float mk_sum_xor16(float v) { auto rr = __builtin_amdgcn_permlane16_swap(__float_as_uint(v), __float_as_uint(v), false, false); return __uint_as_float(rr[0]) + __uint_as_float(rr[1]); }
__device__ __forceinline__ float mk_sum_xor32(float v) { auto rr = __builtin_amdgcn_permlane32_swap(__float_as_uint(v), __float_as_uint(v), false, false); return __uint_as_float(rr[0]) + __uint_as_float(rr[1]); }
__device__ __forceinline__ float mk_xor1(float v) { return __builtin_bit_cast(float, __builtin_amdgcn_update_dpp(0, __builtin_bit_cast(int, v), 0xB1  , 0xf, 0xf, false)); }

namespace pg8 {
#define PG8_LAS __attribute__((address_space(3)))
typedef unsigned short bf16_t;
typedef short bf16x8 __attribute__((ext_vector_type(8)));
typedef float f32x4 __attribute__((ext_vector_type(4)));
typedef unsigned u32x4 __attribute__((ext_vector_type(4)));
constexpr int BM = 256, BK = 64, HALF = 128, HTB = HALF * BK * 2  , STAGE_BYTES = 8 * HTB, NXCD = 8, WGM = 8;

__host__ __device__ __forceinline__ int lds_byte(int r, int c) { const int st = (r >> 4) * 2 + (c >> 5), rr = r & 15, cc = c & 31, ob = rr * 64 + cc * 2; return st * 1024 + (ob ^ (((ob >> 9) & 1) << 5)); }
__host__ __device__ __forceinline__ void stage_rc(int b, int& R, int& C) { const int st = b / 1024, sb = b % 1024, swz = sb ^ (((sb >> 9) & 1) << 5); R = (st >> 1) * 16 + swz / 64; C = (st & 1) * 32 + (swz % 64) / 2; }
__host__ __device__ __forceinline__ int perm32(int rho) { const int n = rho >> 4, i = rho & 15; return 8 * (i >> 2) + 4 * n + (i & 3); }

struct Unit { int pm, pn; };
struct Gemm { const bf16_t* A; const bf16_t* Bt; int M, N, K; };

struct StaticOrder {
    int nM, nN, nwg, G, c;
    __host__ __device__ void init(int M, int N, int G_, int c_) { nM = M / BM; nN = N / BM; nwg = nM * nN; G = G_; c = c_; }
    __host__ __device__ bool next(int i, Unit& u) const {
        const long L = (long)i * G + c; if (L >= nwg) return false;
        int wgid = (int)L; { const int q = nwg / NXCD, r = nwg % NXCD, xcd = wgid % NXCD, off = wgid / NXCD; wgid = (xcd < r ? xcd * (q + 1) : r * (q + 1) + (xcd - r) * q) + off; }
        const int nig = WGM * nN, gid = wgid / nig, fm = gid * WGM, gsz = (nM - fm) < WGM ? (nM - fm) : WGM;
        u.pm = fm + ((wgid % nig) % gsz); u.pn = (wgid % nig) / gsz; return true;
    }
    __device__ __forceinline__ void a_ready(const Unit&) const {}
    __device__ __forceinline__ void done(const Unit&) const {}
};

__device__ __forceinline__ unsigned cvt_pk_bf16(float lo, float hi) { unsigned r; asm volatile("v_cvt_pk_bf16_f32 %0, %1, %2" : "=v"(r) : "v"(lo), "v"(hi)); return r; }
typedef float f32x2 __attribute__((ext_vector_type(2)));
template <class Epi, class Sched, bool ALIGN_EPI = false, bool SP2 = false>
__device__ __forceinline__ void gemm_phase(PG8_LAS unsigned char* lds, const Gemm g, const Sched& S, const Epi& E, int tid_in) {
    int tid_ = tid_in; asm volatile("" : "+v"(tid_));
    const int tid = tid_, wid = __builtin_amdgcn_readfirstlane(tid >> 6), lane = tid & 63, wr = wid >> 2, wc = wid & 3, fr = lane & 15, fq = lane >> 4;
    const int K = g.K, nt = K / BK;
    unsigned voffA[2], voffB[2];
#pragma unroll
    for (int i = 0; i < 2; ++i) { int R, C; stage_rc(tid * 16 + i * 8192, R, C); const int Rb = Epi::PERM ? ((R & ~31) + perm32(R & 31)) : R;
        voffA[i] = (unsigned)(R * K + C) * 2u; voffB[i] = (unsigned)(Rb * K + C) * 2u; }
    const size_t kstep = (size_t)(BK * 2);
    const size_t hstep = (size_t)HALF * K * 2;
    const size_t tstep = 2 * hstep;
    const unsigned ldsw = (unsigned)wid * 1024u;
    const int aoff = lds_byte(wr * 64 + fr, fq * 8), boff = lds_byte(wc * 32 + fr, fq * 8);
#define PG8_SA(b, h) (((b) * 2 + (h)) * HTB)
#define PG8_SB(b, h) ((4 + (b) * 2 + (h)) * HTB)
#define PG8_STAGE(bufoff, gbase, voff) do { _Pragma("unroll") for (int _i = 0; _i < 2; ++_i) \
        __builtin_amdgcn_global_load_lds((const unsigned*)((const char*)(gbase) + (voff)[_i]), (PG8_LAS unsigned*)(lds + (bufoff) + ldsw + _i * 8192), 16, 0, 0); } while (0)
#define PG8_LDA(dst, b, h) do { _Pragma("unroll") for (int m = 0; m < 4; ++m) _Pragma("unroll") for (int k = 0; k < 2; ++k) dst[m][k] = *(const PG8_LAS bf16x8*)(lds + PG8_SA(b, h) + aoff + m * 2048 + k * 1024); } while (0)
#define PG8_LDB(dst, b, h) do { _Pragma("unroll") for (int n = 0; n < 2; ++n) _Pragma("unroll") for (int k = 0; k < 2; ++k) dst[n][k] = *(const PG8_LAS bf16x8*)(lds + PG8_SB(b, h) + boff + n * 2048 + k * 1024); } while (0)
#define PG8_MMA(ai, bj, At, Bt) do { __builtin_amdgcn_s_setprio(1); _Pragma("unroll") for (int m = 0; m < 4; ++m) _Pragma("unroll") for (int n = 0; n < 2; ++n) _Pragma("unroll") for (int k = 0; k < 2; ++k) \
        acc[ai][bj][m][n] = __builtin_amdgcn_mfma_f32_16x16x32_bf16(Bt[n][k], At[m][k], acc[ai][bj][m][n], 0, 0, 0); __builtin_amdgcn_s_setprio(0); } while (0)
#define PG8_WAIT_V(n) asm volatile("s_waitcnt vmcnt(" #n ")" ::: "memory")
#define PG8_WAIT_L(n) asm volatile("s_waitcnt lgkmcnt(" #n ")" ::: "memory")
#define PG8_BAR __builtin_amdgcn_s_barrier()
#define PG8_SCHED __builtin_amdgcn_sched_barrier(0)
    Unit cur, nxt; int ui = 0;
    if (!S.next(0, cur)) return;
    f32x4 acc[2][2][4][2];
#pragma unroll
    for (int a = 0; a < 2; ++a)
#pragma unroll
        for (int b = 0; b < 2; ++b)
#pragma unroll
            for (int m = 0; m < 4; ++m)
#pragma unroll
                for (int n = 0; n < 2; ++n) acc[a][b][m][n] = (f32x4){0.f, 0.f, 0.f, 0.f};
    bf16x8 At[4][2], B0[2][2], B1[2][2];
    const char* cA = (const char*)g.A + (size_t)cur.pm * tstep; const char* cB = (const char*)g.Bt + (size_t)cur.pn * tstep;
    S.a_ready(cur);
    if constexpr (SP2) {
        PG8_STAGE(PG8_SB(0, 0), cB, voffB); PG8_STAGE(PG8_SB(0, 1), cB + hstep, voffB); PG8_STAGE(PG8_SA(0, 0), cA, voffA); PG8_STAGE(PG8_SA(0, 1), cA + hstep, voffA);
        if (wr == 1) PG8_BAR;
        PG8_WAIT_V(2); PG8_BAR;
        PG8_STAGE(PG8_SB(1, 0), cB + kstep, voffB); PG8_STAGE(PG8_SA(1, 0), cA + kstep, voffA); PG8_STAGE(PG8_SB(1, 1), cB + hstep + kstep, voffB);
        PG8_WAIT_V(6); PG8_BAR;
    } else {
        PG8_STAGE(PG8_SB(0, 0), cB, voffB); PG8_STAGE(PG8_SA(0, 0), cA, voffA); PG8_STAGE(PG8_SB(0, 1), cB + hstep, voffB); PG8_STAGE(PG8_SA(0, 1), cA + hstep, voffA);
        if (wr == 1) PG8_BAR;
        PG8_WAIT_V(4); PG8_BAR;
        PG8_STAGE(PG8_SB(1, 0), cB + kstep, voffB); PG8_STAGE(PG8_SA(1, 0), cA + kstep, voffA); PG8_STAGE(PG8_SB(1, 1), cB + hstep + kstep, voffB);
        PG8_WAIT_V(6); PG8_BAR;
    }
    for (;;) {
        E.unit_begin(lds, cur, ui, wid, lane);
        const bool has_next = S.next(ui + 1, nxt);
        const char* nA = has_next ? (const char*)g.A + (size_t)nxt.pm * tstep : cA; const char* nB = has_next ? (const char*)g.Bt + (size_t)nxt.pn * tstep : cB;
        for (int t = 0; t < nt; t += 2) {
            const bool last = (t == nt - 2);
            const char* a1 = cA + (size_t)(t + 1) * kstep;
            const char* a2 = last ? nA : cA + (size_t)(t + 2) * kstep; const char* b2 = last ? nB : cB + (size_t)(t + 2) * kstep;
            const char* a3 = a2 + kstep; const char* b3 = b2 + kstep;
            if (last && has_next) S.a_ready(nxt);
            if constexpr (SP2) {
            PG8_LDB(B0, 0, 0); PG8_LDB(B1, 0, 1); PG8_SCHED; PG8_LDA(At, 0, 0); PG8_STAGE(PG8_SA(1, 1), a1 + hstep, voffA);
            PG8_WAIT_V(8); PG8_WAIT_L(0); PG8_BAR; PG8_MMA(0, 0, At, B0); PG8_MMA(0, 1, At, B1); PG8_BAR; PG8_SCHED;
            PG8_LDA(At, 0, 1); PG8_STAGE(PG8_SB(0, 0), b2, voffB); PG8_STAGE(PG8_SB(0, 1), b2 + hstep, voffB); PG8_STAGE(PG8_SA(0, 0), a2, voffA);
            PG8_WAIT_V(8); PG8_WAIT_L(0); PG8_BAR; PG8_MMA(1, 0, At, B0); PG8_MMA(1, 1, At, B1); PG8_BAR; PG8_SCHED;
            PG8_LDB(B0, 1, 0); PG8_LDB(B1, 1, 1); PG8_SCHED; PG8_LDA(At, 1, 0); PG8_STAGE(PG8_SA(0, 1), a2 + hstep, voffA);
            PG8_WAIT_V(8); PG8_WAIT_L(0); PG8_BAR; PG8_MMA(0, 0, At, B0); PG8_MMA(0, 1, At, B1); PG8_BAR; PG8_SCHED;
            PG8_LDA(At, 1, 1); PG8_STAGE(PG8_SB(1, 0), b3, voffB); PG8_STAGE(PG8_SB(1, 1), b3 + hstep, voffB); PG8_STAGE(PG8_SA(1, 0), a3, voffA);
            PG8_WAIT_V(8); PG8_WAIT_L(0); PG8_BAR; PG8_MMA(1, 0, At, B0); PG8_MMA(1, 1, At, B1); PG8_BAR; PG8_SCHED;
            } else {
            PG8_LDB(B0, 0, 0); PG8_SCHED; PG8_LDA(At, 0, 0); PG8_STAGE(PG8_SA(1, 1), a1 + hstep, voffA);
            PG8_WAIT_L(8); PG8_BAR; PG8_WAIT_L(0); PG8_MMA(0, 0, At, B0); PG8_BAR; PG8_SCHED;
            PG8_LDB(B1, 0, 1); PG8_STAGE(PG8_SB(0, 0), b2, voffB);
            PG8_BAR; PG8_WAIT_L(0); PG8_MMA(0, 1, At, B1); PG8_BAR;
            PG8_LDA(At, 0, 1); PG8_STAGE(PG8_SA(0, 0), a2, voffA);
            PG8_BAR; PG8_WAIT_L(0); PG8_MMA(1, 0, At, B0); PG8_BAR; PG8_SCHED;
            PG8_STAGE(PG8_SB(0, 1), b2 + hstep, voffB);
            PG8_WAIT_V(6); PG8_BAR; PG8_MMA(1, 1, At, B1); PG8_BAR;
            PG8_LDB(B0, 1, 0); PG8_SCHED; PG8_LDA(At, 1, 0); PG8_STAGE(PG8_SA(0, 1), a2 + hstep, voffA);
            PG8_WAIT_L(8); PG8_BAR; PG8_WAIT_L(0); PG8_MMA(0, 0, At, B0); PG8_BAR; PG8_SCHED;
            PG8_LDB(B1, 1, 1); PG8_STAGE(PG8_SB(1, 0), b3, voffB);
            PG8_BAR; PG8_WAIT_L(0); PG8_MMA(0, 1, At, B1); PG8_BAR;
            PG8_LDA(At, 1, 1); PG8_STAGE(PG8_SA(1, 0), a3, voffA);
            PG8_BAR; PG8_WAIT_L(0); PG8_MMA(1, 0, At, B0); PG8_BAR; PG8_SCHED;
            PG8_STAGE(PG8_SB(1, 1), b3 + hstep, voffB);
            PG8_WAIT_V(6); PG8_BAR; PG8_MMA(1, 1, At, B1); PG8_BAR;
            }
        }
        if constexpr (ALIGN_EPI) { if (wr == 0) PG8_BAR; }
        if constexpr (!Epi::AFTER_DRAIN) { E(acc, cur, wr, wc, fr, fq, lds, ui); S.done(cur); }
        if (!has_next) break;
#pragma unroll
        for (int a = 0; a < 2; ++a)
#pragma unroll
            for (int b = 0; b < 2; ++b)
#pragma unroll
                for (int m = 0; m < 4; ++m)
#pragma unroll
                    for (int n = 0; n < 2; ++n) acc[a][b][m][n] = (f32x4){0.f, 0.f, 0.f, 0.f};
        cur = nxt; cA = nA; cB = nB; ++ui;
        if constexpr (ALIGN_EPI) { if (wr == 1) PG8_BAR; }
    }
    PG8_WAIT_V(0);
    if constexpr (!ALIGN_EPI) { if (wr == 0) PG8_BAR; }
    PG8_BAR;
    if constexpr (Epi::AFTER_DRAIN) { E.fused(acc, cur, wr, wc, fr, fq, lds, wid, lane); S.done(cur); }
#undef PG8_SA
#undef PG8_SB
#undef PG8_STAGE
#undef PG8_LDA
#undef PG8_LDB
#undef PG8_MMA
#undef PG8_WAIT_V
#undef PG8_WAIT_L
#undef PG8_BAR
#undef PG8_SCHED
}
}

namespace pg8 {
constexpr int EPI_LDS_OFF = 131072, EPI_LDS_PAR = 8192;
struct EpiStore {
    static constexpr bool PERM = true, AFTER_DRAIN = false;
    bf16_t* O; int ldc; int hm; float* n2p;
    __device__ __forceinline__ void unit_begin(PG8_LAS unsigned char*, const Unit&, int, int, int) const {}
    __device__ __forceinline__ void operator()(const f32x4 (&acc)[2][2][4][2], const Unit& u, int wr, int wc, int fr, int fq, PG8_LAS unsigned char* lds, int ui) const {
        const int row0 = u.pm * BM + wr * 64 + fr, col0 = u.pn * BM + wc * 32 + 8 * fq;
        size_t base[2]; size_t rstride;
        if (hm) { const int b = row0 >> 12, s = row0 & 4095;
#pragma unroll
            for (int bj = 0; bj < 2; ++bj) { const int c = col0 + bj * HALF, t = c >> 11, h = (c >> 7) & 15, d = c & 127; base[bj] = ((size_t)((t * 4 + b) * 16 + h) * 4096 + s) * 128 + d; }
            rstride = 128;
            if (u.pn < 16) {
#pragma unroll
                for (int bj = 0; bj < 2; ++bj) { const int c = col0 + bj * HALF, t = c >> 11, h = (c >> 7) & 15;
                    float* np = n2p + ((size_t)((t * 4 + b) * 16 + h) * 4096 + s) * 4 + wc;
#pragma unroll
                    for (int ai = 0; ai < 2; ++ai)
#pragma unroll
                        for (int m = 0; m < 4; ++m) { const f32x4 v0 = acc[ai][bj][m][0], v1 = acc[ai][bj][m][1];
                            float q = (v0[0] * v0[0] + v0[1] * v0[1]) + (v0[2] * v0[2] + v0[3] * v0[3]) + (v1[0] * v1[0] + v1[1] * v1[1]) + (v1[2] * v1[2] + v1[3] * v1[3]);
                            q = mk_sum_xor32(mk_sum_xor16(q));
                            if (fq == 0) np[(size_t)(ai * HALF + m * 16) * 4] = q; } } }
        }
        else { base[0] = (size_t)row0 * ldc + col0; base[1] = base[0] + HALF; rstride = (size_t)ldc; }
#pragma unroll
        for (int ai = 0; ai < 2; ++ai)
#pragma unroll
            for (int m = 0; m < 4; ++m) {
#pragma unroll
                for (int bj = 0; bj < 2; ++bj) { const f32x4 v0 = acc[ai][bj][m][0], v1 = acc[ai][bj][m][1];
                    u32x4 w; w.x = cvt_pk_bf16(v0[0], v0[1]); w.y = cvt_pk_bf16(v0[2], v0[3]); w.z = cvt_pk_bf16(v1[0], v1[1]); w.w = cvt_pk_bf16(v1[2], v1[3]);
                    *(u32x4*)(O + base[bj] + (size_t)(ai * HALF + m * 16) * rstride) = w; } }
    }
};
struct EpiResid {
    static constexpr bool PERM = true, AFTER_DRAIN = false;
    const void* Xs; bf16_t* Xd; const float* gate; int src_f32; const float* stats;
    __device__ __forceinline__ void unit_begin(PG8_LAS unsigned char* lds, const Unit& u, int ui, int wid, int) const {
        if (wid < 5) { int lane; asm volatile("v_mbcnt_lo_u32_b32 %0, -1, 0\n\tv_mbcnt_hi_u32_b32 %0, -1, %0" : "=&v"(lane));
            const float* src = wid < 3 ? (wid == 0 ? gate + (size_t)((u.pm * BM) >> 12) * 12288 : stats + 2 * 16384 + (wid - 1) * 2048) + u.pn * BM + lane * 4
                                       : stats + (size_t)(u.pm * BM + (wid - 3) * 128) * 2 + lane * 4;
            __builtin_amdgcn_global_load_lds((const unsigned*)src, (PG8_LAS unsigned*)(lds + EPI_LDS_OFF + (ui & 1) * EPI_LDS_PAR + wid * 1024), 16, 0, 0); }
    }
    __device__ __forceinline__ void operator()(const f32x4 (&acc)[2][2][4][2], const Unit& u, int wr, int wc, int fr, int fq, PG8_LAS unsigned char* lds, int ui) const {
        const int row0 = u.pm * BM + wr * 64 + fr, col0 = u.pn * BM + wc * 32 + 8 * fq;
        const PG8_LAS float* lv = (const PG8_LAS float*)(lds + EPI_LDS_OFF + (ui & 1) * EPI_LDS_PAR) + wc * 32 + 8 * fq;
        if (src_f32) {
            f32x4 gv[2][2], av[2][2], bv[2][2];
#pragma unroll
            for (int bj = 0; bj < 2; ++bj)
#pragma unroll
                for (int n = 0; n < 2; ++n) { gv[bj][n] = *(const PG8_LAS f32x4*)(lv + bj * HALF + n * 4); av[bj][n] = *(const PG8_LAS f32x4*)(lv + 256 + bj * HALF + n * 4); bv[bj][n] = *(const PG8_LAS f32x4*)(lv + 512 + bj * HALF + n * 4); }
#pragma unroll
            for (int ai = 0; ai < 2; ++ai)
#pragma unroll
                for (int mp = 0; mp < 2; ++mp) {
                    f32x4 xv[2][2][2]; f32x2 st[2];
#pragma unroll
                    for (int mm = 0; mm < 2; ++mm) { const size_t row = (size_t)(row0 + ai * HALF + (2 * mp + mm) * 16); st[mm] = *(const f32x2*)(stats + row * 2); const float* rowp = (const float*)Xs + row * 2048 + col0;
#pragma unroll
                        for (int bj = 0; bj < 2; ++bj)
#pragma unroll
                            for (int n = 0; n < 2; ++n) xv[mm][bj][n] = *(const f32x4*)(rowp + bj * HALF + n * 4); }
#pragma unroll
                    for (int mm = 0; mm < 2; ++mm) { bf16_t* rowp = Xd + (size_t)(row0 + ai * HALF + (2 * mp + mm) * 16) * 2048 + col0; const float mean = st[mm][0], rstd = st[mm][1];
#pragma unroll
                        for (int bj = 0; bj < 2; ++bj) {
                            const f32x4 r0 = (xv[mm][bj][0] - mean) * rstd * av[bj][0] + bv[bj][0] + gv[bj][0] * acc[ai][bj][2 * mp + mm][0];
                            const f32x4 r1 = (xv[mm][bj][1] - mean) * rstd * av[bj][1] + bv[bj][1] + gv[bj][1] * acc[ai][bj][2 * mp + mm][1];
                            u32x4 w; w.x = cvt_pk_bf16(r0[0], r0[1]); w.y = cvt_pk_bf16(r0[2], r0[3]); w.z = cvt_pk_bf16(r1[0], r1[1]); w.w = cvt_pk_bf16(r1[2], r1[3]);
                            *(u32x4*)(rowp + bj * HALF) = w; } } }
        } else {
#pragma unroll
            for (int ai = 0; ai < 2; ++ai) {
                u32x4 xb[4][2]; f32x2 st[4];
#pragma unroll
                for (int m = 0; m < 4; ++m) { const size_t row = (size_t)(row0 + ai * HALF + m * 16); const bf16_t* rowp = (const bf16_t*)Xs + row * 2048 + col0;
                    xb[m][0] = *(const u32x4*)(rowp); xb[m][1] = *(const u32x4*)(rowp + HALF); }
                __builtin_amdgcn_sched_barrier(0);
#pragma unroll
                for (int m = 0; m < 4; ++m) st[m] = ((const PG8_LAS f32x2*)(lds + EPI_LDS_OFF + (ui & 1) * EPI_LDS_PAR + 3072))[ai * HALF + wr * 64 + m * 16 + fr];
#pragma unroll
                for (int bj = 0; bj < 2; ++bj) {
                    const f32x4 g0 = *(const PG8_LAS f32x4*)(lv + bj * HALF), g1 = *(const PG8_LAS f32x4*)(lv + bj * HALF + 4);
                    const f32x4 a0 = *(const PG8_LAS f32x4*)(lv + 256 + bj * HALF), a1 = *(const PG8_LAS f32x4*)(lv + 256 + bj * HALF + 4);
                    const f32x4 b0 = *(const PG8_LAS f32x4*)(lv + 512 + bj * HALF), b1 = *(const PG8_LAS f32x4*)(lv + 512 + bj * HALF + 4);
#pragma unroll
                    for (int m = 0; m < 4; ++m) {
                        bf16_t* rowp = Xd + (size_t)(row0 + ai * HALF + m * 16) * 2048 + col0 + bj * HALF; const float mean = st[m][0], rstd = st[m][1];
                        const u32x4 xw = xb[m][bj]; f32x4 x0, x1;
                        x0[0] = __uint_as_float(xw.x << 16); x0[1] = __uint_as_float(xw.x & 0xffff0000u); x0[2] = __uint_as_float(xw.y << 16); x0[3] = __uint_as_float(xw.y & 0xffff0000u);
                        x1[0] = __uint_as_float(xw.z << 16); x1[1] = __uint_as_float(xw.z & 0xffff0000u); x1[2] = __uint_as_float(xw.w << 16); x1[3] = __uint_as_float(xw.w & 0xffff0000u);
                        const f32x4 r0 = (x0 - mean) * rstd * a0 + b0 + g0 * acc[ai][bj][m][0];
                        const f32x4 r1 = (x1 - mean) * rstd * a1 + b1 + g1 * acc[ai][bj][m][1];
                        u32x4 w; w.x = cvt_pk_bf16(r0[0], r0[1]); w.y = cvt_pk_bf16(r0[2], r0[3]); w.z = cvt_pk_bf16(r1[0], r1[1]); w.w = cvt_pk_bf16(r1[2], r1[3]);
                        *(u32x4*)rowp = w; } }
                __builtin_amdgcn_sched_barrier(0); }
        }
    }
};
template <int CTRL> __device__ __forceinline__ float dppf(float v) { return __builtin_bit_cast(float, __builtin_amdgcn_update_dpp(0, __builtin_bit_cast(int, v), CTRL, 0xf, 0xf, true)); }
typedef unsigned u32x2v __attribute__((ext_vector_type(2)));
struct EpiFfn {
    static constexpr bool PERM = true, AFTER_DRAIN = false;
    bf16_t* ACT; float* ZH; const float* cw; const float* cb;
    __device__ __forceinline__ void unit_begin(PG8_LAS unsigned char* lds, const Unit& u, int ui, int wid, int) const {
        if (wid < 4) { int lane; asm volatile("v_mbcnt_lo_u32_b32 %0, -1, 0\n\tv_mbcnt_hi_u32_b32 %0, -1, %0" : "=&v"(lane));
            const float* src = (wid < 3 ? cw + wid * 11264 : cb) + (lane < 32 ? 0 : 5632) + u.pn * 128 + (lane & 31) * 4;
            __builtin_amdgcn_global_load_lds((const unsigned*)src, (PG8_LAS unsigned*)(lds + EPI_LDS_OFF + (ui & 1) * EPI_LDS_PAR + wid * 1024), 16, 0, 0); }
    }
    __device__ __forceinline__ void operator()(const f32x4 (&acc)[2][2][4][2], const Unit& u, int wr, int wc, int fr, int fq, PG8_LAS unsigned char* lds, int ui) const {
#pragma unroll
        for (int n = 0; n < 2; ++n) {
            const int ch0 = u.pn * 128 + wc * 32 + 8 * fq + 4 * n;
            f32x4 wa[3], wu[3];
            const PG8_LAS float* lw = (const PG8_LAS float*)(lds + EPI_LDS_OFF + (ui & 1) * EPI_LDS_PAR) + wc * 32 + 8 * fq + 4 * n;
#pragma unroll
            for (int k = 0; k < 3; ++k) { wa[k] = *(const PG8_LAS f32x4*)(lw + k * 256); wu[k] = *(const PG8_LAS f32x4*)(lw + k * 256 + 128); }
            const f32x4 ba = *(const PG8_LAS f32x4*)(lw + 3 * 256), bu = *(const PG8_LAS f32x4*)(lw + 3 * 256 + 128);
#pragma unroll
            for (int ai = 0; ai < 2; ++ai) { const int blk = u.pm * 4 + ai * 2 + wr;
                if (fr < 2) { float* zp = ZH + ((size_t)(blk * 4 + 2 + fr) * 2) * 5632 + ch0; *(f32x4*)zp = acc[ai][0][0][n]; *(f32x4*)(zp + 5632) = acc[ai][1][0][n]; }
                if (fr >= 14) { float* zp = ZH + ((size_t)((blk + 1) * 4 + fr - 14) * 2) * 5632 + ch0; *(f32x4*)zp = acc[ai][0][3][n]; *(f32x4*)(zp + 5632) = acc[ai][1][3][n]; }
                f32x4 q1a = {0.f, 0.f, 0.f, 0.f}, q0a = q1a, q1u = q1a, q0u = q1a;
#pragma unroll
                for (int m = 0; m < 4; ++m) { float o[4];
                    const f32x4 va = acc[ai][0][m][n], vu = acc[ai][1][m][n];
                    f32x4 t1a = wa[1] * va, t0a = wa[0] * va, t1u = wu[1] * vu, t0u = wu[0] * vu;
                    f32x4 ya = ba + wa[2] * va, yu = bu + wu[2] * vu;
#define FFN_DPP4(Y, T, CTRL) asm volatile("s_nop 1\n\tv_add_f32_dpp %0, %4, %0 " CTRL " row_mask:0xf bank_mask:0xf bound_ctrl:1\n\tv_add_f32_dpp %1, %5, %1 " CTRL " row_mask:0xf bank_mask:0xf bound_ctrl:1\n\t" \
                                          "v_add_f32_dpp %2, %6, %2 " CTRL " row_mask:0xf bank_mask:0xf bound_ctrl:1\n\tv_add_f32_dpp %3, %7, %3 " CTRL " row_mask:0xf bank_mask:0xf bound_ctrl:1" \
                                          : "+v"(Y[0]), "+v"(Y[1]), "+v"(Y[2]), "+v"(Y[3]) : "v"(T[0]), "v"(T[1]), "v"(T[2]), "v"(T[3]))
                    asm volatile("s_nop 4" : "+v"(t1a), "+v"(t0a), "+v"(t1u), "+v"(t0u), "+v"(q1a), "+v"(q0a), "+v"(q1u), "+v"(q0u));
                    FFN_DPP4(ya, t1a, "row_shr:1"); FFN_DPP4(yu, t1u, "row_shr:1"); FFN_DPP4(ya, t0a, "row_shr:2"); FFN_DPP4(yu, t0u, "row_shr:2");
                    if (m) { FFN_DPP4(ya, q1a, "row_shl:15"); FFN_DPP4(yu, q1u, "row_shl:15"); FFN_DPP4(ya, q0a, "row_shl:14"); FFN_DPP4(yu, q0u, "row_shl:14"); }
#undef FFN_DPP4
#pragma unroll
                    for (int e = 0; e < 4; e += 2) {
                        const f32x2 a2 = {ya[e], ya[e + 1]}, u2 = {yu[e], yu[e + 1]}, x2 = a2 * (-1.4426950408889634f);
                        f32x2 d2; d2.x = __builtin_amdgcn_exp2f(x2.x); d2.y = __builtin_amdgcn_exp2f(x2.y); d2 = d2 + 1.0f;
                        f32x2 r2; r2.x = __builtin_amdgcn_rcpf(d2.x); r2.y = __builtin_amdgcn_rcpf(d2.y);
                        const f32x2 o2 = (a2 * u2) * r2; o[e] = o2.x; o[e + 1] = o2.y; }
                    q1a = t1a; q0a = t0a; q1u = t1u; q0u = t0u;
                    if (m > 0 || fr >= 2) { u32x2v w; w.x = cvt_pk_bf16(o[0], o[1]); w.y = cvt_pk_bf16(o[2], o[3]); *(u32x2v*)(ACT + (size_t)(blk * 64 + m * 16 + fr) * 5632 + ch0) = w; }
                    __builtin_amdgcn_sched_barrier(0); } } }
    }
};
}
namespace fx {
using bf16 = __hip_bfloat16;
constexpr int D = 128, RS = 128  , OS = 2048  ;
constexpr float THR = 24.f;     constexpr bool WSKIP = false; constexpr float T_DEAD = 24.f;
constexpr float SCALE = 0.08838834764831845f;
constexpr int NW = 8, QBLK = 32, KVBLK = 64, QB = NW * QBLK;
constexpr int SHM_V = KVBLK * D * 2, SHM_K = KVBLK * D * 2;
constexpr int BIAS_OFF = 2 * SHM_V + 2 * SHM_K + NW * 64 * 4;
constexpr int GATE_OFF = BIAS_OFF + 4096 * 4;
constexpr int LDS_BYTES = GATE_OFF + 8 * 8192;
typedef short bf16x8 __attribute__((ext_vector_type(8)));
typedef short s16x4 __attribute__((ext_vector_type(4)));
typedef float f32x16 __attribute__((ext_vector_type(16)));
typedef float f32x4 __attribute__((ext_vector_type(4)));
typedef unsigned u32x4 __attribute__((ext_vector_type(4)));
template <class A, class Bt> struct same_t { static constexpr bool v = false; };
template <class A> struct same_t<A, A> { static constexpr bool v = true; };
#define KSWZ(row, colB) ((row) * 256 + ((colB) ^ (((row) & 7) << 4)))
#define SBAR() __builtin_amdgcn_sched_barrier(0)
__device__ __forceinline__ int v_st(int k, int c) { const int kk = (k & ~0xC) | ((k & 4) << 1) | ((k & 8) >> 1); return ((kk >> 3) * 4 + (c >> 5)) * 512 + ((kk & 7) * 32 + (c & 31)) * 2; }
__device__ __forceinline__ int v_rd_base(int lane) { return ((lane & 3) << 3) | (((lane >> 2) & 3) << 6) | (((lane >> 4) & 1) << 5) | (((lane >> 5) & 1) << 8); }
constexpr int v_rd_off(int d0, int ks, int half) { return d0 * 512 + ks * 4096 + half * 2048; }
__device__ __forceinline__ int crow(int r, int hi) { return (r & 3) + 8 * (r >> 2) + 4 * hi; }
__device__ __forceinline__ unsigned cvtpk(float lo, float hi) {
    unsigned r; asm volatile("v_cvt_pk_bf16_f32 %0, %1, %2" : "=v"(r) : "v"(lo), "v"(hi)); return r;
}
__device__ __forceinline__ bf16x8 pack8(f32x4 a, f32x4 b) {
    u32x4 w = {cvtpk(a[0], a[1]), cvtpk(a[2], a[3]), cvtpk(b[0], b[1]), cvtpk(b[2], b[3])};
    return *reinterpret_cast<bf16x8*>(&w);
}
template <class T> __device__ __forceinline__ bf16x8 load8(const T* p) {
    if constexpr (same_t<T, float>::v) { return pack8(*(const f32x4*)p, *(const f32x4*)(p + 4)); }
    else { return *reinterpret_cast<const bf16x8*>(p); }
}
__device__ __forceinline__ void mask_tile(f32x16& p0, f32x16& p1, int dq, unsigned W) {
    const float NEG = -__builtin_inff();
#pragma unroll
    for (int r = 0; r < 16; ++r) {
        const int c = (r & 3) + 8 * (r >> 2);
        if ((unsigned)(dq - c) >= W) p0[r] = NEG;
        if ((unsigned)(dq - c - 32) >= W) p1[r] = NEG;
    }
}
__device__ __forceinline__ void partialSM(f32x16& p0, f32x16& p1, float& m_reg, float& mn, float& alpha, bool& dead) {
    float pmax = p0[0]; for (int r = 1; r < 16; ++r) pmax = fmaxf(pmax, p0[r]); for (int r = 0; r < 16; ++r) pmax = fmaxf(pmax, p1[r]);
    { auto rr = __builtin_amdgcn_permlane32_swap(__float_as_uint(pmax), __float_as_uint(pmax), false, false);
      pmax = fmaxf(__uint_as_float(rr[0]), __uint_as_float(rr[1])); }
    constexpr float C2 = 1.4426950408889634f * SCALE;
    dead = __all((pmax - m_reg) * SCALE < -T_DEAD);
    if (dead) { mn = m_reg; alpha = 1.f; return; }
    if (__builtin_expect(__all((pmax - m_reg) * SCALE <= THR), 1)) { mn = m_reg; alpha = 1.f; }
    else { mn = fmaxf(m_reg, pmax); alpha = __builtin_amdgcn_exp2f((m_reg - mn) * C2); m_reg = mn; }
    const float mnL = -mn * C2;
    for (int r = 0; r < 16; ++r) p0[r] = fmaf(p0[r], C2, mnL); for (int r = 0; r < 16; ++r) p1[r] = fmaf(p1[r], C2, mnL);
    for (int r = 0; r < 16; ++r) p0[r] = __builtin_amdgcn_exp2f(p0[r]);
}
__device__ __forceinline__ void finishSM(f32x16& p0, f32x16& p1, float alpha, float& l_reg, bf16x8& pa0, bf16x8& pa1, bf16x8& pa2, bf16x8& pa3) {
    for (int r = 0; r < 16; ++r) p1[r] = __builtin_amdgcn_exp2f(p1[r]);
    float ps = 0; for (int r = 0; r < 16; ++r) ps += p0[r]; for (int r = 0; r < 16; ++r) ps += p1[r];
    { auto rr = __builtin_amdgcn_permlane32_swap(__float_as_uint(ps), __float_as_uint(ps), false, false);
      ps = __uint_as_float(rr[0]) + __uint_as_float(rr[1]); }
    l_reg = l_reg * alpha + ps;
#define PK4(P, B_, OUT) do { unsigned a0 = cvtpk(P[B_+0], P[B_+1]), a1 = cvtpk(P[B_+2], P[B_+3]);                          \
        unsigned b0 = cvtpk(P[B_+4], P[B_+5]), b1 = cvtpk(P[B_+6], P[B_+7]);                                             \
        auto r0 = __builtin_amdgcn_permlane32_swap(a0, b0, false, false); auto r1 = __builtin_amdgcn_permlane32_swap(a1, b1, false, false); \
        u32x4 w = {r0[0], r1[0], r0[1], r1[1]}; OUT = *reinterpret_cast<bf16x8*>(&w); } while (0)
    PK4(p0, 0, pa0); PK4(p0, 8, pa1); PK4(p1, 0, pa2); PK4(p1, 8, pa3);
#undef PK4
}
template <int KB, bool SK>
__device__ __forceinline__ void qkt(f32x16& p0, f32x16& p1, const char* K_lds, int r32, int hi, const bf16x8* qr, bool act, const float* bl) {
    if (SK && !act) { const float NEG = -__builtin_inff();
#pragma unroll
        for (int r = 0; r < 16; ++r) { p0[r] = NEG; p1[r] = NEG; } return; }
#pragma unroll
    for (int g_ = 0; g_ < 4; ++g_) { const f32x4 t0 = *(const f32x4*)(bl + 8 * g_), t1 = *(const f32x4*)(bl + 32 + 8 * g_);
#pragma unroll
        for (int e_ = 0; e_ < 4; ++e_) { p0[4 * g_ + e_] = t0[e_]; p1[4 * g_ + e_] = t1[e_]; } }
    const char* kb[4];
#pragma unroll
    for (int dd = 0; dd < 4; ++dd) kb[dd] = K_lds + KB * SHM_K + KSWZ(r32, (dd * 16 + hi * 8) * 2);
#pragma unroll
    for (int d0 = 0; d0 < 8; ++d0) { const char* a = kb[d0 & 3] + (d0 >> 2) * 128;
        bf16x8 b0 = *reinterpret_cast<const bf16x8*>(a);
        bf16x8 b1 = *reinterpret_cast<const bf16x8*>(a + 32 * 256);
        p0 = __builtin_amdgcn_mfma_f32_32x32x16_bf16(b0, qr[d0], p0, 0, 0, 0);
        p1 = __builtin_amdgcn_mfma_f32_32x32x16_bf16(b1, qr[d0], p1, 0, 0, 0); }
}
template <int VB, bool SK>
__device__ __forceinline__ void pv_tile(f32x16* o, int vb0, bf16x8 pa0, bf16x8 pa1, bf16x8 pa2, bf16x8 pa3, bool act) {
    if (SK && !act) return;
#define TRRD(dst, off) asm volatile("ds_read_b64_tr_b16 %0, %1 offset:%2" : "=&v"(dst) : "v"(vb0), "i"(off) : "memory")
#define PV_D0(d0) do { s16x4 l0, l1, l2, l3, h0, h1, h2, h3; constexpr int b_ = VB * SHM_V + v_rd_off(d0, 0, 0);     \
        TRRD(l0, b_); TRRD(h0, b_ + 2048); TRRD(l1, b_ + 4096); TRRD(h1, b_ + 6144); TRRD(l2, b_ + 8192); TRRD(h2, b_ + 10240); TRRD(l3, b_ + 12288); TRRD(h3, b_ + 14336); \
        asm volatile("s_waitcnt lgkmcnt(0)" ::: "memory"); SBAR();                 \
        o[d0] = __builtin_amdgcn_mfma_f32_32x32x16_bf16(pa0, (bf16x8){l0[0], l0[1], l0[2], l0[3], h0[0], h0[1], h0[2], h0[3]}, o[d0], 0, 0, 0);   \
        o[d0] = __builtin_amdgcn_mfma_f32_32x32x16_bf16(pa1, (bf16x8){l1[0], l1[1], l1[2], l1[3], h1[0], h1[1], h1[2], h1[3]}, o[d0], 0, 0, 0);   \
        o[d0] = __builtin_amdgcn_mfma_f32_32x32x16_bf16(pa2, (bf16x8){l2[0], l2[1], l2[2], l2[3], h2[0], h2[1], h2[2], h2[3]}, o[d0], 0, 0, 0);   \
        o[d0] = __builtin_amdgcn_mfma_f32_32x32x16_bf16(pa3, (bf16x8){l3[0], l3[1], l3[2], l3[3], h3[0], h3[1], h3[2], h3[3]}, o[d0], 0, 0, 0); } while (0)
    PV_D0(0); PV_D0(1); PV_D0(2); PV_D0(3);
#undef PV_D0
#undef TRRD
}

template <class TIn, class TOut> struct BlockRef { const TIn* Q; const TIn* K; const TIn* V; TOut* O; const float* Bias; const TIn* G; int P0; int JLO; };
#define FX_LASU __attribute__((address_space(3))) unsigned
#define BIAS_DMA(ref) do { _Pragma("unroll") for (int i_ = 0; i_ < 2; ++i_) __builtin_amdgcn_global_load_lds((const unsigned*)((ref).Bias + (size_t)(i_ * 512 + tid) * 4), (FX_LASU*)(lds + BIAS_OFF + i_ * 8192 + wid * 1024), 16, 0, 0); } while (0)
template <class TIn> struct Seam {
    bf16x8 qr[8];
    bf16x8 st_v0, st_v1, st_k0, st_k1; f32x4 sf0, sf1, sf2, sf3;
    f32x4 tq[16];
};
__device__ __forceinline__ int swa_jlo(int P0, int W) { const int lowk = P0 - W + 1; return lowk > 0 ? lowk / KVBLK : 0; }
#define ROW(p, k0, rr) ((p) + (size_t)((k0) + (rr)) * RS + sc)
#define VMW() asm volatile("s_waitcnt vmcnt(0)" ::: "memory")
#define VMWN(n) asm volatile("s_waitcnt vmcnt(%0)" :: "i"(n) : "memory")
#define SLOAD_H(Kp, Vp, k0) do { S.st_v0 = load8<TIn>(ROW(Vp, k0, sr)); S.st_v1 = load8<TIn>(ROW(Vp, k0, 32 + sr));              \
                         S.st_k0 = load8<TIn>(ROW(Kp, k0, sr)); S.st_k1 = load8<TIn>(ROW(Kp, k0, 32 + sr)); } while (0)
#define SWRITE_HK(bf) do { *(bf16x8*)(K_lds + (bf) * SHM_K + kws) = S.st_k0; *(bf16x8*)(K_lds + (bf) * SHM_K + kws + 32 * 256) = S.st_k1; } while (0)
#define SWRITE_HV(bf) do { *(bf16x8*)(V_lds + (bf) * SHM_V + vst0) = S.st_v0; *(bf16x8*)(V_lds + (bf) * SHM_V + vst1) = S.st_v1; } while (0)
#define SWRITE_H(bf) do { SWRITE_HV(bf); SWRITE_HK(bf); } while (0)
#define SLOAD_F(p, k0) do { S.sf0 = *(const f32x4*)ROW(p, k0, sr); S.sf1 = *(const f32x4*)(ROW(p, k0, sr) + 4);                \
                            S.sf2 = *(const f32x4*)ROW(p, k0, 32 + sr); S.sf3 = *(const f32x4*)(ROW(p, k0, 32 + sr) + 4); } while (0)
#define SWRITE_KF(bf) do { *(bf16x8*)(K_lds + (bf) * SHM_K + kws) = pack8(S.sf0, S.sf1); *(bf16x8*)(K_lds + (bf) * SHM_K + kws + 32 * 256) = pack8(S.sf2, S.sf3); } while (0)
#define SWRITE_VF(bf) do { *(bf16x8*)(V_lds + (bf) * SHM_V + vst0) = pack8(S.sf0, S.sf1); *(bf16x8*)(V_lds + (bf) * SHM_V + vst1) = pack8(S.sf2, S.sf3); } while (0)
template <class TIn, class TOut>
__device__ __forceinline__ void causal_swa_prime(const BlockRef<TIn, TOut>& cur, int W, char* lds, Seam<TIn>& S, int tid_in) {
    constexpr bool F32 = same_t<TIn, float>::v;
    int tid_l_ = tid_in; asm volatile("" : "+v"(tid_l_));
    const int tid = tid_l_, wid = __builtin_amdgcn_readfirstlane(tid >> 6), lane = tid & 63, r32 = lane & 31, hi = lane >> 5;
    const int sr = tid >> 4, sc = (tid & 15) * 8, kws = KSWZ(sr, sc * 2); char* K_lds = lds + 2 * SHM_V;
    const int kb0 = ((cur.P0 + QB - 1) / KVBLK) * KVBLK;
    for (int d0 = 0; d0 < 8; ++d0) S.qr[d0] = load8<TIn>(cur.Q + (size_t)(wid * QBLK + r32) * RS + d0 * 16 + hi * 8);
    BIAS_DMA(cur);
    if constexpr (F32) { SLOAD_F((const float*)cur.K, kb0); VMW(); SWRITE_KF(0); SBAR(); SLOAD_F((const float*)cur.V, kb0); }
    else { SLOAD_H(cur.K, cur.V, kb0); VMW(); SWRITE_HK(0); }
    __syncthreads();
}
template <class TIn, class TOut>
__device__ __forceinline__ void causal_swa_block(const BlockRef<TIn, TOut>& cur, const BlockRef<TIn, TOut>& nxt, int skv, int W, char* lds, Seam<TIn>& S, int tid_in) {
    constexpr bool F32 = same_t<TIn, float>::v;
    int tid_l_ = tid_in; asm volatile("" : "+v"(tid_l_));
    const int tid = tid_l_, wid = __builtin_amdgcn_readfirstlane(tid >> 6), lane = tid & 63, r32 = lane & 31, hi = lane >> 5;
    const int j_lo = cur.JLO;
    int j_hi = (cur.P0 + QB - 1) / KVBLK + 1; if (j_hi > skv / KVBLK) j_hi = skv / KVBLK;
    const int NT = j_hi - j_lo;
    const int kbn = ((nxt.P0 + QB - 1) / KVBLK) * KVBLK;
    const int qlo = cur.P0 + wid * QBLK, qm = qlo + r32 - 4 * hi;
    char* V_lds = lds; char* K_lds = lds + 2 * SHM_V; const float* bias_l = (const float*)(lds + BIAS_OFF) + 4 * hi;
    float* ws = (float*)(lds + 2 * SHM_V + 2 * SHM_K) + wid * 64; float* li_l = ws, * al_l = ws + 32;
    float m_reg = -1e30f, l_reg = 0; f32x16 o[4] = {};
    const int sr = tid >> 4, sc = (tid & 15) * 8, vst0 = v_st(sr, sc), vst1 = v_st(32 + sr, sc), kws = KSWZ(sr, sc * 2);
    const int vb0 = (int)(uintptr_t)V_lds + v_rd_base(lane);
    const TIn* Kh = cur.K; const TIn* Vh = cur.V;
#define RESC(a) do { if (__any((a) < 1.f)) { if (hi == 0) al_l[r32] = (a); asm volatile("s_waitcnt lgkmcnt(0)" ::: "memory");              \
                     for (int d_ = 0; d_ < 4; ++d_) for (int r = 0; r < 16; ++r) o[d_][r] *= al_l[crow(r, hi)]; } } while (0)
#define KBASE(t) ((j_hi - 1 - (t)) * KVBLK)
#define ACT(t) (KBASE(t) <= qlo + QBLK - 1 && KBASE(t) + KVBLK - 1 >= qlo - W + 1)
#define MASKT(P0_, P1_, t) do { const int kb_ = KBASE(t); if ((!SK || ACT(t)) && (kb_ + KVBLK - 1 > qlo || kb_ <= qlo + QBLK - 1 - W)) mask_tile(P0_, P1_, qm - kb_, (unsigned)W); } while (0)
    constexpr int NQL = F32 ? 16 : 8;
    constexpr bool SK = WSKIP && !F32;
#define SEAM_K0() do { if constexpr (F32) { VMWN(NQL); SWRITE_KF(0); SBAR(); SLOAD_F((const float*)nxt.V, kbn); } else { VMW(); SWRITE_HK(0); } SBAR(); } while (0)
    f32x16 pA0, pA1, pB0, pB1; float mnA, mnB, alA, alB; bf16x8 pa0, pa1, pa2, pa3;
    if constexpr (F32) { VMW(); SWRITE_VF(0); SBAR(); } else { SWRITE_HV(0); SBAR(); }
    if (NT > 1) { if constexpr (F32) SLOAD_F((const float*)Kh, KBASE(1)); else SLOAD_H(Kh, Vh, KBASE(1)); }
    SBAR(); qkt<0, SK>(pA0, pA1, K_lds, r32, hi, S.qr, ACT(0), bias_l + KBASE(0));
    if constexpr (F32) { if (NT > 1) { VMW(); SWRITE_KF(1); SBAR(); SLOAD_F((const float*)Vh, KBASE(1)); } }
    bool dA = false, dB = false;
    MASKT(pA0, pA1, 0); partialSM(pA0, pA1, m_reg, mnA, alA, dA);
    if (NT > 1) { VMW(); if constexpr (F32) { SWRITE_VF(1); SBAR(); if (NT > 2) SLOAD_F((const float*)Kh, KBASE(2)); } else SWRITE_H(1); }
    __syncthreads();
#define HALF_STEP(PX0, PX1, mnX, alX, dX, PY0, PY1, alY, dY, t, KB, VB, SB) do {                                                      \
        if constexpr (!F32) { if ((t) + 1 < NT) SLOAD_H(Kh, Vh, KBASE((t) + 1)); }     \
        SBAR(); qkt<KB, SK>(PX0, PX1, K_lds, r32, hi, S.qr, ACT(t), bias_l + KBASE(t));                                             \
        if (!(dY)) finishSM(PY0, PY1, alY, l_reg, pa0, pa1, pa2, pa3); SBAR();                                                \
        if ((t) + 1 < NT) { if constexpr (F32) { VMW(); SWRITE_KF(SB); SBAR(); SLOAD_F((const float*)Vh, KBASE((t) + 1)); }  \
                            SBAR(); }                                                                                        \
        if (!(dY)) pv_tile<VB, SK>(o, vb0, pa0, pa1, pa2, pa3, ACT((t) - 1)); MASKT(PX0, PX1, (t)); partialSM(PX0, PX1, m_reg, mnX, alX, dX);                                        \
        __syncthreads();                                                                                                      \
        if ((t) + 1 < NT) { VMW(); if constexpr (F32) { SWRITE_VF(SB); SBAR(); if ((t) + 2 < NT) SLOAD_F((const float*)Kh, KBASE((t) + 2)); } \
                            else { SWRITE_H(SB); } }                                                                          \
        RESC(alX); __syncthreads(); } while (0)
    for (int t = 1; t + 1 < NT; t += 2) {
        HALF_STEP(pB0, pB1, mnB, alB, dB, pA0, pA1, alA, dA, t, 1, 0, 0);
        HALF_STEP(pA0, pA1, mnA, alA, dA, pB0, pB1, alB, dB, t + 1, 0, 1, 1);
    }
    const bool even = (NT & 1) == 0;
    if (even) { SBAR(); qkt<1, SK>(pB0, pB1, K_lds, r32, hi, S.qr, ACT(NT - 1), bias_l + KBASE(NT - 1)); SBAR(); } else { BIAS_DMA(nxt); }
    { const char* gsrc_ = (const char*)(cur.G + (size_t)(wid * QBLK + (lane >> 4)) * RS + (lane & 15) * 8);
      _Pragma("unroll") for (int i_ = 0; i_ < 8; ++i_) __builtin_amdgcn_global_load_lds((const unsigned*)(gsrc_ + (size_t)i_ * 4 * RS * 2), (FX_LASU*)(lds + GATE_OFF + wid * 8192 + i_ * 1024), 16, 0, 0); }
#define QROW(e) (nxt.Q + (size_t)(wid * QBLK + r32) * RS + ((e) >> 1) * 16 + hi * 8 + ((e) & 1) * 4)
    if constexpr (F32) { SLOAD_F((const float*)nxt.K, kbn); SBAR();
#pragma unroll
        for (int e = 0; e < 8; ++e) S.tq[e] = *(const f32x4*)QROW(e); }
    else { SLOAD_H(nxt.K, nxt.V, kbn); SBAR();
#pragma unroll
        for (int d0 = 0; d0 < 8; ++d0) S.qr[d0] = load8<TIn>(nxt.Q + (size_t)(wid * QBLK + r32) * RS + d0 * 16 + hi * 8); }
    SBAR();
    if (!dA) finishSM(pA0, pA1, alA, l_reg, pa0, pa1, pa2, pa3); SBAR();
    if constexpr (F32) {
#pragma unroll
        for (int e = 8; e < 16; ++e) S.tq[e] = *(const f32x4*)QROW(e); SBAR(); }
#undef QROW
    if (!dA) pv_tile<0, SK>(o, vb0, pa0, pa1, pa2, pa3, ACT(even ? NT - 2 : NT - 1));
    if (even) { MASKT(pB0, pB1, NT - 1); partialSM(pB0, pB1, m_reg, mnB, alB, dB); __syncthreads(); BIAS_DMA(nxt); RESC(alB);
        if (!dB) { finishSM(pB0, pB1, alB, l_reg, pa0, pa1, pa2, pa3); SBAR(); pv_tile<1, SK>(o, vb0, pa0, pa1, pa2, pa3, ACT(NT - 1)); } }
    SBAR(); SEAM_K0();
    if (hi == 0) li_l[r32] = l_reg; asm volatile("s_waitcnt lgkmcnt(0)" ::: "memory");
    float rli[16];
#pragma unroll
    for (int r = 0; r < 16; ++r) rli[r] = __builtin_amdgcn_rcpf(li_l[crow(r, hi)]);
    TOut* Owl = cur.O + (size_t)(wid * QBLK + 4 * hi) * OS + r32; const char* gll = lds + GATE_OFF + wid * 8192 + hi * 1024 + r32 * 2;
#pragma unroll
    for (int r = 0; r < 16; ++r) { constexpr int dummy_ = 0; const int rc = (r & 3) + 8 * (r >> 2);
#pragma unroll
        for (int d0 = 0; d0 < 4; ++d0) { const float v = o[d0][r] * rli[r];
            const float vn = mk_xor1(v);
            if ((r32 & 1) == 0) { const unsigned gg = *(const unsigned*)(gll + rc * 256 + d0 * 64);
                const float g0 = __uint_as_float(gg << 16), g1 = __uint_as_float(gg & 0xffff0000u);
                const float s0 = __builtin_amdgcn_rcpf(1.f + __expf(-g0)), s1 = __builtin_amdgcn_rcpf(1.f + __expf(-g1));
                *(unsigned*)(Owl + (size_t)rc * OS + d0 * 32) = cvtpk(v * s0, vn * s1); } }
        SBAR(); }
    if constexpr (F32) {
#pragma unroll
        for (int d0 = 0; d0 < 8; ++d0) S.qr[d0] = pack8(S.tq[2 * d0], S.tq[2 * d0 + 1]); }
    __syncthreads();
#undef RESC
#undef KBASE
#undef ACT
#undef MASKT
#undef SEAM_K0
#undef HALF_STEP
}
#undef ROW
#undef VMW
#undef VMWN
#undef SLOAD_H
#undef SWRITE_HK
#undef SWRITE_HV
#undef SWRITE_H
#undef SLOAD_F
#undef SWRITE_KF
#undef SWRITE_VF

}

typedef unsigned short bf16_t;
typedef float f32x4 __attribute__((ext_vector_type(4)));
typedef float f32x16 __attribute__((ext_vector_type(16)));
typedef float f32x2 __attribute__((ext_vector_type(2)));
typedef short bf16x8 __attribute__((ext_vector_type(8)));
typedef short bf16x4 __attribute__((ext_vector_type(4)));
typedef unsigned u32x4 __attribute__((ext_vector_type(4)));
typedef unsigned u32x2 __attribute__((ext_vector_type(2)));
constexpr int DM = 2048, NBATCH = 4, SEQ = 4096, MTOK = NBATCH * SEQ, DFF = 5632;
constexpr float LN_EPS = 1e-5f, RMS_EPS = 1e-5f, DN_ALPHA = 1.6817928305074290f;
constexpr size_t MiB = 1u << 20;
constexpr size_t WS_CTL = 0, CTL_ZERO_BYTES = 1 * MiB;
constexpr size_t WS_MOD = 1 * MiB;
constexpr size_t WS_SK16 = 2 * MiB;
constexpr size_t WS_FB = 3 * MiB;
constexpr size_t WS_ELAST = 4 * MiB;
constexpr size_t WS_ST = 5 * MiB;
constexpr size_t WS_ID = 5 * MiB + 512 * 1024;
constexpr size_t WS_WFOX = 8 * MiB;
constexpr size_t WS_WGLA = 88 * MiB;
constexpr size_t WS_WCONV = 120 * MiB;
constexpr size_t WS_WUP = 152 * MiB;
constexpr size_t WS_WDOWN = 328 * MiB;
constexpr size_t WS_H = 416 * MiB;
constexpr size_t WS_PROJ = 480 * MiB;
constexpr size_t WS_ACT = 832 * MiB;
constexpr size_t WS_QD = 1008 * MiB, WS_KI = 1040 * MiB, WS_KDT = 1072 * MiB, WS_VT = 1104 * MiB;
constexpr size_t WS_OINT = 1168 * MiB;
constexpr size_t WS_QDF = 1296 * MiB;
constexpr size_t WS_N2P = 1328 * MiB;
constexpr size_t WS_XB = 1336 * MiB;
constexpr size_t WS_END = 1400 * MiB;
constexpr int LDS_TOTAL = 163840, MISC_OFF = LDS_TOTAL - 64;
constexpr int CW_BAR = 4096;

__device__ __forceinline__ float bf2f(unsigned short b) { return __uint_as_float(((unsigned)b) << 16); }
__device__ __forceinline__ unsigned pk2(float lo, float hi) { return pg8::cvt_pk_bf16(lo, hi); }
__device__ __forceinline__ unsigned short f2bf(float f) { return (unsigned short)(pk2(f, 0.f) & 0xffffu); }
template <int CTRL> __device__ __forceinline__ float dpp_rot(float v) { return __builtin_bit_cast(float, __builtin_amdgcn_update_dpp(0, __builtin_bit_cast(int, v), CTRL, 0xf, 0xf, false)); }
__device__ __forceinline__ float wave_sum(float v) {
    v += dpp_rot<0x128>(v); v += dpp_rot<0x124>(v); v += dpp_rot<0x122>(v); v += dpp_rot<0x121>(v);
    { auto rr = __builtin_amdgcn_permlane16_swap(__float_as_uint(v), __float_as_uint(v), false, false); v = __uint_as_float(rr[0]) + __uint_as_float(rr[1]); }
    { auto rr = __builtin_amdgcn_permlane32_swap(__float_as_uint(v), __float_as_uint(v), false, false); v = __uint_as_float(rr[0]) + __uint_as_float(rr[1]); }
    return v;
}
__device__ __forceinline__ float log_sigmoid(float x) { return fminf(x, 0.f) - __logf(1.f + __expf(-fabsf(x))); }
__device__ __forceinline__ float silu_f(float x) { return x * __builtin_amdgcn_rcpf(1.f + __expf(-x)); }
__device__ __forceinline__ int crow(int r, int hi) { return (r & 3) + 8 * (r >> 2) + 4 * hi; }
__device__ __forceinline__ void cvt8(const u32x4 w, float (&f)[8]) {
    f[0] = __uint_as_float(w.x << 16); f[1] = __uint_as_float(w.x & 0xffff0000u); f[2] = __uint_as_float(w.y << 16); f[3] = __uint_as_float(w.y & 0xffff0000u);
    f[4] = __uint_as_float(w.z << 16); f[5] = __uint_as_float(w.z & 0xffff0000u); f[6] = __uint_as_float(w.w << 16); f[7] = __uint_as_float(w.w & 0xffff0000u);
}
__device__ __forceinline__ u32x4 pack8f(const float (&f)[8]) { u32x4 w; w.x = pk2(f[0], f[1]); w.y = pk2(f[2], f[3]); w.z = pk2(f[4], f[5]); w.w = pk2(f[6], f[7]); return w; }

#define XB_TMO      128
#define XB_XCNT(j)  (256  + 64 * (j))
#define XB_XSUB(j)  (1280 + 64 * (j))
#define XB_XGEN(j)  (2304 + 64 * (j))
#define XB_TOP      3328
#define XB_TOPGEN   3392
#define XCD_BAR_WORDS 3456
#define XB_SPIN_CAP (1u << 18)
#define LAS __attribute__((address_space(3)))

__device__ __forceinline__ unsigned xb_ld(unsigned* p)              { return __hip_atomic_load(p, __ATOMIC_RELAXED, __HIP_MEMORY_SCOPE_AGENT); }
__device__ __forceinline__ unsigned xb_add(unsigned* p, unsigned v) { return __hip_atomic_fetch_add(p, v, __ATOMIC_RELAXED, __HIP_MEMORY_SCOPE_AGENT); }
__device__ __forceinline__ unsigned xb_xcc_id() { return (unsigned)__builtin_amdgcn_s_getreg((3 << 11) | 20) & 0xFu; }
#define XB_SPIN(cond, bar) do { unsigned _sp = 0; while (cond) { __builtin_amdgcn_s_sleep(1); \
    if ((++_sp & 255u) == 0u) { if (xb_ld(&(bar)[XB_TMO])) break; if (_sp > XB_SPIN_CAP) { atomicAdd(&(bar)[XB_TMO], 1u); break; } } } } while (0)

struct XcdBarrier {
    unsigned* bar; unsigned x;
    volatile LAS unsigned* st;
};

__device__ __forceinline__ XcdBarrier xcd_barrier_post(unsigned* bar, volatile LAS unsigned* st, int xb_tid) {
    XcdBarrier b; b.bar = bar; b.x = xb_xcc_id(); b.st = st;
    if (xb_tid == 0) (void)xb_add(&bar[XB_XCNT(b.x)], 1u);
    return b;
}
__device__ __forceinline__ void xcd_barrier_complete(unsigned* bar, unsigned x, unsigned& nloc, unsigned& nx) {
    const unsigned G = gridDim.x * gridDim.y * gridDim.z;
    unsigned sum, cnt, mine, sp = 0u;
    for (;;) {
        sum = 0u; cnt = 0u; mine = 0u;
#pragma unroll
        for (unsigned j = 0; j < 16; ++j) { const unsigned c = xb_ld(&bar[XB_XCNT(j)]); sum += c; cnt += (c > 0u) ? 1u : 0u; mine = (j == x) ? c : mine; }
        if (sum == G) break;
        __builtin_amdgcn_s_sleep(1);
        if ((++sp & 255u) == 0u) { if (xb_ld(&bar[XB_TMO])) break; if (sp > XB_SPIN_CAP) { atomicAdd(&bar[XB_TMO], 1u); break; } }
    }
    nloc = mine > 0u ? mine : 1u; nx = cnt > 0u ? cnt : 1u;
}

__device__ __forceinline__ void xcd_barrier(const XcdBarrier& b, int xb_tid) {
    asm volatile("s_waitcnt vmcnt(0)" ::: "memory");
    __syncthreads();
    if (xb_tid == 0) {
        unsigned* bar = b.bar;
        __builtin_amdgcn_s_waitcnt(0);
        unsigned nloc = b.st[0], nx = b.st[1];
        if (nloc == 0u) { xcd_barrier_complete(bar, b.x, nloc, nx); b.st[0] = nloc; b.st[1] = nx; }
        const unsigned old = xb_add(&bar[XB_XSUB(b.x)], 1u);
        const unsigned gen = old / nloc;
        if (old + 1u == (gen + 1u) * nloc) {
            __builtin_amdgcn_fence(__ATOMIC_RELEASE, "agent");
            asm volatile("s_waitcnt vmcnt(0)" ::: "memory");
            const unsigned og = xb_add(&bar[XB_TOP], 1u);
            const unsigned tg = og / nx;
            if (og + 1u == (tg + 1u) * nx) xb_add(&bar[XB_TOPGEN], 1u);
            else XB_SPIN(xb_ld(&bar[XB_TOPGEN]) == tg, bar);
            __builtin_amdgcn_fence(__ATOMIC_ACQUIRE, "agent");
            xb_add(&bar[XB_XGEN(b.x)], 1u);
            asm volatile("s_waitcnt vmcnt(0)" ::: "memory");
        } else {
            XB_SPIN(xb_ld(&bar[XB_XGEN(b.x)]) == gen, bar);
            __builtin_amdgcn_fence(__ATOMIC_ACQUIRE, "agent");
            asm volatile("s_waitcnt vmcnt(0)" ::: "memory");
        }
    }
    __syncthreads();
}


#define MK_GRID_VARS int BID = blockIdx.x, NBLK = gridDim.x; asm volatile("" : "+s"(BID), "+s"(NBLK))
struct Args { const float* in[31]; float* out; unsigned char* ws; int ph_lo, ph_hi, flags, pad; };

#define P0_AS1 __attribute__((address_space(1)))
struct P0Item { const float* W; bf16_t* WT; int K, N, rbase, k0, n0; };
__device__ __forceinline__ void p0_load(const P0Item& q, f32x4 (&v)[8], int lane) {
    const P0_AS1 float* src = (const P0_AS1 float*)q.W + (size_t)(q.k0 + (lane >> 3)) * q.N + q.n0 + 4 * (lane & 7);
#pragma unroll
    for (int i = 0; i < 8; ++i) v[i] = *(const P0_AS1 f32x4*)(src + (size_t)(8 * i) * q.N);
}
__device__ __forceinline__ void p0_store(const P0Item& q, const f32x4 (&v)[8], LAS float* scr, int lane) {
#pragma unroll
    for (int i = 0; i < 8; ++i) { LAS float* d = scr + (8 * i + (lane >> 3)) * 33 + 4 * (lane & 7); d[0] = v[i][0]; d[1] = v[i][1]; d[2] = v[i][2]; d[3] = v[i][3]; }
    asm volatile("s_waitcnt lgkmcnt(0)" ::: "memory");
    const int c = lane & 7;
#pragma unroll
    for (int j = 0; j < 4; ++j) { const int n = (lane >> 3) + 8 * j; const LAS float* s = scr + (8 * c) * 33 + n;
        u32x4 o; o.x = pk2(s[0 * 33], s[1 * 33]); o.y = pk2(s[2 * 33], s[3 * 33]); o.z = pk2(s[4 * 33], s[5 * 33]); o.w = pk2(s[6 * 33], s[7 * 33]);
        *(P0_AS1 u32x4*)((P0_AS1 bf16_t*)q.WT + (size_t)(q.rbase + n) * q.K + q.k0 + 8 * c) = o; }
    asm volatile("s_waitcnt lgkmcnt(0)" ::: "memory");
}
typedef const __attribute__((address_space(4))) Args CArgs;
__device__ __forceinline__ void phase_prologue(CArgs* ap, unsigned char* lds, int tid, int wid, int lane) {
    MK_GRID_VARS;
    unsigned char* ws = ap->ws;
    for (int t = BID; t < 192; t += NBLK) {
        float* cond = (float*)lds;
        for (int i = tid; i < 4 * DM; i += 512) { const float c = ap->in[1][i]; cond[i] = c / (1.f + __expf(-c)); }
        __syncthreads();
        const int l = t / 48, col0 = (t % 48) * 256;
        const float* wp = ap->in[2] + ((size_t)l * DM + wid * 256) * 12288 + col0 + 4 * lane;
        f32x4 acc[4] = {{0.f, 0.f, 0.f, 0.f}, {0.f, 0.f, 0.f, 0.f}, {0.f, 0.f, 0.f, 0.f}, {0.f, 0.f, 0.f, 0.f}};
#pragma unroll 8
        for (int k = 0; k < 256; ++k) { const f32x4 wv = *(const f32x4*)(wp + (size_t)k * 12288); const int kk = wid * 256 + k;
#pragma unroll
            for (int b = 0; b < 4; ++b) acc[b] += cond[b * DM + kk] * wv; }
        float* red = (float*)(lds + 32768);
#pragma unroll
        for (int b = 0; b < 4; ++b) *(f32x4*)(red + ((wid * 4 + b) * 256 + 4 * lane)) = acc[b];
        __syncthreads();
        float* mod = (float*)(ws + WS_MOD);
        for (int idx = tid; idx < 1024; idx += 512) { const int b = idx >> 8, col = idx & 255; float s = ap->in[3][l * 12288 + col0 + col];
#pragma unroll
            for (int w = 0; w < 8; ++w) s += red[(w * 4 + b) * 256 + col];
            mod[(size_t)(l * 4 + b) * 12288 + col0 + col] = s; }
        __syncthreads();
    }
    LAS float* scr = (LAS float*)((LAS unsigned char*)lds + wid * 16384);
    const int gw = BID * 8 + wid, NGW = NBLK * 8;
    bf16_t* wfox0 = (bf16_t*)(ws + WS_WFOX); bf16_t* wfox1 = (bf16_t*)(ws + WS_WFOX + 40 * MiB);
    bf16_t* wgla = (bf16_t*)(ws + WS_WGLA); bf16_t* wconv = (bf16_t*)(ws + WS_WCONV);
    bf16_t* wup = (bf16_t*)(ws + WS_WUP); bf16_t* wdn = (bf16_t*)(ws + WS_WDOWN);
    constexpr int I_DD = (DM / 64) * (DM / 32), I_DH = (DM / 64) * (1024 / 32), I_D3 = (DM / 64) * (6144 / 32), I_UP = (DM / 64) * (11264 / 32), I_DN = (DFF / 64) * (DM / 32);
    constexpr int NITEMS = 10 * I_DD + 2 * I_DH + 3 * I_DD + I_D3 + I_DD + 4 * I_UP + 4 * I_DN;
    constexpr size_t DD = (size_t)DM * DM;
#define TJOB(SRC, KK, NN, DST, ROFF, CNT) if (!found) { if (r < (CNT)) { q.W = (SRC); q.K = (KK); q.N = (NN); q.WT = (DST); roff = (ROFF); found = true; } else r -= (CNT); }
    auto item = [&](int it) -> P0Item {
        P0Item q; q.W = nullptr; q.WT = nullptr; q.K = 64; q.N = 32; int roff = 0, r = it; bool found = false;
        TJOB(ap->in[8], DM, DM, wfox0, 0, I_DD) TJOB(ap->in[9], DM, DM, wfox0, 2048, I_DD) TJOB(ap->in[10], DM, DM, wfox0, 4096, I_DD) TJOB(ap->in[11], DM, DM, wfox0, 6144, I_DD)
        TJOB(ap->in[14], DM, DM, wfox0 + (size_t)8192 * DM, 0, I_DD)
        TJOB(ap->in[8] + DD, DM, DM, wfox1, 0, I_DD) TJOB(ap->in[9] + DD, DM, DM, wfox1, 2048, I_DD) TJOB(ap->in[10] + DD, DM, DM, wfox1, 4096, I_DD) TJOB(ap->in[11] + DD, DM, DM, wfox1, 6144, I_DD)
        TJOB(ap->in[14] + DD, DM, DM, wfox1 + (size_t)8192 * DM, 0, I_DD)
        TJOB(ap->in[15], DM, 1024, wgla, 0, I_DH) TJOB(ap->in[16], DM, 1024, wgla, 1024, I_DH) TJOB(ap->in[17], DM, DM, wgla, 2048, I_DD) TJOB(ap->in[21], DM, DM, wgla, 4096, I_DD)
        TJOB(ap->in[23], DM, DM, wgla + (size_t)6144 * DM, 0, I_DD)
        TJOB(ap->in[24], DM, 6144, wconv, 0, I_D3) TJOB(ap->in[26], DM, DM, wconv + (size_t)6144 * DM, 0, I_DD)
        TJOB(ap->in[27], DM, 11264, wup, -1, I_UP) TJOB(ap->in[27] + (size_t)1 * DM * 11264, DM, 11264, wup + (size_t)1 * 11264 * DM, -1, I_UP)
        TJOB(ap->in[27] + (size_t)2 * DM * 11264, DM, 11264, wup + (size_t)2 * 11264 * DM, -1, I_UP) TJOB(ap->in[27] + (size_t)3 * DM * 11264, DM, 11264, wup + (size_t)3 * 11264 * DM, -1, I_UP)
        TJOB(ap->in[30], DFF, DM, wdn, 0, I_DN) TJOB(ap->in[30] + (size_t)1 * DFF * DM, DFF, DM, wdn + (size_t)1 * DM * DFF, 0, I_DN)
        TJOB(ap->in[30] + (size_t)2 * DFF * DM, DFF, DM, wdn + (size_t)2 * DM * DFF, 0, I_DN) TJOB(ap->in[30] + (size_t)3 * DFF * DM, DFF, DM, wdn + (size_t)3 * DM * DFF, 0, I_DN)
        const int nblk = q.N / 32, kb = r / nblk, nb = r % nblk; q.k0 = 64 * kb; q.n0 = 32 * nb;
        q.rbase = roff + q.n0; if (roff < 0) { const int half = q.n0 >= DFF ? 1 : 0, ch = q.n0 - half * DFF; q.rbase = 256 * (ch >> 7) + 128 * half + (ch & 127); }
        return q; };
    if (gw < NITEMS) {
        f32x4 va[8], vb[8]; int it = gw;
        P0Item qa = item(it), qb; p0_load(qa, va, lane);
        for (;;) {
            { const int itn = it + NGW; const bool hn = itn < NITEMS; qb = item(hn ? itn : it); p0_load(qb, vb, lane); p0_store(qa, va, scr, lane); if (!hn) break; it = itn; }
            { const int itn = it + NGW; const bool hn = itn < NITEMS; qa = item(hn ? itn : it); p0_load(qa, va, lane); p0_store(qb, vb, scr, lane); if (!hn) break; it = itn; }
        }
    }
#undef TJOB
}

template <bool SRC_BF, bool SK>
__device__ __forceinline__ void phase_lnmod(const void* src, float* X, bf16_t* H, bool do_ln, bool do_mod, const float* lng, const float* lnb,
                                            const float* sc, const float* sh, int sk_mode, const float* skW, const float* skB, float* sk_out, float* stats,
                                            unsigned char* lds, int tid, int wid, int lane) {
    MK_GRID_VARS;
    if constexpr (SK) {
        f32x4* Wl = (f32x4*)lds;
        for (int idx = tid; idx < 8192; idx += 512) { const int ln = idx & 63, q = (idx >> 6) & 3, i = (idx >> 8) & 3, j = idx >> 10;
            Wl[idx] = *(const f32x4*)(skW + (size_t)(256 * j + 4 * ln + i) * 16 + 4 * q); }
        __syncthreads();
    }
    if (stats && BID == 0) for (int i = tid; i < DM; i += 512) { stats[2 * MTOK + i] = DN_ALPHA * (do_ln ? lng[i] : 1.f); stats[2 * MTOK + DM + i] = DN_ALPHA * (do_ln ? lnb[i] : 0.f); }
    const int nw = NBLK * 8, gw = BID * 8 + wid, R = (MTOK + nw - 1) / nw, row_begin = gw * R, row_end = (row_begin + R < MTOK) ? row_begin + R : MTOK;
    if (row_begin < row_end) {
        constexpr bool DIST2 = SRC_BF && !SK;
        f32x4 gs[8], bs[8]; f32x4 vn[8]; u32x2 vbA[8], vbB[8];
#define LN_LOAD_ROW(r, VB) do { if constexpr (SRC_BF) { const u32x2* xr = (const u32x2*)((const bf16_t*)src + (size_t)(r) * DM) + lane; _Pragma("unroll") for (int j = 0; j < 8; ++j) VB[j] = xr[64 * j]; } \
                            else { const f32x4* xr = (const f32x4*)((const float*)src + (size_t)(r) * DM) + lane; _Pragma("unroll") for (int j = 0; j < 8; ++j) vn[j] = xr[64 * j]; } } while (0)
#define LN_ROW(row_, v, VB) do { float s_ = 0.f;                                                                                                                     \
            _Pragma("unroll") for (int j = 0; j < 8; ++j) {                                                                                                      \
                if constexpr (SRC_BF) { v[j][0] = __uint_as_float(VB[j].x << 16); v[j][1] = __uint_as_float(VB[j].x & 0xffff0000u); v[j][2] = __uint_as_float(VB[j].y << 16); v[j][3] = __uint_as_float(VB[j].y & 0xffff0000u); } \
                else v[j] = vn[j];                                                                                                                               \
                s_ += (v[j][0] + v[j][1]) + (v[j][2] + v[j][3]); }                                                                                               \
            if constexpr (DIST2) { if ((row_) + 2 < row_lim) LN_LOAD_ROW((row_) + 2, VB); } else { if ((row_) + 1 < row_lim) LN_LOAD_ROW((row_) + 1, VB); }                                                                                                   \
            float mean_ = 0.f, rstd_ = 1.f;                                                                                                                      \
            if (do_ln) {                                                                                                                                         \
                mean_ = wave_sum(s_) * (1.f / DM); float s2_ = 0.f;                                                                                              \
                _Pragma("unroll") for (int j = 0; j < 8; ++j) { v[j] = v[j] - mean_; s2_ += (v[j][0] * v[j][0] + v[j][1] * v[j][1]) + (v[j][2] * v[j][2] + v[j][3] * v[j][3]); } \
                rstd_ = 1.f / sqrtf(wave_sum(s2_) * (1.f / DM) + LN_EPS);                                                                                        \
                _Pragma("unroll") for (int j = 0; j < 8; ++j) v[j] = (v[j] * rstd_) * gs[j] + bs[j];                                                             \
            } else {                                                                                                                                             \
                _Pragma("unroll") for (int j = 0; j < 8; ++j) v[j] = v[j] * gs[j] + bs[j];                                                                       \
            }                                                                                                                                                    \
            if (stats) { if (lane == 0) { f32x2 st; st[0] = mean_; st[1] = rstd_; *(f32x2*)(stats + (size_t)(row_) * 2) = st; } }                                \
            else { f32x4* xo = (f32x4*)(X + (size_t)(row_) * DM) + lane; _Pragma("unroll") for (int j = 0; j < 8; ++j) xo[64 * j] = v[j]; }                      \
            if (do_mod) { u32x2* ho = (u32x2*)(H + (size_t)(row_) * DM) + lane;                                                                                  \
                _Pragma("unroll") for (int j = 0; j < 8; ++j) { u32x2 w; w.x = pk2(v[j][0], v[j][1]); w.y = pk2(v[j][2], v[j][3]); ho[64 * j] = w; } } } while (0)
        if (!do_mod) {
#pragma unroll
            for (int j = 0; j < 8; ++j) { gs[j] = ((const f32x4*)lng)[64 * j + lane]; bs[j] = ((const f32x4*)lnb)[64 * j + lane]; } }
        for (int seg = row_begin; seg < row_end; ) {
            const int cur_b = seg >> 12, seg_lim = (cur_b + 1) << 12, row_lim = seg_lim < row_end ? seg_lim : row_end;
            if (do_mod) {
                const f32x4* sc4 = (const f32x4*)(sc + (size_t)cur_b * 12288) + lane; const f32x4* sh4 = (const f32x4*)(sh + (size_t)cur_b * 12288) + lane;
#pragma unroll
                for (int j = 0; j < 8; ++j) { const f32x4 s1 = 1.f + sc4[64 * j], s0 = sh4[64 * j];
                    if (do_ln) { gs[j] = ((const f32x4*)lng)[64 * j + lane] * s1; bs[j] = ((const f32x4*)lnb)[64 * j + lane] * s1 + s0; } else { gs[j] = s1; bs[j] = s0; } } }
            LN_LOAD_ROW(seg, vbA);
            if constexpr (DIST2) { if (seg + 1 < row_lim) LN_LOAD_ROW(seg + 1, vbB); }
            if constexpr (!SK) {
                for (int row = seg; row < row_lim; row += 2) { f32x4 v[8]; LN_ROW(row, v, vbA); if (row + 1 < row_lim) { if constexpr (DIST2) { LN_ROW(row + 1, v, vbB); } else { LN_ROW(row + 1, v, vbA); } } }
            } else {
                for (int row = seg; row < row_lim; row += 2) {
                    f32x4 va[8], vc[8];
                    LN_ROW(row, va, vbA);
                    const bool two = row + 1 < row_lim;
                    if (two) { LN_ROW(row + 1, vc, vbA); }
                    else {
#pragma unroll
                        for (int j = 0; j < 8; ++j) vc[j] = va[j]; }
                    const f32x4* Wl = (const f32x4*)lds + lane;
                    f32x2 aa[8], ac[8];
#pragma unroll
                    for (int n = 0; n < 8; ++n) { aa[n][0] = 0.f; aa[n][1] = 0.f; ac[n] = aa[n]; }
#pragma unroll
                    for (int j = 0; j < 8; ++j)
#pragma unroll
                        for (int i = 0; i < 4; ++i) { f32x2 ha, hc; ha[0] = va[j][i]; ha[1] = va[j][i]; hc[0] = vc[j][i]; hc[1] = vc[j][i];
#pragma unroll
                            for (int q = 0; q < 4; ++q) { const f32x4 w = Wl[((j * 4 + i) * 4 + q) * 64]; f32x2 w01, w23; w01[0] = w[0]; w01[1] = w[1]; w23[0] = w[2]; w23[1] = w[3];
                                aa[2 * q] = __builtin_elementwise_fma(ha, w01, aa[2 * q]); aa[2 * q + 1] = __builtin_elementwise_fma(ha, w23, aa[2 * q + 1]);
                                ac[2 * q] = __builtin_elementwise_fma(hc, w01, ac[2 * q]); ac[2 * q + 1] = __builtin_elementwise_fma(hc, w23, ac[2 * q + 1]); }
                            if (i == 3) __builtin_amdgcn_sched_barrier(0); }
                    float mine_a = 0.f, mine_c = 0.f;
#pragma unroll
                    for (int n = 0; n < 16; ++n) { const float ta = wave_sum(aa[n >> 1][n & 1]), tc = wave_sum(ac[n >> 1][n & 1]); mine_a = (lane == n) ? ta : mine_a; mine_c = (lane == n) ? tc : mine_c; }
                    if (lane < 16) { float bias = 0.f; if (sk_mode == 1) { bias = skB[lane]; mine_a = log_sigmoid(mine_a + bias); mine_c = log_sigmoid(mine_c + bias); }
                        if (sk_mode == 1) { float* so = sk_out + ((size_t)((row >> 12) * 16 + lane) << 12) + (row & 4095);
                            so[0] = mine_a; if (two) so[1] = mine_c; }
                        else { sk_out[(size_t)row * 16 + lane] = mine_a; if (two) sk_out[(size_t)(row + 1) * 16 + lane] = mine_c; } }
                }
            }
            seg = row_lim;
        }
#undef LN_ROW
    }
}

#undef LN_LOAD_ROW
__device__ __forceinline__ void fox_cumsum(const float* logf  , float* FB  , int wid, int lane) {
    MK_GRID_VARS;
    for (int u = BID * 8 + wid; u < 64; u += NBLK * 8) {
        const int b = u >> 4, hh = u & 15;
        const float* lf = logf + (size_t)u * SEQ + lane * 64; (void)b; (void)hh;
        float v[64]; float s = 0.f;
#pragma unroll
        for (int t = 0; t < 64; t += 4) { const f32x4 x = *(const f32x4*)(lf + t); v[t] = x[0]; v[t + 1] = x[1]; v[t + 2] = x[2]; v[t + 3] = x[3]; }
#pragma unroll
        for (int t = 0; t < 64; ++t) { s += v[t]; v[t] = s; }
        float pre = s;
#pragma unroll
        for (int o = 1; o < 64; o <<= 1) { const float t = mk_shfl_up(pre, o); if (lane >= o) pre += t; }
        const float excl = pre - s;
        float* out = FB + (size_t)u * SEQ + lane * 64;
#pragma unroll
        for (int t = 0; t < 64; t += 4) { f32x4 o4; o4[0] = -(excl + v[t]) * 11.313708499f; o4[1] = -(excl + v[t + 1]) * 11.313708499f; o4[2] = -(excl + v[t + 2]) * 11.313708499f; o4[3] = -(excl + v[t + 3]) * 11.313708499f;
            *(f32x4*)(out + t) = o4; }
    }
}

constexpr float T_SKIP = 24.f;
__device__ __forceinline__ void phase_fox_attn(const bf16_t* PROJ, const float* FB, const float* N2P, bf16_t* O, char* lds, int tid) {
    MK_GRID_VARS;
    using namespace fx;
    typedef BlockRef<bf16, bf16> Ref;
    const int total = 512, stride = NBLK, lane = tid & 63, wid = __builtin_amdgcn_readfirstlane(tid >> 6);
    float* kmx = (float*)(lds + 2 * SHM_V + 2 * SHM_K);
    float* qmx = kmx + 64;
    int* jlo_l = (int*)(lds + LDS_BYTES);
    int* tab = (int*)(lds + LDS_BYTES + 64);
    const bool use_tab = NBLK == 256;
    if (use_tab) {
        if (wid == 0) {
            const float wv = FB[(size_t)lane * SEQ + SEQ - 1];
            const float Wh = mk_sum_xor32(mk_sum_xor16(wv));
            int rank = 0;
#pragma unroll
            for (int hp = 0; hp < 16; ++hp) { const float o = __uint_as_float(__builtin_amdgcn_readlane(__float_as_uint(Wh), hp)); rank += (o < Wh || (o == Wh && hp < (lane & 15))) ? 1 : 0; }
            const int x = BID & 7;
            const unsigned long long mA = __ballot(rank == x && lane < 16), mB = __ballot(rank == 15 - x && lane < 16);
            const int hA = (int)__builtin_ctzll(mA), hB = (int)__builtin_ctzll(mB);
            const int r = lane & 7, bh = ((lane >> 3) & 3) * 16 + ((lane >> 5) ? hB : hA);
            const float wi = __builtin_bit_cast(float, __builtin_amdgcn_ds_bpermute(bh << 2, __builtin_bit_cast(int, wv)));
            const float Wt = (T_SKIP + 30.f) * (4095.f / 64.f) / (wi * SCALE);
            const float est = fminf(4.f * r, Wt) + fminf(4.f * (15 - r), Wt);
            int rk = 0;
#pragma unroll
            for (int o = 0; o < 64; ++o) { const float e = __uint_as_float(__builtin_amdgcn_readlane(__float_as_uint(est), o)); rk += (e > est || (e == est && o < lane)) ? 1 : 0; }
            const int j = BID >> 3;
            const int i1 = (int)__builtin_ctzll(__ballot(rk == j)), i2 = (int)__builtin_ctzll(__ballot(rk == 63 - j));
            const int t0 = __builtin_amdgcn_readlane(bh, i1), t1 = __builtin_amdgcn_readlane(r, i1), t2 = __builtin_amdgcn_readlane(bh, i2), t3 = __builtin_amdgcn_readlane(r, i2);
            if (lane == 0) { tab[0] = t0; tab[1] = t1; tab[2] = t2; tab[3] = t3; }
        }
        __syncthreads();
    }
    {   int idx = 0;
        for (int Lx = BID; Lx < total; Lx += stride, ++idx) {
            int r, bh;
            if (use_tab) { bh = tab[idx * 2]; r = tab[idx * 2 + 1]; }
            else { const int xcd = Lx & 7, k = Lx >> 3, gi = k >> 3; r = (gi & 4) ? 7 - (k & 7) : (k & 7); bh = (gi * 8 + xcd) ^ ((gi & 4) ? 8 : 0); }
            const f32x4* kn = (const f32x4*)(N2P + ((size_t)(64 + bh) * SEQ) * 4);
            const f32x4* qn = (const f32x4*)(N2P + ((size_t)bh * SEQ) * 4);
            float km = 0.f;
#pragma unroll
            for (int e = 0; e < 8; ++e) { const f32x4 v = kn[tid * 8 + e]; km = fmaxf(km, (v[0] + v[1]) + (v[2] + v[3])); }
            km = fmaxf(km, mk_shfl_xor(km, 1)); km = fmaxf(km, mk_shfl_xor(km, 2)); km = fmaxf(km, mk_shfl_xor(km, 4));
            if ((tid & 7) == 0) kmx[tid >> 3] = km;
            for (int pass = 0; pass < 2; ++pass) {
                const int qb = pass ? 15 - r : r, P0 = qb * QB;
                __syncthreads();
                float qm = 0.f;
                if (tid < 256) { const f32x4 v = qn[P0 + tid]; qm = (v[0] + v[1]) + (v[2] + v[3]); }
#pragma unroll
                for (int o = 1; o < 64; o <<= 1) qm = fmaxf(qm, mk_shfl_xor(qm, o));
                if (lane == 0) qmx[wid] = qm;
                __syncthreads();
                if (wid == 0) {
                    const float Q = sqrtf(fmaxf(fmaxf(qmx[0], qmx[1]), fmaxf(qmx[2], qmx[3])));
                    const int jd = P0 / KVBLK;
                    const float Kd = sqrtf(fmaxf(fmaxf(kmx[jd], kmx[jd + 1]), fmaxf(kmx[jd + 2], kmx[jd + 3])));
                    const float* fb = FB + (size_t)bh * SEQ;
                    const float bound = 1.02f * Q * (sqrtf(kmx[lane]) + Kd) + (fb[lane * KVBLK + KVBLK - 1] - fb[P0]);
                    const bool keep = lane < jd && !(bound < -T_SKIP / SCALE);
                    const unsigned long long mask = __ballot(keep);
                    const int jlo = mask ? (int)__builtin_ctzll(mask) : jd;
                    if (lane == 0) jlo_l[idx * 2 + pass] = jlo;
                }
            }
            __syncthreads();
        }
    }
    int L = BID;
    if (L < total) {
        auto mkref = [&](int Lx, int pass, int slot) -> Ref {
            int r, bh;
            if (use_tab) { bh = __builtin_amdgcn_readfirstlane(tab[slot * 2]); r = __builtin_amdgcn_readfirstlane(tab[slot * 2 + 1]); }
            else { const int xcd = Lx & 7, k = Lx >> 3, gi = k >> 3; r = (gi & 4) ? 7 - (k & 7) : (k & 7); bh = (gi * 8 + xcd) ^ ((gi & 4) ? 8 : 0); }
            const int qb = pass ? 15 - r : r;
            const int b = bh >> 4, h = bh & 15; const size_t row0 = (size_t)b * SEQ + (size_t)qb * QB;
            Ref rf; const bf16* P = (const bf16*)PROJ; const size_t TS = (size_t)64 * SEQ * D, hb = (size_t)bh * SEQ * D;
            rf.Q = P + hb + (size_t)qb * QB * D; rf.K = P + TS + hb; rf.V = P + 2 * TS + hb; rf.G = P + 3 * TS + hb + (size_t)qb * QB * D;
            rf.O = (bf16*)O + row0 * OS + h * D; rf.Bias = FB + (size_t)bh * SEQ; rf.P0 = qb * QB; rf.JLO = __builtin_amdgcn_readfirstlane(jlo_l[slot * 2 + pass]); return rf; };
        int pass = 0, slot = 0; Ref cur = mkref(L, 0, 0);
        Seam<bf16> S;
        causal_swa_prime<bf16, bf16>(cur, SEQ, lds, S, tid);
        for (;;) {
            const bool more_pass = pass == 0, more_item = L + stride < total, last = !more_pass && !more_item;
            int passn = pass + 1, Ln = L, slotn = slot;
            if (!more_pass) { passn = 0; Ln = more_item ? L + stride : L; slotn = more_item ? slot + 1 : slot; }
            const Ref nxt = last ? cur : mkref(Ln, passn, slotn);
            causal_swa_block<bf16, bf16>(cur, nxt, SEQ, SEQ, lds, S, tid);
            if (last) break;
            cur = nxt; pass = passn; L = Ln; slot = slotn;
        }
    }
}

__device__ __forceinline__ void phase_gla_prep(const bf16_t* PROJ, const float* A1, const float* wa2, const float* ba, bf16_t* QD, bf16_t* QDF, bf16_t* KI, bf16_t* KDT, bf16_t* VT, float* ELAST,
                                               unsigned char* lds, int tid) {
    MK_GRID_VARS;
    float* a1l = (float*)lds;
    for (int u = BID; u < 512; u += NBLK) {
        const int b = u >> 7, n = (u >> 1) & 63, p = u & 1; const size_t row0 = (size_t)b * SEQ + n * 64;
        __syncthreads();
        for (int i = tid; i < 1024; i += 512) a1l[i] = A1[row0 * 16 + i];
        __syncthreads();
        { const int hh = 2 * p + (tid >> 8), d = tid & 255, col = hh * 256 + d, bh = b * 4 + hh;
          float w2[16];
#pragma unroll
          for (int r = 0; r < 16; ++r) w2[r] = wa2[r * 1024 + col];
          const float bav = ba[col];
          const bf16_t* qp = PROJ + row0 * 6144 + col; const bf16_t* kp = qp + 1024;
          bf16_t* qdp = QD + row0 * 1024 + col; bf16_t* kip = KI + row0 * 1024 + col;
          bf16_t* qfp; { const int dkl = d & 31, x = dkl & 15; qfp = QDF + ((((((size_t)bh * 64 + n) * 8 + (d >> 5)) * 2) * 2 + (dkl >> 4)) * 64 + ((x >> 2) & 1) * 32) * 8 + 4 * (x >> 3) + (x & 3); }
          float kif[64]; float cb = 0.f;
#pragma unroll
          for (int jj = 0; jj < 64; ++jj) {
              const f32x4* ar = (const f32x4*)(a1l + jj * 16); float ga = bav;
#pragma unroll
              for (int q = 0; q < 4; ++q) { const f32x4 av = ar[q]; ga += av[0] * w2[4 * q] + av[1] * w2[4 * q + 1] + av[2] * w2[4 * q + 2] + av[3] * w2[4 * q + 3]; }
              cb += log_sigmoid(ga) * 0.0625f;
              const float qv = bf2f(qp[(size_t)jj * 6144]) * 0.0625f, kv = bf2f(kp[(size_t)jj * 6144]);
              const float e = __expf(cb), ei = __expf(-cb), kin = kv * ei;
              const unsigned short qb = f2bf(qv * e); qdp[(size_t)jj * 1024] = qb; qfp[((jj >> 5) * 128 + (jj & 31)) * 8] = qb; kip[(size_t)jj * 1024] = f2bf(kin); kif[jj] = kin;
          }
          const float el = __expf(cb);
          ELAST[((size_t)bh * 64 + n) * 256 + d] = el;
          u32x4* kd = (u32x4*)KDT + ((((size_t)bh * 64 + n) * 8 + (d >> 5)) * 4) * 64 + (d & 31);
#pragma unroll
          for (int g = 0; g < 8; ++g) { u32x4 w; w.x = pk2(kif[8 * g] * el, kif[8 * g + 1] * el); w.y = pk2(kif[8 * g + 2] * el, kif[8 * g + 3] * el);
              w.z = pk2(kif[8 * g + 4] * el, kif[8 * g + 5] * el); w.w = pk2(kif[8 * g + 6] * el, kif[8 * g + 7] * el); kd[(g >> 1) * 64 + (g & 1) * 32] = w; } }
        { const int c2 = 2 * tid, hh = 2 * p + (c2 >> 9), dv = c2 & 511, bh = b * 4 + hh;
          const unsigned* vp = (const unsigned*)(PROJ + row0 * 6144 + 2048 + hh * 512 + dv);
          unsigned vv[64];
#pragma unroll
          for (int jj = 0; jj < 64; ++jj) vv[jj] = vp[(size_t)jj * 3072];
          u32x4* vt0 = (u32x4*)VT + ((((size_t)bh * 64 + n) * 16 + (dv >> 5)) * 4) * 64 + (dv & 31); u32x4* vt1 = vt0 + 1;
#pragma unroll
          for (int g = 0; g < 8; ++g) { u32x4 lo, hi;
              lo.x = (vv[8 * g] & 0xffffu) | (vv[8 * g + 1] << 16); lo.y = (vv[8 * g + 2] & 0xffffu) | (vv[8 * g + 3] << 16); lo.z = (vv[8 * g + 4] & 0xffffu) | (vv[8 * g + 5] << 16); lo.w = (vv[8 * g + 6] & 0xffffu) | (vv[8 * g + 7] << 16);
              hi.x = (vv[8 * g] >> 16) | (vv[8 * g + 1] & 0xffff0000u); hi.y = (vv[8 * g + 2] >> 16) | (vv[8 * g + 3] & 0xffff0000u); hi.z = (vv[8 * g + 4] >> 16) | (vv[8 * g + 5] & 0xffff0000u); hi.w = (vv[8 * g + 6] >> 16) | (vv[8 * g + 7] & 0xffff0000u);
              vt0[(g >> 1) * 64 + (g & 1) * 32] = lo; vt1[(g >> 1) * 64 + (g & 1) * 32] = hi; } }
    }
}
struct ScanOps { bf16x8 qa[2][2], ka[4], vb[4]; f32x4 ev[4]; };
__device__ __forceinline__ void scan_load(ScanOps& o, const char* qd_u, const char* kdt_u, const char* vt_u, const char* el_u, unsigned qoff, unsigned koff, unsigned eoff) {
#pragma unroll
    for (int mb = 0; mb < 2; ++mb)
#pragma unroll
        for (int ks = 0; ks < 2; ++ks) o.qa[mb][ks] = *(const bf16x8*)(qd_u + (mb * 2 + ks) * 1024 + qoff);
#pragma unroll
    for (int ks = 0; ks < 4; ++ks) { o.ka[ks] = *(const bf16x8*)(kdt_u + ks * 1024 + koff); o.vb[ks] = *(const bf16x8*)(vt_u + ks * 1024 + koff); }
#pragma unroll
    for (int g = 0; g < 4; ++g) o.ev[g] = *(const f32x4*)(el_u + g * 32 + eoff);
}
__device__ __forceinline__ void phase_gla_scan(const bf16_t* QDF, const bf16_t* KDT, const bf16_t* VT, const float* ELAST, bf16_t* OINT, unsigned char* lds, int tid, int wid, int lane) {
    MK_GRID_VARS;
    const int l32 = lane & 31, hi = lane >> 5;
    float* buf = (float*)lds;
    for (int u = BID; u < 256; u += NBLK) {
        const int xcd = u & 7, kk = u >> 3, bh = xcd * 2 + (kk >> 4), s = kk & 15, b = bh >> 2, hh = bh & 3;
        f32x16 S;
#pragma unroll
        for (int r = 0; r < 16; ++r) S[r] = 0.f;
        const char* qd_u0 = (const char*)((const u32x4*)QDF + ((((size_t)bh * 64 * 8 + wid) * 2) * 2) * 64);
        const char* kdt_u0 = (const char*)((const u32x4*)KDT + (((size_t)bh * 64 * 8 + wid) * 4) * 64);
        const char* vt_u0 = (const char*)((const u32x4*)VT + (((size_t)bh * 64 * 16 + s) * 4) * 64);
        const char* el_u0 = (const char*)(ELAST + (size_t)bh * 64 * 256 + 32 * wid);
        const unsigned koff = (unsigned)lane * 16u, qoff = koff, eoff = (unsigned)(4 * hi) * 4u;
#define SCAN_LOAD(c, n_) scan_load((c), qd_u0 + (size_t)(n_) * 8 * 4096, kdt_u0 + (size_t)(n_) * 256 * 64 * 2, vt_u0 + (size_t)(n_) * 512 * 64 * 2, el_u0 + (size_t)(n_) * 256 * 4, qoff, koff, eoff)
#define SCAN_STEP(c, n_) do { bf16x8 sb[2];                                                                                                                   \
            _Pragma("unroll") for (int ks = 0; ks < 2; ++ks) { u32x4 w; w.x = pk2(S[8 * ks], S[8 * ks + 1]); w.y = pk2(S[8 * ks + 2], S[8 * ks + 3]); w.z = pk2(S[8 * ks + 4], S[8 * ks + 5]); w.w = pk2(S[8 * ks + 6], S[8 * ks + 7]); \
                sb[ks] = *reinterpret_cast<bf16x8*>(&w); }                                                                                                     \
            f32x16 op[2];                                                                                                                                      \
            _Pragma("unroll") for (int mb = 0; mb < 2; ++mb) {                                                                                                 \
                _Pragma("unroll") for (int r = 0; r < 16; ++r) op[mb][r] = 0.f;                                                                                \
                _Pragma("unroll") for (int ks = 0; ks < 2; ++ks) op[mb] = __builtin_amdgcn_mfma_f32_32x32x16_bf16((c).qa[mb][ks], sb[ks], op[mb], 0, 0, 0); }  \
            _Pragma("unroll") for (int r = 0; r < 16; ++r) S[r] *= (c).ev[r >> 2][r & 3];                                                                      \
            _Pragma("unroll") for (int ks = 0; ks < 4; ++ks) S = __builtin_amdgcn_mfma_f32_32x32x16_bf16((c).ka[ks], (c).vb[ks], S, 0, 0, 0);                   \
            asm volatile("" : "+v"(S), "+v"(op[0]), "+v"(op[1]));     \
            __builtin_amdgcn_sched_barrier(0); SCAN_LOAD((c), (n_) + 2 < 64 ? (n_) + 2 : 63); __builtin_amdgcn_sched_barrier(0);                                                                 \
            float* pb = buf + ((size_t)((n_) & 1) * 8 + wid) * 2048 + (4 * hi) * 32 + l32;     \
            float* pbe = pb + hi * 32; float* pbo = pb - hi * 32;                                                                                              \
            _Pragma("unroll") for (int mb = 0; mb < 2; ++mb)                                                                                                   \
                _Pragma("unroll") for (int r = 0; r < 16; ++r) ((r & 1) ? pbo : pbe)[(32 * mb + (r & 3) + 8 * (r >> 2)) * 32] = op[mb][r];                     \
            asm volatile("s_waitcnt lgkmcnt(0)" ::: "memory"); __builtin_amdgcn_s_barrier(); asm volatile("" ::: "memory");     \
            { const int tok = tid >> 3, dv = (tid & 7) * 4;                                                                                                    \
              const float* rb = buf + (size_t)((n_) & 1) * 8 * 2048 + (tok ^ ((tok >> 2) & 1)) * 32 + dv; f32x4 acc = *(const f32x4*)rb;                       \
              _Pragma("unroll") for (int w = 1; w < 8; ++w) acc += *(const f32x4*)(rb + w * 2048);                                                             \
              u32x2 ow; ow.x = pk2(acc[0], acc[1]); ow.y = pk2(acc[2], acc[3]);                                                                                      \
              *(u32x2*)(OINT + ((size_t)b * SEQ + (n_) * 64 + tok) * DM + hh * 512 + 32 * s + dv) = ow; } } while (0)
        ScanOps oa, ob; SCAN_LOAD(oa, 0); SCAN_LOAD(ob, 1);
        for (int n = 0; n < 64; n += 2) { SCAN_STEP(oa, n); SCAN_STEP(ob, n + 1); }
#undef SCAN_STEP
#undef SCAN_LOAD
        __syncthreads();
    }
}
#define MK_LASU __attribute__((address_space(3))) unsigned
__device__ __forceinline__ void phase_gla_intra(const bf16_t* PROJ, const bf16_t* QD, const bf16_t* KI, const bf16_t* VT, const bf16_t* OINT, const float* normg, bf16_t* OG,
                                                unsigned char* lds, int tid, int wid, int lane) {
    MK_GRID_VARS;
    bf16_t* attl = (bf16_t*)lds;
    float* rss = (float*)(lds + 64 * 72 * 2);
    float* rstdl = rss + 8 * 64;
    constexpr int RG_OFF = 16384;
    const int l16 = lane & 15, q4 = lane >> 4, l32 = lane & 31, hi = lane >> 5;
    for (int u = BID; u < 1024; u += NBLK) {
        const int b = u >> 8, n = (u >> 2) & 63, hh = u & 3, bh = b * 4 + hh; const size_t row0 = (size_t)b * SEQ + n * 64;
        { const char* src = (const char*)(PROJ + (row0 + wid) * 6144 + 4096 + hh * 512 + lane * 8);
#pragma unroll
          for (int i = 0; i < 8; ++i) __builtin_amdgcn_global_load_lds((const unsigned*)(src + (size_t)i * 8 * 6144 * 2), (MK_LASU*)(lds + RG_OFF + (i * 512 + wid * 64) * 16), 16, 0, 0); }
        f32x16 acc[2][2];
        { const bf16_t* oil = OINT + (row0 + 4 * hi) * DM + hh * 512 + 64 * wid + l32;
#pragma unroll
          for (int mb = 0; mb < 2; ++mb)
#pragma unroll
              for (int nb = 0; nb < 2; ++nb)
#pragma unroll
                  for (int r = 0; r < 16; ++r) acc[mb][nb][r] = bf2f(oil[(size_t)(32 * mb + (r & 3) + 8 * (r >> 2)) * DM + 32 * nb]); }
        bf16x8 vb0[4], vb1[4];
        { const bf16x8* vtp = (const bf16x8*)VT + ((((size_t)bh * 64 + n) * 16 + 2 * wid) * 4) * 64 + lane;
#pragma unroll
          for (int ks = 0; ks < 4; ++ks) { vb0[ks] = vtp[ks * 64]; vb1[ks] = vtp[(4 + ks) * 64]; } }
        const int ti = wid >> 1;
#pragma unroll
        for (int t2 = 0; t2 < 2; ++t2) { const int tj = 2 * (wid & 1) + t2;
            f32x4 c = {0.f, 0.f, 0.f, 0.f};
            if (tj <= ti) {
                const bf16_t* ap = QD + (row0 + 16 * ti + l16) * 1024 + hh * 256 + 8 * q4;
                const bf16_t* bp = KI + (row0 + 16 * tj + l16) * 1024 + hh * 256 + 8 * q4;
#pragma unroll
                for (int st = 0; st < 8; ++st) c = __builtin_amdgcn_mfma_f32_16x16x32_bf16(*(const bf16x8*)(ap + 32 * st), *(const bf16x8*)(bp + 32 * st), c, 0, 0, 0);
            }
#pragma unroll
            for (int r = 0; r < 4; ++r) { const int i = 16 * ti + 4 * q4 + r, jx = 16 * tj + l16; attl[i * 72 + jx] = f2bf(jx <= i ? c[r] : 0.f); } }
        __syncthreads();
#pragma unroll
        for (int ks = 0; ks < 4; ++ks) {
            const bf16x8 a0 = *(const bf16x8*)(attl + l32 * 72 + 16 * ks + 8 * hi), a1 = *(const bf16x8*)(attl + (32 + l32) * 72 + 16 * ks + 8 * hi);
            const bf16x8 b0 = vb0[ks], b1 = vb1[ks];
            acc[0][0] = __builtin_amdgcn_mfma_f32_32x32x16_bf16(a0, b0, acc[0][0], 0, 0, 0); acc[0][1] = __builtin_amdgcn_mfma_f32_32x32x16_bf16(a0, b1, acc[0][1], 0, 0, 0);
            acc[1][0] = __builtin_amdgcn_mfma_f32_32x32x16_bf16(a1, b0, acc[1][0], 0, 0, 0); acc[1][1] = __builtin_amdgcn_mfma_f32_32x32x16_bf16(a1, b1, acc[1][1], 0, 0, 0); }
        float* rssl = rss + wid * 64 + 4 * hi;
#pragma unroll
        for (int mb = 0; mb < 2; ++mb)
#pragma unroll
            for (int r = 0; r < 16; ++r) { const float x0 = acc[mb][0][r], x1 = acc[mb][1][r]; float ss = x0 * x0 + x1 * x1;
                ss += __builtin_bit_cast(float, __builtin_amdgcn_update_dpp(0, __builtin_bit_cast(int, ss), 0x128, 0xf, 0xf, false));
                ss += __builtin_bit_cast(float, __builtin_amdgcn_update_dpp(0, __builtin_bit_cast(int, ss), 0x124, 0xf, 0xf, false));
                ss += __builtin_bit_cast(float, __builtin_amdgcn_update_dpp(0, __builtin_bit_cast(int, ss), 0x122, 0xf, 0xf, false));
                ss += __builtin_bit_cast(float, __builtin_amdgcn_update_dpp(0, __builtin_bit_cast(int, ss), 0x121, 0xf, 0xf, false));
                ss = mk_sum_xor16(ss);
                if (l32 == 0) rssl[32 * mb + (r & 3) + 8 * (r >> 2)] = ss; }
        asm volatile("s_waitcnt vmcnt(0)" ::: "memory");
        __syncthreads();
        if (tid < 64) { float tot = 0.f;
#pragma unroll
            for (int w = 0; w < 8; ++w) tot += rss[w * 64 + tid];
            rstdl[tid] = 1.f / sqrtf(tot * (1.f / 512.f) + RMS_EPS); }
        __syncthreads();
        const float g0 = normg[64 * wid + l32], g1 = normg[64 * wid + 32 + l32];
        const bf16_t* rgl = (const bf16_t*)(lds + RG_OFF) + (4 * hi) * 512 + 64 * wid + l32;
        const float* rsr = rstdl + 4 * hi;
        bf16_t* ogl = OG + (row0 + 4 * hi) * DM + hh * 512 + 64 * wid + l32;
#pragma unroll
        for (int mb = 0; mb < 2; ++mb)
#pragma unroll
            for (int r = 0; r < 16; ++r) { const int rc = 32 * mb + (r & 3) + 8 * (r >> 2);
                const float rstd = rsr[rc];
                const float r0 = bf2f(rgl[rc * 512]), r1 = bf2f(rgl[rc * 512 + 32]);
                ogl[(size_t)rc * DM] = f2bf(acc[mb][0][r] * rstd * g0 * silu_f(r0)); ogl[(size_t)rc * DM + 32] = f2bf(acc[mb][1][r] * rstd * g1 * silu_f(r1)); }
        __syncthreads();
    }
}

__device__ __forceinline__ void phase_conv_core(const bf16_t* PROJ, const float* cw  , bf16_t* OG, int tid) {
    MK_GRID_VARS;
    for (int u = BID; u < MTOK / 64; u += NBLK) {
        const int cg = tid & 255, c0 = 8 * cg, row_start = u * 64 + 32 * (tid >> 8);
        float w[3][8];
#pragma unroll
        for (int k = 0; k < 3; ++k) { const f32x4 a = *(const f32x4*)(cw + k * DM + c0), b = *(const f32x4*)(cw + k * DM + c0 + 4);
#pragma unroll
            for (int e = 0; e < 4; ++e) { w[k][e] = a[e]; w[k][4 + e] = b[e]; } }
        float p2[8], p1[8];
#pragma unroll
        for (int e = 0; e < 8; ++e) { p2[e] = 0.f; p1[e] = 0.f; }
        if ((row_start & (SEQ - 1)) != 0) {
            float c[8], uu[8];
            cvt8(*(const u32x4*)(PROJ + (size_t)(row_start - 2) * 6144 + 2048 + c0), c); cvt8(*(const u32x4*)(PROJ + (size_t)(row_start - 2) * 6144 + 4096 + c0), uu);
#pragma unroll
            for (int e = 0; e < 8; ++e) p2[e] = c[e] * uu[e];
            cvt8(*(const u32x4*)(PROJ + (size_t)(row_start - 1) * 6144 + 2048 + c0), c); cvt8(*(const u32x4*)(PROJ + (size_t)(row_start - 1) * 6144 + 4096 + c0), uu);
#pragma unroll
            for (int e = 0; e < 8; ++e) p1[e] = c[e] * uu[e];
        }
#pragma unroll 4
        for (int r = 0; r < 32; ++r) { const size_t row = (size_t)(row_start + r);
            float gb[8], c[8], uu[8], y[8];
            cvt8(*(const u32x4*)(PROJ + row * 6144 + c0), gb); cvt8(*(const u32x4*)(PROJ + row * 6144 + 2048 + c0), c); cvt8(*(const u32x4*)(PROJ + row * 6144 + 4096 + c0), uu);
#pragma unroll
            for (int e = 0; e < 8; ++e) { const float cu = c[e] * uu[e]; y[e] = gb[e] * (w[0][e] * p2[e] + w[1][e] * p1[e] + w[2][e] * cu); p2[e] = p1[e]; p1[e] = cu; }
            *(u32x4*)(OG + row * DM + c0) = pack8f(y); }
    }
}
__device__ __forceinline__ void phase_ffn_fix(const float* ZH, const float* cw  , const float* cb  , bf16_t* ACT, int tid) {
    MK_GRID_VARS;
    constexpr int NCG = DFF / 8, NIT = (MTOK / 64) * 2 * NCG;
    for (int it = BID * 512 + tid; it < NIT; it += NBLK * 512) {
        const int cg = it % NCG, r = (it / NCG) & 1, blk = it / (2 * NCG), c0 = 8 * cg;
        const bool first = (blk & 63) == 0;
        const float* zb = ZH + (size_t)blk * 4 * 2 * 5632 + c0;
        float y[8];
#pragma unroll
        for (int hq = 0; hq < 2; ++hq) {
            f32x4 za[3], zu[3];
#pragma unroll
            for (int k = 0; k < 3; ++k) { const int s = r + k;
                const bool zero = first && s < 2;
                za[k] = zero ? (f32x4){0.f, 0.f, 0.f, 0.f} : *(const f32x4*)(zb + (size_t)(s * 2) * 5632 + 4 * hq);
                zu[k] = zero ? (f32x4){0.f, 0.f, 0.f, 0.f} : *(const f32x4*)(zb + (size_t)(s * 2 + 1) * 5632 + 4 * hq); }
            f32x4 ya = *(const f32x4*)(cb + c0 + 4 * hq), yu = *(const f32x4*)(cb + DFF + c0 + 4 * hq);
#pragma unroll
            for (int k = 0; k < 3; ++k) { ya += *(const f32x4*)(cw + k * 11264 + c0 + 4 * hq) * za[k]; yu += *(const f32x4*)(cw + k * 11264 + DFF + c0 + 4 * hq) * zu[k]; }
#pragma unroll
            for (int e = 0; e < 4; ++e) y[4 * hq + e] = silu_f(ya[e]) * yu[e]; }
        *(u32x4*)(ACT + (size_t)(blk * 64 + r) * DFF + c0) = pack8f(y);
    }
}

constexpr int PH_FINAL = 65, PH_END = 66;
#ifndef MK_DUP
#define MK_DUP 0
#endif
constexpr size_t WS_XD = WS_END, WS_HD = WS_END + 64 * MiB, WS_SKD = WS_END + 128 * MiB, WS_STD = WS_END + 130 * MiB;
__global__ void __launch_bounds__(512, 2) mk_fwd(Args args_) {
    extern __shared__ __attribute__((aligned(16))) unsigned char lds[];
    const int tid0 = threadIdx.x, wid0 = __builtin_amdgcn_readfirstlane(tid0 >> 6);
    const __attribute__((address_space(4))) Args* argp = (const __attribute__((address_space(4))) Args*)__builtin_amdgcn_kernarg_segment_ptr();
    asm volatile("" : "+s"(argp));
#define args (*argp)
    unsigned char* ws = args.ws;
    const int lo = args.ph_lo, hi = args.ph_hi, dummy = args.flags;
    volatile LAS unsigned* MISC = (volatile LAS unsigned*)((LAS unsigned char*)lds + MISC_OFF);
    if (tid0 < 16) MISC[tid0] = 0u;
    __syncthreads();
    XcdBarrier bar; bar.bar = (unsigned*)(ws + WS_CTL) + CW_BAR; bar.x = 0; bar.st = nullptr;
    if (hi - lo > 1) bar = xcd_barrier_post((unsigned*)(ws + WS_CTL) + CW_BAR, MISC, tid0);
#define IN(k) (lo <= (k) && (k) < hi)
#define SEAM(k) do { if ((k) + 1 < hi) { XcdBarrier b_ = bar; asm volatile("" : "+s"(b_.bar), "+s"(b_.x)); xcd_barrier(b_, wid0 * 64 + mk_lane()); } } while (0)
#define LOCALS() unsigned char* w = ws; asm volatile("" : "+s"(w)); int wid_ = wid0; asm volatile("" : "+s"(wid_)); int lane_; asm volatile("v_mbcnt_lo_u32_b32 %0, -1, 0\n\tv_mbcnt_hi_u32_b32 %0, -1, %0" : "=&v"(lane_)); const int wid = wid_, lane = lane_, tid = wid * 64 + lane; (void)lane; (void)wid; (void)tid; int BID = blockIdx.x, NBLK = gridDim.x; asm volatile("" : "+s"(BID), "+s"(NBLK)); bf16_t* XB = (bf16_t*)(w + WS_XB); float* MOD = (float*)(w + WS_MOD); float* SK16 = (float*)(w + WS_SK16); float* FB = (float*)(w + WS_FB); float* ELAST = (float*)(w + WS_ELAST); \
    bf16_t* H = (bf16_t*)(w + WS_H); bf16_t* PROJ = (bf16_t*)(w + WS_PROJ); bf16_t* ACT = (bf16_t*)(w + WS_ACT); \
    bf16_t* QD = (bf16_t*)(w + WS_QD); bf16_t* KI = (bf16_t*)(w + WS_KI); bf16_t* KDT = (bf16_t*)(w + WS_KDT); bf16_t* VT = (bf16_t*)(w + WS_VT); bf16_t* OINT = (bf16_t*)(w + WS_OINT); bf16_t* QDF = (bf16_t*)(w + WS_QDF); (void)QDF; \
    (void)XB; (void)MOD; (void)SK16; (void)FB; (void)ELAST; (void)H; (void)PROJ; (void)ACT; (void)QD; (void)KI; (void)KDT; (void)VT; (void)OINT

    if (IN(0)) { LOCALS(); phase_prologue(argp, lds, tid, wid, lane); SEAM(0); }

    if (IN(1)) {
        LOCALS(); const float* modl = MOD;
        const int rep = dummy;
        phase_lnmod<false, true>(args.in[0], nullptr, rep ? (bf16_t*)(w + WS_HD) : H, false, true, args.in[6], args.in[7], modl + 2048, modl, 1, args.in[12], args.in[13], rep ? (float*)(w + WS_SKD) : SK16, (float*)(w + (rep ? WS_STD : WS_ST)), lds, tid, wid, lane);
        SEAM(1);
    }

    for (int sub = 0; sub < 8; ++sub) {
        const int layer = sub >> 1, is_ffn = sub & 1, kind = is_ffn ? 3 : layer % 3, j = layer / 3, base = 1 + 8 * sub;
        if (sub != 0 && IN(base + 0)) {
            LOCALS(); const float* modl = MOD + (size_t)layer * 4 * 12288;
            const float* lng = is_ffn ? args.in[4] + layer * DM : args.in[6] + (layer - 1) * DM;
            const float* lnb = is_ffn ? args.in[5] + layer * DM : args.in[7] + (layer - 1) * DM;
            const float* sc = modl + (is_ffn ? 8192 : 2048); const float* sh = modl + (is_ffn ? 6144 : 0);
            const int sk = kind == 0 ? 1 : (kind == 1 ? 2 : 0);
            const float* skW = kind == 0 ? args.in[12] + (size_t)j * DM * 16 : args.in[18]; const float* skB = args.in[13] + j * 16;
            const int rep = dummy;
            if (sk) phase_lnmod<true, true>(XB, nullptr, rep ? (bf16_t*)(w + WS_HD) : H, true, true, lng, lnb, sc, sh, sk, skW, skB, rep ? (float*)(w + WS_SKD) : SK16, (float*)(w + (rep ? WS_STD : WS_ST)), lds, tid, wid, lane);
            else phase_lnmod<true, false>(XB, nullptr, rep ? (bf16_t*)(w + WS_HD) : H, true, true, lng, lnb, sc, sh, 0, skW, skB, rep ? (float*)(w + WS_SKD) : SK16, (float*)(w + (rep ? WS_STD : WS_ST)), lds, tid, wid, lane);
            SEAM(base + 0);
        }
        if (IN(base + 1)) {
            LOCALS();
            const bf16_t* Bt; int N;
            if (kind == 0) { Bt = (const bf16_t*)(w + WS_WFOX + (size_t)j * 40 * MiB); N = 8192; fox_cumsum(SK16, FB, wid, lane); }
            else if (kind == 1) { Bt = (const bf16_t*)(w + WS_WGLA); N = 6144; }
            else if (kind == 2) { Bt = (const bf16_t*)(w + WS_WCONV); N = 6144; }
            else { Bt = (const bf16_t*)(w + WS_WUP) + (size_t)layer * 11264 * DM; N = 11264; }
            pg8::Gemm g{H, Bt, MTOK, N, DM}; pg8::StaticOrder S; S.init(MTOK, N, NBLK, BID);
            if (kind == 3) { pg8::EpiFfn E{ACT, (float*)PROJ, args.in[28] + (size_t)layer * 3 * 11264, args.in[29] + (size_t)layer * 11264};
                pg8::gemm_phase<pg8::EpiFfn, pg8::StaticOrder, true, true>((LAS unsigned char*)lds, g, S, E, tid); }
            else { pg8::EpiStore E{PROJ, N, kind == 0 ? 1 : 0, (float*)(w + WS_N2P)};
                pg8::gemm_phase<pg8::EpiStore, pg8::StaticOrder, true, true>((LAS unsigned char*)lds, g, S, E, tid); }
            SEAM(base + 1);
        }
        if (kind == 0) {
            if (IN(base + 2)) { LOCALS(); phase_fox_attn(PROJ, FB, (const float*)(w + WS_N2P), ACT, (char*)lds, tid); SEAM(base + 2); }
        } else if (kind == 1) {
            if (IN(base + 2)) { LOCALS(); phase_gla_prep(PROJ, SK16, args.in[19], args.in[20], QD, QDF, KI, KDT, VT, ELAST, lds, tid); SEAM(base + 2); }
            if (IN(base + 3)) { LOCALS(); phase_gla_scan(QDF, KDT, VT, ELAST, OINT, lds, tid, wid, lane); SEAM(base + 3); }
            if (IN(base + 4)) { LOCALS(); phase_gla_intra(PROJ, QD, KI, VT, OINT, args.in[22], ACT, lds, tid, wid, lane); SEAM(base + 4); }
        } else if (kind == 2) {
            if (IN(base + 2)) { LOCALS(); phase_conv_core(PROJ, args.in[25], ACT, tid); SEAM(base + 2); }
        } else {
            if (IN(base + 2)) { LOCALS(); phase_ffn_fix((const float*)PROJ, args.in[28] + (size_t)layer * 3 * 11264, args.in[29] + (size_t)layer * 11264, ACT, tid); SEAM(base + 2); }
        }
        if (IN(base + 5)) {
            LOCALS(); const float* modl = MOD + (size_t)layer * 4 * 12288;
            const bf16_t* Bt; int K;
            if (kind == 0) { Bt = (const bf16_t*)(w + WS_WFOX + (size_t)j * 40 * MiB) + (size_t)8192 * DM; K = DM; }
            else if (kind == 1) { Bt = (const bf16_t*)(w + WS_WGLA) + (size_t)6144 * DM; K = DM; }
            else if (kind == 2) { Bt = (const bf16_t*)(w + WS_WCONV) + (size_t)6144 * DM; K = DM; }
            else { Bt = (const bf16_t*)(w + WS_WDOWN) + (size_t)layer * DM * DFF; K = DFF; }
            pg8::Gemm g{ACT, Bt, MTOK, DM, K}; pg8::StaticOrder S; S.init(MTOK, DM, NBLK, BID);
            { pg8::EpiResid E{sub == 0 ? (const void*)args.in[0] : (const void*)XB, dummy ? (bf16_t*)(w + WS_XD) : XB, modl + (is_ffn ? 10240 : 4096), sub == 0, (const float*)(w + WS_ST)};
                pg8::gemm_phase<pg8::EpiResid, pg8::StaticOrder, true, true>((LAS unsigned char*)lds, g, S, E, tid); }
            SEAM(base + 5);
        }
    }
    if (IN(PH_FINAL)) { LOCALS(); phase_lnmod<true, false>(XB, dummy ? (float*)(w + WS_PROJ) : args.out, H, true, false, args.in[6] + 3 * DM, args.in[7] + 3 * DM, nullptr, nullptr, 0, nullptr, nullptr, nullptr, nullptr, lds, tid, wid, lane); }
#undef LOCALS
#undef IN
#undef SEAM
#undef args
}

extern "C" void kernel_launch(void* const* d_in, const int* in_sizes, int n_in, void* d_out, int out_size, void* d_ws, size_t ws_size, hipStream_t stream) {
    static int grid = 0;
    if (grid == 0) {
        if (n_in != 31 || in_sizes[0] != MTOK * DM || out_size != MTOK * DM || ws_size < WS_END + (MK_DUP ? 136 * MiB : 0)) {
            fprintf(stderr, "kernel_launch: built for 31 inputs, x/out of %d floats, >= %zu bytes of workspace; got n_in %d, in0 %d, out %d, ws %zu; nothing launched\n", MTOK * DM, (size_t)WS_END, n_in, n_in > 0 ? in_sizes[0] : -1, out_size, ws_size);
            grid = -1; return; }
        int dev = 0, cus = 0, per_cu = 0;
        if (hipGetDevice(&dev) != hipSuccess || hipDeviceGetAttribute(&cus, hipDeviceAttributeMultiprocessorCount, dev) != hipSuccess) { fprintf(stderr, "kernel_launch: device query failed\n"); grid = -1; return; }
        if (hipFuncSetAttribute((const void*)mk_fwd, hipFuncAttributeMaxDynamicSharedMemorySize, LDS_TOTAL) != hipSuccess) { fprintf(stderr, "kernel_launch: hipFuncSetAttribute(%d B LDS) failed\n", LDS_TOTAL); grid = -1; return; }
        if (hipOccupancyMaxActiveBlocksPerMultiprocessor(&per_cu, (const void*)mk_fwd, 512, LDS_TOTAL) != hipSuccess || per_cu < 1)
            fprintf(stderr, "kernel_launch: note: occupancy query reports %d workgroups per CU\n", per_cu);
        (void)hipGetLastError();
        grid = cus;
    }
    if (grid < 0) return;
    if (hipMemsetAsync((char*)d_ws + WS_CTL, 0, CTL_ZERO_BYTES, stream) != hipSuccess) { fprintf(stderr, "kernel_launch: memset failed\n"); return; }
    Args a{};
    for (int i = 0; i < 31; ++i) a.in[i] = (const float*)d_in[i];
    a.out = (float*)d_out; a.ws = (unsigned char*)d_ws;
#if MK_PER_PHASE
    for (int ph = 0; ph < PH_END; ++ph) {
        int group = 64;
        if (ph > 0 && ph < PH_FINAL) { const int sub = (ph - 1) >> 3, loc = (ph - 1) & 7, kind = (sub & 1) ? 3 : (sub >> 1) % 3;
            const bool exists = loc <= 2 || loc == 5 || (kind == 1 && loc <= 4); if (!exists) continue;
            group = loc == 0 ? 4 : loc == 1 ? (1 | (kind == 3 ? 512 : 1024)) : loc == 5 ? (2 | (kind == 3 ? 128 : 256)) : (kind == 0 ? 8 : kind == 1 ? (16 | (loc == 2 ? 2048 : loc == 3 ? 4096 : 8192)) : 32); }
        if (ph == PH_FINAL) group = 4;
        a.ph_lo = ph; a.ph_hi = ph + 1; a.flags = 0;
        hipLaunchKernelGGL(mk_fwd, dim3(grid), dim3(512), LDS_TOTAL, stream, a);
        if ((MK_DUP & group) == (MK_DUP & -MK_DUP) && (MK_DUP & group)) { a.flags = 1; hipLaunchKernelGGL(mk_fwd, dim3(grid), dim3(512), LDS_TOTAL, stream, a); }
    }
#else
    a.ph_lo = 0; a.ph_hi = PH_END;
    hipLaunchKernelGGL(mk_fwd, dim3(grid), dim3(512), LDS_TOTAL, stream, a);
#endif
    const hipError_t le = hipPeekAtLastError();
    if (le != hipSuccess) fprintf(stderr, "kernel_launch: launch failed: %s (grid %d)\n", hipGetErrorName(le), grid);
}
```

```cpp
#include <hip/hip_runtime.h>
#include <hip/hip_bf16.h>
#include <cstdio>
#include <cstdint>

#ifndef MK_PER_PHASE
#define MK_PER_PHASE 0
#endif

__device__ __forceinline__ int mk_lane() { int l; asm volatile("v_mbcnt_lo_u32_b32 %0, -1, 0\n\tv_mbcnt_hi_u32_b32 %0, -1, %0" : "=&v"(l)); return l; }
__device__ __forceinline__ float mk_shfl_xor(float v, int m) { return __builtin_bit_cast(float, __builtin_amdgcn_ds_bpermute((mk_lane() ^ m) << 2, __builtin_bit_cast(int, v))); }
__device__ __forceinline__ float mk_shfl_up(float v, int o) { return __builtin_bit_cast(float, __builtin_amdgcn_ds_bpermute(((mk_lane() - o) & 63) << 2, __builtin_bit_cast(int, v))); }
__device__ __forceinline__ float mk_sum_xor16(float v) { auto rr = __builtin_amdgcn_permlane16_swap(__float_as_uint(v), __float_as_uint(v), false, false); return __uint_as_float(rr[0]) + __uint_as_float(rr[1]); }
__device__ __forceinline__ float mk_sum_xor32(float v) { auto rr = __builtin_amdgcn_permlane32_swap(__float_as_uint(v), __float_as_uint(v), false, false); return __uint_as_float(rr[0]) + __uint_as_float(rr[1]); }
__device__ __forceinline__ float mk_xor1(float v) { return __builtin_bit_cast(float, __builtin_amdgcn_update_dpp(0, __builtin_bit_cast(int, v), 0xB1  , 0xf, 0xf, false)); }

namespace pg8 {
#define PG8_LAS __attribute__((address_space(3)))
typedef unsigned short bf16_t;
typedef short bf16x8 __attribute__((ext_vector_type(8)));
typedef float f32x4 __attribute__((ext_vector_type(4)));
typedef unsigned u32x4 __attribute__((ext_vector_type(4)));
constexpr int BM = 256, BK = 64, HALF = 128, HTB = HALF * BK * 2  , STAGE_BYTES = 8 * HTB, NXCD = 8, WGM = 8;

__host__ __device__ __forceinline__ int lds_byte(int r, int c) { const int st = (r >> 4) * 2 + (c >> 5), rr = r & 15, cc = c & 31, ob = rr * 64 + cc * 2; return st * 1024 + (ob ^ (((ob >> 9) & 1) << 5)); }
__host__ __device__ __forceinline__ void stage_rc(int b, int& R, int& C) { const int st = b / 1024, sb = b % 1024, swz = sb ^ (((sb >> 9) & 1) << 5); R = (st >> 1) * 16 + swz / 64; C = (st & 1) * 32 + (swz % 64) / 2; }
__host__ __device__ __forceinline__ int perm32(int rho) { const int n = rho >> 4, i = rho & 15; return 8 * (i >> 2) + 4 * n + (i & 3); }

struct Unit { int pm, pn; };
struct Gemm { const bf16_t* A; const bf16_t* Bt; int M, N, K; };

struct StaticOrder {
    int nM, nN, nwg, G, c, rg;
    __host__ __device__ void init(int M, int N, int G_, int c_, int rg_ = 0) { nM = M / BM; nN = N / BM; nwg = nM * nN; G = G_; c = c_; rg = rg_; }
    __host__ __device__ bool next(int i, Unit& u) const {
        const long L = (long)i * G + c; if (L >= nwg) return false;
        int wgid = (int)L; { const int q = nwg / NXCD, r = nwg % NXCD, xcd = wgid % NXCD, off = wgid / NXCD; wgid = (xcd < r ? xcd * (q + 1) : r * (q + 1) + (xcd - r) * q) + off; }
        const int nig = WGM * nN, gid = wgid / nig, fm = gid * WGM, gsz = (nM - fm) < WGM ? (nM - fm) : WGM;
        if (rg) { const int o = wgid % nig; u.pm = fm + 4 * (o >> 5) + (o & 3); u.pn = (o >> 2) & 7; return true; }
        u.pm = fm + ((wgid % nig) % gsz); u.pn = (wgid % nig) / gsz; return true;
    }
    __device__ __forceinline__ void a_ready(const Unit&) const {}
    __device__ __forceinline__ void done(const Unit&) const {}
};

__device__ __forceinline__ unsigned cvt_pk_bf16(float lo, float hi) { unsigned r; asm volatile("v_cvt_pk_bf16_f32 %0, %1, %2" : "=v"(r) : "v"(lo), "v"(hi)); return r; }
typedef float f32x2 __attribute__((ext_vector_type(2)));
template <class Epi, class Sched, bool ALIGN_EPI = false, bool SP2 = false>
__device__ __forceinline__ void gemm_phase(PG8_LAS unsigned char* lds, const Gemm g, const Sched& S, const Epi& E, int tid_in) {
    int tid_ = tid_in; asm volatile("" : "+v"(tid_));
    const int tid = tid_, wid = __builtin_amdgcn_readfirstlane(tid >> 6), lane = tid & 63, wr = wid >> 2, wc = wid & 3, fr = lane & 15, fq = lane >> 4;
    const int K = g.K, nt = K / BK;
    unsigned voffA[2], voffB[2];
#pragma unroll
    for (int i = 0; i < 2; ++i) { int R, C; stage_rc(tid * 16 + i * 8192, R, C); const int Rb = Epi::PERM ? ((R & ~31) + perm32(R & 31)) : R;
        voffA[i] = (unsigned)(R * K + C) * 2u; voffB[i] = (unsigned)(Rb * K + C) * 2u; }
    const size_t kstep = (size_t)(BK * 2);
    const size_t hstep = (size_t)HALF * K * 2;
    const size_t tstep = 2 * hstep;
    const unsigned ldsw = (unsigned)wid * 1024u;
    const int aoff = lds_byte(wr * 64 + fr, fq * 8), boff = lds_byte(wc * 32 + fr, fq * 8);
#define PG8_SA(b, h) (((b) * 2 + (h)) * HTB)
#define PG8_SB(b, h) ((4 + (b) * 2 + (h)) * HTB)
#define PG8_STAGE(bufoff, gbase, voff) do { _Pragma("unroll") for (int _i = 0; _i < 2; ++_i) \
        __builtin_amdgcn_global_load_lds((const unsigned*)((const char*)(gbase) + (voff)[_i]), (PG8_LAS unsigned*)(lds + (bufoff) + ldsw + _i * 8192), 16, 0, 0); } while (0)
#define PG8_LDA(dst, b, h) do { _Pragma("unroll") for (int m = 0; m < 4; ++m) _Pragma("unroll") for (int k = 0; k < 2; ++k) dst[m][k] = *(const PG8_LAS bf16x8*)(lds + PG8_SA(b, h) + aoff + m * 2048 + k * 1024); } while (0)
#define PG8_LDB(dst, b, h) do { _Pragma("unroll") for (int n = 0; n < 2; ++n) _Pragma("unroll") for (int k = 0; k < 2; ++k) dst[n][k] = *(const PG8_LAS bf16x8*)(lds + PG8_SB(b, h) + boff + n * 2048 + k * 1024); } while (0)
#define PG8_MMA(ai, bj, At, Bt) do { __builtin_amdgcn_s_setprio(1); _Pragma("unroll") for (int m = 0; m < 4; ++m) _Pragma("unroll") for (int n = 0; n < 2; ++n) _Pragma("unroll") for (int k = 0; k < 2; ++k) \
        acc[ai][bj][m][n] = __builtin_amdgcn_mfma_f32_16x16x32_bf16(Bt[n][k], At[m][k], acc[ai][bj][m][n], 0, 0, 0); __builtin_amdgcn_s_setprio(0); } while (0)
#define PG8_WAIT_V(n) asm volatile("s_waitcnt vmcnt(" #n ")" ::: "memory")
#define PG8_WAIT_L(n) asm volatile("s_waitcnt lgkmcnt(" #n ")" ::: "memory")
#define PG8_BAR __builtin_amdgcn_s_barrier()
#define PG8_SCHED __builtin_amdgcn_sched_barrier(0)
    Unit cur, nxt; int ui = 0;
    if (!S.next(0, cur)) return;
    f32x4 acc[2][2][4][2];
#pragma unroll
    for (int a = 0; a < 2; ++a)
#pragma unroll
        for (int b = 0; b < 2; ++b)
#pragma unroll
            for (int m = 0; m < 4; ++m)
#pragma unroll
                for (int n = 0; n < 2; ++n) acc[a][b][m][n] = (f32x4){0.f, 0.f, 0.f, 0.f};
    bf16x8 At[4][2], B0[2][2], B1[2][2];
    const char* cA = (const char*)g.A + (size_t)cur.pm * tstep; const char* cB = (const char*)g.Bt + (size_t)cur.pn * tstep;
    S.a_ready(cur);
    if constexpr (SP2) {
        PG8_STAGE(PG8_SB(0, 0), cB, voffB); PG8_STAGE(PG8_SB(0, 1), cB + hstep, voffB); PG8_STAGE(PG8_SA(0, 0), cA, voffA); PG8_STAGE(PG8_SA(0, 1), cA + hstep, voffA);
        if (wr == 1) PG8_BAR;
        PG8_WAIT_V(2); PG8_BAR;
        PG8_STAGE(PG8_SB(1, 0), cB + kstep, voffB); PG8_STAGE(PG8_SA(1, 0), cA + kstep, voffA); PG8_STAGE(PG8_SB(1, 1), cB + hstep + kstep, voffB);
        PG8_WAIT_V(6); PG8_BAR;
    } else {
        PG8_STAGE(PG8_SB(0, 0), cB, voffB); PG8_STAGE(PG8_SA(0, 0), cA, voffA); PG8_STAGE(PG8_SB(0, 1), cB + hstep, voffB); PG8_STAGE(PG8_SA(0, 1), cA + hstep, voffA);
        if (wr == 1) PG8_BAR;
        PG8_WAIT_V(4); PG8_BAR;
        PG8_STAGE(PG8_SB(1, 0), cB + kstep, voffB); PG8_STAGE(PG8_SA(1, 0), cA + kstep, voffA); PG8_STAGE(PG8_SB(1, 1), cB + hstep + kstep, voffB);
        PG8_WAIT_V(6); PG8_BAR;
    }
    for (;;) {
        E.unit_begin(lds, cur, ui, wid, lane);
        const bool has_next = S.next(ui + 1, nxt);
        const char* nA = has_next ? (const char*)g.A + (size_t)nxt.pm * tstep : cA; const char* nB = has_next ? (const char*)g.Bt + (size_t)nxt.pn * tstep : cB;
        for (int t = 0; t < nt; t += 2) {
            const bool last = (t == nt - 2);
            const char* a1 = cA + (size_t)(t + 1) * kstep;
            const char* a2 = last ? nA : cA + (size_t)(t + 2) * kstep; const char* b2 = last ? nB : cB + (size_t)(t + 2) * kstep;
            const char* a3 = a2 + kstep; const char* b3 = b2 + kstep;
            if (last && has_next) S.a_ready(nxt);
            if constexpr (SP2) {
            PG8_LDB(B0, 0, 0); PG8_LDB(B1, 0, 1); PG8_SCHED; PG8_LDA(At, 0, 0); PG8_STAGE(PG8_SA(1, 1), a1 + hstep, voffA);
            PG8_WAIT_V(8); PG8_WAIT_L(0); PG8_BAR; PG8_MMA(0, 0, At, B0); PG8_MMA(0, 1, At, B1); PG8_BAR; PG8_SCHED;
            PG8_LDA(At, 0, 1); PG8_STAGE(PG8_SB(0, 0), b2, voffB); PG8_STAGE(PG8_SB(0, 1), b2 + hstep, voffB); PG8_STAGE(PG8_SA(0, 0), a2, voffA);
            PG8_WAIT_V(8); PG8_WAIT_L(0); PG8_BAR; PG8_MMA(1, 0, At, B0); PG8_MMA(1, 1, At, B1); PG8_BAR; PG8_SCHED;
            PG8_LDB(B0, 1, 0); PG8_LDB(B1, 1, 1); PG8_SCHED; PG8_LDA(At, 1, 0); PG8_STAGE(PG8_SA(0, 1), a2 + hstep, voffA);
            PG8_WAIT_V(8); PG8_WAIT_L(0); PG8_BAR; PG8_MMA(0, 0, At, B0); PG8_MMA(0, 1, At, B1); PG8_BAR; PG8_SCHED;
            PG8_LDA(At, 1, 1); PG8_STAGE(PG8_SB(1, 0), b3, voffB); PG8_STAGE(PG8_SB(1, 1), b3 + hstep, voffB); PG8_STAGE(PG8_SA(1, 0), a3, voffA);
            PG8_WAIT_V(8); PG8_WAIT_L(0); PG8_BAR; PG8_MMA(1, 0, At, B0); PG8_MMA(1, 1, At, B1); PG8_BAR; PG8_SCHED;
            } else {
            PG8_LDB(B0, 0, 0); PG8_SCHED; PG8_LDA(At, 0, 0); PG8_STAGE(PG8_SA(1, 1), a1 + hstep, voffA);
            PG8_WAIT_L(8); PG8_BAR; PG8_WAIT_L(0); PG8_MMA(0, 0, At, B0); PG8_BAR; PG8_SCHED;
            PG8_LDB(B1, 0, 1); PG8_STAGE(PG8_SB(0, 0), b2, voffB);
            PG8_BAR; PG8_WAIT_L(0); PG8_MMA(0, 1, At, B1); PG8_BAR;
            PG8_LDA(At, 0, 1); PG8_STAGE(PG8_SA(0, 0), a2, voffA);
            PG8_BAR; PG8_WAIT_L(0); PG8_MMA(1, 0, At, B0); PG8_BAR; PG8_SCHED;
            PG8_STAGE(PG8_SB(0, 1), b2 + hstep, voffB);
            PG8_WAIT_V(6); PG8_BAR; PG8_MMA(1, 1, At, B1); PG8_BAR;
            PG8_LDB(B0, 1, 0); PG8_SCHED; PG8_LDA(At, 1, 0); PG8_STAGE(PG8_SA(0, 1), a2 + hstep, voffA);
            PG8_WAIT_L(8); PG8_BAR; PG8_WAIT_L(0); PG8_MMA(0, 0, At, B0); PG8_BAR; PG8_SCHED;
            PG8_LDB(B1, 1, 1); PG8_STAGE(PG8_SB(1, 0), b3, voffB);
            PG8_BAR; PG8_WAIT_L(0); PG8_MMA(0, 1, At, B1); PG8_BAR;
            PG8_LDA(At, 1, 1); PG8_STAGE(PG8_SA(1, 0), a3, voffA);
            PG8_BAR; PG8_WAIT_L(0); PG8_MMA(1, 0, At, B0); PG8_BAR; PG8_SCHED;
            PG8_STAGE(PG8_SB(1, 1), b3 + hstep, voffB);
            PG8_WAIT_V(6); PG8_BAR; PG8_MMA(1, 1, At, B1); PG8_BAR;
            }
        }
        if constexpr (ALIGN_EPI) { if (wr == 0) PG8_BAR; }
        if constexpr (!Epi::AFTER_DRAIN) { E(acc, cur, wr, wc, fr, fq, lds, ui); S.done(cur); }
        if (!has_next) break;
#pragma unroll
        for (int a = 0; a < 2; ++a)
#pragma unroll
            for (int b = 0; b < 2; ++b)
#pragma unroll
                for (int m = 0; m < 4; ++m)
#pragma unroll
                    for (int n = 0; n < 2; ++n) acc[a][b][m][n] = (f32x4){0.f, 0.f, 0.f, 0.f};
        cur = nxt; cA = nA; cB = nB; ++ui;
        if constexpr (ALIGN_EPI) { if (wr == 1) PG8_BAR; }
    }
    PG8_WAIT_V(0);
    if constexpr (!ALIGN_EPI) { if (wr == 0) PG8_BAR; }
    PG8_BAR;
    if constexpr (Epi::AFTER_DRAIN) { E.fused(acc, cur, wr, wc, fr, fq, lds, wid, lane); S.done(cur); }
#undef PG8_SA
#undef PG8_SB
#undef PG8_STAGE
#undef PG8_LDA
#undef PG8_LDB
#undef PG8_MMA
#undef PG8_WAIT_V
#undef PG8_WAIT_L
#undef PG8_BAR
#undef PG8_SCHED
}
}

namespace pg8 {
constexpr int EPI_LDS_OFF = 131072, EPI_LDS_PAR = 9216, EPI_RED_OFF = EPI_LDS_OFF + 2 * EPI_LDS_PAR  , EPI_MS_OFF = EPI_RED_OFF + 8192  ;
struct EpiStore {
    static constexpr bool PERM = true, AFTER_DRAIN = false;
    bf16_t* O; int ldc; int hm; float* n2p;
    __device__ __forceinline__ void unit_begin(PG8_LAS unsigned char*, const Unit&, int, int, int) const {}
    __device__ __forceinline__ void operator()(const f32x4 (&acc)[2][2][4][2], const Unit& u, int wr, int wc, int fr, int fq, PG8_LAS unsigned char* lds, int ui) const {
        const int row0 = u.pm * BM + wr * 64 + fr, col0 = u.pn * BM + wc * 32 + 8 * fq;
        size_t base[2]; size_t rstride;
        if (hm) { const int b = row0 >> 12, s = row0 & 4095;
#pragma unroll
            for (int bj = 0; bj < 2; ++bj) { const int c = col0 + bj * HALF, t = c >> 11, h = (c >> 7) & 15, d = c & 127; base[bj] = ((size_t)((t * 4 + b) * 16 + h) * 4096 + s) * 128 + d; }
            rstride = 128;
            if (u.pn < 16) {
#pragma unroll
                for (int bj = 0; bj < 2; ++bj) { const int c = col0 + bj * HALF, t = c >> 11, h = (c >> 7) & 15;
                    float* np = n2p + ((size_t)((t * 4 + b) * 16 + h) * 4096 + s) * 4 + wc;
#pragma unroll
                    for (int ai = 0; ai < 2; ++ai)
#pragma unroll
                        for (int m = 0; m < 4; ++m) { const f32x4 v0 = acc[ai][bj][m][0], v1 = acc[ai][bj][m][1];
                            float q = (v0[0] * v0[0] + v0[1] * v0[1]) + (v0[2] * v0[2] + v0[3] * v0[3]) + (v1[0] * v1[0] + v1[1] * v1[1]) + (v1[2] * v1[2] + v1[3] * v1[3]);
                            q = mk_sum_xor32(mk_sum_xor16(q));
                            if (fq == 0) np[(size_t)(ai * HALF + m * 16) * 4] = q; } } }
        }
        else { base[0] = (size_t)row0 * ldc + col0; base[1] = base[0] + HALF; rstride = (size_t)ldc; }
#pragma unroll
        for (int ai = 0; ai < 2; ++ai)
#pragma unroll
            for (int m = 0; m < 4; ++m) {
#pragma unroll
                for (int bj = 0; bj < 2; ++bj) { const f32x4 v0 = acc[ai][bj][m][0], v1 = acc[ai][bj][m][1];
                    u32x4 w; w.x = cvt_pk_bf16(v0[0], v0[1]); w.y = cvt_pk_bf16(v0[2], v0[3]); w.z = cvt_pk_bf16(v1[0], v1[1]); w.w = cvt_pk_bf16(v1[2], v1[3]);
                    *(u32x4*)(O + base[bj] + (size_t)(ai * HALF + m * 16) * rstride) = w; } }
    }
};
struct EpiResid {
    static constexpr bool PERM = true, AFTER_DRAIN = false;
    const void* Xs; bf16_t* Xd; const float* gate; int src_f32; const float* stats;
    __device__ __forceinline__ void unit_begin(PG8_LAS unsigned char* lds, const Unit& u, int ui, int wid, int) const {
        if (wid < 5) { int lane; asm volatile("v_mbcnt_lo_u32_b32 %0, -1, 0\n\tv_mbcnt_hi_u32_b32 %0, -1, %0" : "=&v"(lane));
            const float* src = wid < 3 ? (wid == 0 ? gate + (size_t)((u.pm * BM) >> 12) * 12288 : stats + 2 * 16384 + (src_f32 >> 1) + (wid - 1) * 2048) + u.pn * BM + lane * 4
                                       : stats + (size_t)(u.pm * BM + (wid - 3) * 128) * 2 + lane * 4;
            __builtin_amdgcn_global_load_lds((const unsigned*)src, (PG8_LAS unsigned*)(lds + EPI_LDS_OFF + (ui & 1) * EPI_LDS_PAR + wid * 1024), 16, 0, 0); }
    }
    __device__ __forceinline__ void operator()(const f32x4 (&acc)[2][2][4][2], const Unit& u, int wr, int wc, int fr, int fq, PG8_LAS unsigned char* lds, int ui) const {
        const int row0 = u.pm * BM + wr * 64 + fr, col0 = u.pn * BM + wc * 32 + 8 * fq;
        const PG8_LAS float* lv = (const PG8_LAS float*)(lds + EPI_LDS_OFF + (ui & 1) * EPI_LDS_PAR) + wc * 32 + 8 * fq;
        if (src_f32 & 1) {
            f32x4 gv[2][2], av[2][2], bv[2][2];
#pragma unroll
            for (int bj = 0; bj < 2; ++bj)
#pragma unroll
                for (int n = 0; n < 2; ++n) { gv[bj][n] = *(const PG8_LAS f32x4*)(lv + bj * HALF + n * 4); av[bj][n] = *(const PG8_LAS f32x4*)(lv + 256 + bj * HALF + n * 4); bv[bj][n] = *(const PG8_LAS f32x4*)(lv + 512 + bj * HALF + n * 4); }
#pragma unroll
            for (int ai = 0; ai < 2; ++ai)
#pragma unroll
                for (int mp = 0; mp < 2; ++mp) {
                    f32x4 xv[2][2][2]; f32x2 st[2];
#pragma unroll
                    for (int mm = 0; mm < 2; ++mm) { const size_t row = (size_t)(row0 + ai * HALF + (2 * mp + mm) * 16); st[mm] = *(const f32x2*)(stats + row * 2); const float* rowp = (const float*)Xs + row * 2048 + col0;
#pragma unroll
                        for (int bj = 0; bj < 2; ++bj)
#pragma unroll
                            for (int n = 0; n < 2; ++n) xv[mm][bj][n] = *(const f32x4*)(rowp + bj * HALF + n * 4); }
#pragma unroll
                    for (int mm = 0; mm < 2; ++mm) { bf16_t* rowp = Xd + (size_t)(row0 + ai * HALF + (2 * mp + mm) * 16) * 2048 + col0; const float mean = st[mm][0], rstd = st[mm][1];
#pragma unroll
                        for (int bj = 0; bj < 2; ++bj) {
                            const f32x4 r0 = (xv[mm][bj][0] - mean) * rstd * av[bj][0] + bv[bj][0] + gv[bj][0] * acc[ai][bj][2 * mp + mm][0];
                            const f32x4 r1 = (xv[mm][bj][1] - mean) * rstd * av[bj][1] + bv[bj][1] + gv[bj][1] * acc[ai][bj][2 * mp + mm][1];
                            u32x4 w; w.x = cvt_pk_bf16(r0[0], r0[1]); w.y = cvt_pk_bf16(r0[2], r0[3]); w.z = cvt_pk_bf16(r1[0], r1[1]); w.w = cvt_pk_bf16(r1[2], r1[3]);
                            *(u32x4*)(rowp + bj * HALF) = w; } } }
        } else {
#pragma unroll
            for (int ai = 0; ai < 2; ++ai) {
                u32x4 xb[4][2]; f32x2 st[4];
#pragma unroll
                for (int m = 0; m < 4; ++m) { const size_t row = (size_t)(row0 + ai * HALF + m * 16); const bf16_t* rowp = (const bf16_t*)Xs + row * 2048 + col0;
                    xb[m][0] = *(const u32x4*)(rowp); xb[m][1] = *(const u32x4*)(rowp + HALF); }
                __builtin_amdgcn_sched_barrier(0);
#pragma unroll
                for (int m = 0; m < 4; ++m) st[m] = ((const PG8_LAS f32x2*)(lds + EPI_LDS_OFF + (ui & 1) * EPI_LDS_PAR + 3072))[ai * HALF + wr * 64 + m * 16 + fr];
#pragma unroll
                for (int bj = 0; bj < 2; ++bj) {
                    const f32x4 g0 = *(const PG8_LAS f32x4*)(lv + bj * HALF), g1 = *(const PG8_LAS f32x4*)(lv + bj * HALF + 4);
                    const f32x4 a0 = *(const PG8_LAS f32x4*)(lv + 256 + bj * HALF), a1 = *(const PG8_LAS f32x4*)(lv + 256 + bj * HALF + 4);
                    const f32x4 b0 = *(const PG8_LAS f32x4*)(lv + 512 + bj * HALF), b1 = *(const PG8_LAS f32x4*)(lv + 512 + bj * HALF + 4);
#pragma unroll
                    for (int m = 0; m < 4; ++m) {
                        bf16_t* rowp = Xd + (size_t)(row0 + ai * HALF + m * 16) * 2048 + col0 + bj * HALF; const float mean = st[m][0], rstd = st[m][1];
                        const u32x4 xw = xb[m][bj]; f32x4 x0, x1;
                        x0[0] = __uint_as_float(xw.x << 16); x0[1] = __uint_as_float(xw.x & 0xffff0000u); x0[2] = __uint_as_float(xw.y << 16); x0[3] = __uint_as_float(xw.y & 0xffff0000u);
                        x1[0] = __uint_as_float(xw.z << 16); x1[1] = __uint_as_float(xw.z & 0xffff0000u); x1[2] = __uint_as_float(xw.w << 16); x1[3] = __uint_as_float(xw.w & 0xffff0000u);
                        const f32x4 r0 = (x0 - mean) * rstd * a0 + b0 + g0 * acc[ai][bj][m][0];
                        const f32x4 r1 = (x1 - mean) * rstd * a1 + b1 + g1 * acc[ai][bj][m][1];
                        u32x4 w; w.x = cvt_pk_bf16(r0[0], r0[1]); w.y = cvt_pk_bf16(r0[2], r0[3]); w.z = cvt_pk_bf16(r1[0], r1[1]); w.w = cvt_pk_bf16(r1[2], r1[3]);
                        *(u32x4*)rowp = w; } }
                __builtin_amdgcn_sched_barrier(0); }
        }
    }
};
template <int CTRL> __device__ __forceinline__ float dppf(float v) { return __builtin_bit_cast(float, __builtin_amdgcn_update_dpp(0, __builtin_bit_cast(int, v), CTRL, 0xf, 0xf, true)); }
typedef unsigned u32x2v __attribute__((ext_vector_type(2)));
struct EpiFfn {
    static constexpr bool PERM = true, AFTER_DRAIN = false;
    bf16_t* ACT; float* ZH; const float* cw; const float* cb;
    __device__ __forceinline__ void unit_begin(PG8_LAS unsigned char* lds, const Unit& u, int ui, int wid, int) const {
        if (wid < 4) { int lane; asm volatile("v_mbcnt_lo_u32_b32 %0, -1, 0\n\tv_mbcnt_hi_u32_b32 %0, -1, %0" : "=&v"(lane));
            const float* src = (wid < 3 ? cw + wid * 11264 : cb) + (lane < 32 ? 0 : 5632) + u.pn * 128 + (lane & 31) * 4;
            __builtin_amdgcn_global_load_lds((const unsigned*)src, (PG8_LAS unsigned*)(lds + EPI_LDS_OFF + (ui & 1) * EPI_LDS_PAR + wid * 1024), 16, 0, 0); }
    }
    __device__ __forceinline__ void operator()(const f32x4 (&acc)[2][2][4][2], const Unit& u, int wr, int wc, int fr, int fq, PG8_LAS unsigned char* lds, int ui) const {
#pragma unroll
        for (int n = 0; n < 2; ++n) {
            const int ch0 = u.pn * 128 + wc * 32 + 8 * fq + 4 * n;
            f32x4 wa[3], wu[3];
            const PG8_LAS float* lw = (const PG8_LAS float*)(lds + EPI_LDS_OFF + (ui & 1) * EPI_LDS_PAR) + wc * 32 + 8 * fq + 4 * n;
#pragma unroll
            for (int k = 0; k < 3; ++k) { wa[k] = *(const PG8_LAS f32x4*)(lw + k * 256); wu[k] = *(const PG8_LAS f32x4*)(lw + k * 256 + 128); }
            const f32x4 ba = *(const PG8_LAS f32x4*)(lw + 3 * 256), bu = *(const PG8_LAS f32x4*)(lw + 3 * 256 + 128);
#pragma unroll
            for (int ai = 0; ai < 2; ++ai) { const int blk = u.pm * 4 + ai * 2 + wr;
                if (fr < 2) { float* zp = ZH + ((size_t)(blk * 4 + 2 + fr) * 2) * 5632 + ch0; *(f32x4*)zp = acc[ai][0][0][n]; *(f32x4*)(zp + 5632) = acc[ai][1][0][n]; }
                if (fr >= 14) { float* zp = ZH + ((size_t)((blk + 1) * 4 + fr - 14) * 2) * 5632 + ch0; *(f32x4*)zp = acc[ai][0][3][n]; *(f32x4*)(zp + 5632) = acc[ai][1][3][n]; }
                f32x4 q1a = {0.f, 0.f, 0.f, 0.f}, q0a = q1a, q1u = q1a, q0u = q1a;
#pragma unroll
                for (int m = 0; m < 4; ++m) { float o[4];
                    const f32x4 va = acc[ai][0][m][n], vu = acc[ai][1][m][n];
                    f32x4 t1a = wa[1] * va, t0a = wa[0] * va, t1u = wu[1] * vu, t0u = wu[0] * vu;
                    f32x4 ya = ba + wa[2] * va, yu = bu + wu[2] * vu;
#define FFN_DPP4(Y, T, CTRL) asm volatile("s_nop 1\n\tv_add_f32_dpp %0, %4, %0 " CTRL " row_mask:0xf bank_mask:0xf bound_ctrl:1\n\tv_add_f32_dpp %1, %5, %1 " CTRL " row_mask:0xf bank_mask:0xf bound_ctrl:1\n\t" \
                                          "v_add_f32_dpp %2, %6, %2 " CTRL " row_mask:0xf bank_mask:0xf bound_ctrl:1\n\tv_add_f32_dpp %3, %7, %3 " CTRL " row_mask:0xf bank_mask:0xf bound_ctrl:1" \
                                          : "+v"(Y[0]), "+v"(Y[1]), "+v"(Y[2]), "+v"(Y[3]) : "v"(T[0]), "v"(T[1]), "v"(T[2]), "v"(T[3]))
                    asm volatile("s_nop 4" : "+v"(t1a), "+v"(t0a), "+v"(t1u), "+v"(t0u), "+v"(q1a), "+v"(q0a), "+v"(q1u), "+v"(q0u));
                    FFN_DPP4(ya, t1a, "row_shr:1"); FFN_DPP4(yu, t1u, "row_shr:1"); FFN_DPP4(ya, t0a, "row_shr:2"); FFN_DPP4(yu, t0u, "row_shr:2");
                    if (m) { FFN_DPP4(ya, q1a, "row_shl:15"); FFN_DPP4(yu, q1u, "row_shl:15"); FFN_DPP4(ya, q0a, "row_shl:14"); FFN_DPP4(yu, q0u, "row_shl:14"); }
#undef FFN_DPP4
#pragma unroll
                    for (int e = 0; e < 4; e += 2) {
                        const f32x2 a2 = {ya[e], ya[e + 1]}, u2 = {yu[e], yu[e + 1]}, x2 = a2 * (-1.4426950408889634f);
                        f32x2 d2; d2.x = __builtin_amdgcn_exp2f(x2.x); d2.y = __builtin_amdgcn_exp2f(x2.y); d2 = d2 + 1.0f;
                        f32x2 r2; r2.x = __builtin_amdgcn_rcpf(d2.x); r2.y = __builtin_amdgcn_rcpf(d2.y);
                        const f32x2 o2 = (a2 * u2) * r2; o[e] = o2.x; o[e + 1] = o2.y; }
                    q1a = t1a; q0a = t0a; q1u = t1u; q0u = t0u;
                    if (m > 0 || fr >= 2) { u32x2v w; w.x = cvt_pk_bf16(o[0], o[1]); w.y = cvt_pk_bf16(o[2], o[3]); *(u32x2v*)(ACT + (size_t)(blk * 64 + m * 16 + fr) * 5632 + ch0) = w; }
                    __builtin_amdgcn_sched_barrier(0); } } }
    }
};
}
namespace fx {
using bf16 = __hip_bfloat16;
constexpr int D = 128, RS = 128  , OS = 2048  ;
constexpr float THR = 24.f;     constexpr bool WSKIP = false; constexpr float T_DEAD = 24.f;
constexpr float SCALE = 0.08838834764831845f;
constexpr int NW = 8, QBLK = 32, KVBLK = 64, QB = NW * QBLK;
constexpr int SHM_V = KVBLK * D * 2, SHM_K = KVBLK * D * 2;
constexpr int BIAS_OFF = 2 * SHM_V + 2 * SHM_K + NW * 64 * 4;
constexpr int GATE_OFF = BIAS_OFF + 4096 * 4;
constexpr int LDS_BYTES = GATE_OFF + 8 * 8192;
typedef short bf16x8 __attribute__((ext_vector_type(8)));
typedef short s16x4 __attribute__((ext_vector_type(4)));
typedef float f32x16 __attribute__((ext_vector_type(16)));
typedef float f32x4 __attribute__((ext_vector_type(4)));
typedef unsigned u32x4 __attribute__((ext_vector_type(4)));
template <class A, class Bt> struct same_t { static constexpr bool v = false; };
template <class A> struct same_t<A, A> { static constexpr bool v = true; };
#define KSWZ(row, colB) ((row) * 256 + ((colB) ^ (((row) & 7) << 4)))
#define SBAR() __builtin_amdgcn_sched_barrier(0)
__device__ __forceinline__ int v_st(int k, int c) { const int kk = (k & ~0xC) | ((k & 4) << 1) | ((k & 8) >> 1); return ((kk >> 3) * 4 + (c >> 5)) * 512 + ((kk & 7) * 32 + (c & 31)) * 2; }
__device__ __forceinline__ int v_rd_base(int lane) { return ((lane & 3) << 3) | (((lane >> 2) & 3) << 6) | (((lane >> 4) & 1) << 5) | (((lane >> 5) & 1) << 8); }
constexpr int v_rd_off(int d0, int ks, int half) { return d0 * 512 + ks * 4096 + half * 2048; }
__device__ __forceinline__ int crow(int r, int hi) { return (r & 3) + 8 * (r >> 2) + 4 * hi; }
__device__ __forceinline__ unsigned cvtpk(float lo, float hi) {
    unsigned r; asm volatile("v_cvt_pk_bf16_f32 %0, %1, %2" : "=v"(r) : "v"(lo), "v"(hi)); return r;
}
__device__ __forceinline__ bf16x8 pack8(f32x4 a, f32x4 b) {
    u32x4 w = {cvtpk(a[0], a[1]), cvtpk(a[2], a[3]), cvtpk(b[0], b[1]), cvtpk(b[2], b[3])};
    return *reinterpret_cast<bf16x8*>(&w);
}
template <class T> __device__ __forceinline__ bf16x8 load8(const T* p) {
    if constexpr (same_t<T, float>::v) { return pack8(*(const f32x4*)p, *(const f32x4*)(p + 4)); }
    else { return *reinterpret_cast<const bf16x8*>(p); }
}
__device__ __forceinline__ void mask_tile(f32x16& p0, f32x16& p1, int dq, unsigned W) {
    const float NEG = -__builtin_inff();
#pragma unroll
    for (int r = 0; r < 16; ++r) {
        const int c = (r & 3) + 8 * (r >> 2);
        if ((unsigned)(dq - c) >= W) p0[r] = NEG;
        if ((unsigned)(dq - c - 32) >= W) p1[r] = NEG;
    }
}
__device__ __forceinline__ void partialSM(f32x16& p0, f32x16& p1, float& m_reg, float& mn, float& alpha, bool& dead) {
    float pmax = p0[0]; for (int r = 1; r < 16; ++r) pmax = fmaxf(pmax, p0[r]); for (int r = 0; r < 16; ++r) pmax = fmaxf(pmax, p1[r]);
    { auto rr = __builtin_amdgcn_permlane32_swap(__float_as_uint(pmax), __float_as_uint(pmax), false, false);
      pmax = fmaxf(__uint_as_float(rr[0]), __uint_as_float(rr[1])); }
    constexpr float C2 = 1.4426950408889634f * SCALE;
    dead = __all((pmax - m_reg) * SCALE < -T_DEAD);
    if (dead) { mn = m_reg; alpha = 1.f; return; }
    if (__builtin_expect(__all((pmax - m_reg) * SCALE <= THR), 1)) { mn = m_reg; alpha = 1.f; }
    else { mn = fmaxf(m_reg, pmax); alpha = __builtin_amdgcn_exp2f((m_reg - mn) * C2); m_reg = mn; }
    const float mnL = -mn * C2;
    for (int r = 0; r < 16; ++r) p0[r] = fmaf(p0[r], C2, mnL); for (int r = 0; r < 16; ++r) p1[r] = fmaf(p1[r], C2, mnL);
    for (int r = 0; r < 16; ++r) p0[r] = __builtin_amdgcn_exp2f(p0[r]);
}
__device__ __forceinline__ void finishSM(f32x16& p0, f32x16& p1, float alpha, float& l_reg, bf16x8& pa0, bf16x8& pa1, bf16x8& pa2, bf16x8& pa3) {
    for (int r = 0; r < 16; ++r) p1[r] = __builtin_amdgcn_exp2f(p1[r]);
    float ps = 0; for (int r = 0; r < 16; ++r) ps += p0[r]; for (int r = 0; r < 16; ++r) ps += p1[r];
    { auto rr = __builtin_amdgcn_permlane32_swap(__float_as_uint(ps), __float_as_uint(ps), false, false);
      ps = __uint_as_float(rr[0]) + __uint_as_float(rr[1]); }
    l_reg = l_reg * alpha + ps;
#define PK4(P, B_, OUT) do { unsigned a0 = cvtpk(P[B_+0], P[B_+1]), a1 = cvtpk(P[B_+2], P[B_+3]);                          \
        unsigned b0 = cvtpk(P[B_+4], P[B_+5]), b1 = cvtpk(P[B_+6], P[B_+7]);                                             \
        auto r0 = __builtin_amdgcn_permlane32_swap(a0, b0, false, false); auto r1 = __builtin_amdgcn_permlane32_swap(a1, b1, false, false); \
        u32x4 w = {r0[0], r1[0], r0[1], r1[1]}; OUT = *reinterpret_cast<bf16x8*>(&w); } while (0)
    PK4(p0, 0, pa0); PK4(p0, 8, pa1); PK4(p1, 0, pa2); PK4(p1, 8, pa3);
#undef PK4
}
template <int KB, bool SK>
__device__ __forceinline__ void qkt(f32x16& p0, f32x16& p1, const char* K_lds, int r32, int hi, const bf16x8* qr, bool act, const float* bl) {
    if (SK && !act) { const float NEG = -__builtin_inff();
#pragma unroll
        for (int r = 0; r < 16; ++r) { p0[r] = NEG; p1[r] = NEG; } return; }
#pragma unroll
    for (int g_ = 0; g_ < 4; ++g_) { const f32x4 t0 = *(const f32x4*)(bl + 8 * g_), t1 = *(const f32x4*)(bl + 32 + 8 * g_);
#pragma unroll
        for (int e_ = 0; e_ < 4; ++e_) { p0[4 * g_ + e_] = t0[e_]; p1[4 * g_ + e_] = t1[e_]; } }
    const char* kb[4];
#pragma unroll
    for (int dd = 0; dd < 4; ++dd) kb[dd] = K_lds + KB * SHM_K + KSWZ(r32, (dd * 16 + hi * 8) * 2);
#pragma unroll
    for (int d0 = 0; d0 < 8; ++d0) { const char* a = kb[d0 & 3] + (d0 >> 2) * 128;
        bf16x8 b0 = *reinterpret_cast<const bf16x8*>(a);
        bf16x8 b1 = *reinterpret_cast<const bf16x8*>(a + 32 * 256);
        p0 = __builtin_amdgcn_mfma_f32_32x32x16_bf16(b0, qr[d0], p0, 0, 0, 0);
        p1 = __builtin_amdgcn_mfma_f32_32x32x16_bf16(b1, qr[d0], p1, 0, 0, 0); }
}
template <int VB, bool SK>
__device__ __forceinline__ void pv_tile(f32x16* o, int vb0, bf16x8 pa0, bf16x8 pa1, bf16x8 pa2, bf16x8 pa3, bool act) {
    if (SK && !act) return;
#define TRRD(dst, off) asm volatile("ds_read_b64_tr_b16 %0, %1 offset:%2" : "=&v"(dst) : "v"(vb0), "i"(off) : "memory")
#define PV_D0(d0) do { s16x4 l0, l1, l2, l3, h0, h1, h2, h3; constexpr int b_ = VB * SHM_V + v_rd_off(d0, 0, 0);     \
        TRRD(l0, b_); TRRD(h0, b_ + 2048); TRRD(l1, b_ + 4096); TRRD(h1, b_ + 6144); TRRD(l2, b_ + 8192); TRRD(h2, b_ + 10240); TRRD(l3, b_ + 12288); TRRD(h3, b_ + 14336); \
        asm volatile("s_waitcnt lgkmcnt(0)" ::: "memory"); SBAR();                 \
        o[d0] = __builtin_amdgcn_mfma_f32_32x32x16_bf16(pa0, (bf16x8){l0[0], l0[1], l0[2], l0[3], h0[0], h0[1], h0[2], h0[3]}, o[d0], 0, 0, 0);   \
        o[d0] = __builtin_amdgcn_mfma_f32_32x32x16_bf16(pa1, (bf16x8){l1[0], l1[1], l1[2], l1[3], h1[0], h1[1], h1[2], h1[3]}, o[d0], 0, 0, 0);   \
        o[d0] = __builtin_amdgcn_mfma_f32_32x32x16_bf16(pa2, (bf16x8){l2[0], l2[1], l2[2], l2[3], h2[0], h2[1], h2[2], h2[3]}, o[d0], 0, 0, 0);   \
        o[d0] = __builtin_amdgcn_mfma_f32_32x32x16_bf16(pa3, (bf16x8){l3[0], l3[1], l3[2], l3[3], h3[0], h3[1], h3[2], h3[3]}, o[d0], 0, 0, 0); } while (0)
    PV_D0(0); PV_D0(1); PV_D0(2); PV_D0(3);
#undef PV_D0
#undef TRRD
}

template <class TIn, class TOut> struct BlockRef { const TIn* Q; const TIn* K; const TIn* V; TOut* O; const float* Bias; const TIn* G; int P0; int JLO; };
#define FX_LASU __attribute__((address_space(3))) unsigned
#define BIAS_DMA(ref) do { _Pragma("unroll") for (int i_ = 0; i_ < 2; ++i_) __builtin_amdgcn_global_load_lds((const unsigned*)((ref).Bias + (size_t)(i_ * 512 + tid) * 4), (FX_LASU*)(lds + BIAS_OFF + i_ * 8192 + wid * 1024), 16, 0, 0); } while (0)
template <class TIn> struct Seam {
    bf16x8 qr[8];
    bf16x8 st_v0, st_v1, st_k0, st_k1; f32x4 sf0, sf1, sf2, sf3;
    f32x4 tq[16];
};
__device__ __forceinline__ int swa_jlo(int P0, int W) { const int lowk = P0 - W + 1; return lowk > 0 ? lowk / KVBLK : 0; }
#define ROW(p, k0, rr) ((p) + (size_t)((k0) + (rr)) * RS + sc)
#define VMW() asm volatile("s_waitcnt vmcnt(0)" ::: "memory")
#define VMWN(n) asm volatile("s_waitcnt vmcnt(%0)" :: "i"(n) : "memory")
#define SLOAD_H(Kp, Vp, k0) do { S.st_v0 = load8<TIn>(ROW(Vp, k0, sr)); S.st_v1 = load8<TIn>(ROW(Vp, k0, 32 + sr));              \
                         S.st_k0 = load8<TIn>(ROW(Kp, k0, sr)); S.st_k1 = load8<TIn>(ROW(Kp, k0, 32 + sr)); } while (0)
#define SWRITE_HK(bf) do { *(bf16x8*)(K_lds + (bf) * SHM_K + kws) = S.st_k0; *(bf16x8*)(K_lds + (bf) * SHM_K + kws + 32 * 256) = S.st_k1; } while (0)
#define SWRITE_HV(bf) do { *(bf16x8*)(V_lds + (bf) * SHM_V + vst0) = S.st_v0; *(bf16x8*)(V_lds + (bf) * SHM_V + vst1) = S.st_v1; } while (0)
#define SWRITE_H(bf) do { SWRITE_HV(bf); SWRITE_HK(bf); } while (0)
#define SLOAD_F(p, k0) do { S.sf0 = *(const f32x4*)ROW(p, k0, sr); S.sf1 = *(const f32x4*)(ROW(p, k0, sr) + 4);                \
                            S.sf2 = *(const f32x4*)ROW(p, k0, 32 + sr); S.sf3 = *(const f32x4*)(ROW(p, k0, 32 + sr) + 4); } while (0)
#define SWRITE_KF(bf) do { *(bf16x8*)(K_lds + (bf) * SHM_K + kws) = pack8(S.sf0, S.sf1); *(bf16x8*)(K_lds + (bf) * SHM_K + kws + 32 * 256) = pack8(S.sf2, S.sf3); } while (0)
#define SWRITE_VF(bf) do { *(bf16x8*)(V_lds + (bf) * SHM_V + vst0) = pack8(S.sf0, S.sf1); *(bf16x8*)(V_lds + (bf) * SHM_V + vst1) = pack8(S.sf2, S.sf3); } while (0)
template <class TIn, class TOut>
__device__ __forceinline__ void causal_swa_prime(const BlockRef<TIn, TOut>& cur, int W, char* lds, Seam<TIn>& S, int tid_in) {
    constexpr bool F32 = same_t<TIn, float>::v;
    int tid_l_ = tid_in; asm volatile("" : "+v"(tid_l_));
    const int tid = tid_l_, wid = __builtin_amdgcn_readfirstlane(tid >> 6), lane = tid & 63, r32 = lane & 31, hi = lane >> 5;
    const int sr = tid >> 4, sc = (tid & 15) * 8, kws = KSWZ(sr, sc * 2); char* K_lds = lds + 2 * SHM_V;
    const int kb0 = ((cur.P0 + QB - 1) / KVBLK) * KVBLK;
    for (int d0 = 0; d0 < 8; ++d0) S.qr[d0] = load8<TIn>(cur.Q + (size_t)(wid * QBLK + r32) * RS + d0 * 16 + hi * 8);
    BIAS_DMA(cur);
    if constexpr (F32) { SLOAD_F((const float*)cur.K, kb0); VMW(); SWRITE_KF(0); SBAR(); SLOAD_F((const float*)cur.V, kb0); }
    else { SLOAD_H(cur.K, cur.V, kb0); VMW(); SWRITE_HK(0); }
    __syncthreads();
}
template <class TIn, class TOut>
__device__ __forceinline__ void causal_swa_block(const BlockRef<TIn, TOut>& cur, const BlockRef<TIn, TOut>& nxt, int skv, int W, char* lds, Seam<TIn>& S, int tid_in) {
    constexpr bool F32 = same_t<TIn, float>::v;
    int tid_l_ = tid_in; asm volatile("" : "+v"(tid_l_));
    const int tid = tid_l_, wid = __builtin_amdgcn_readfirstlane(tid >> 6), lane = tid & 63, r32 = lane & 31, hi = lane >> 5;
    const int j_lo = cur.JLO;
    int j_hi = (cur.P0 + QB - 1) / KVBLK + 1; if (j_hi > skv / KVBLK) j_hi = skv / KVBLK;
    const int NT = j_hi - j_lo;
    const int kbn = ((nxt.P0 + QB - 1) / KVBLK) * KVBLK;
    const int qlo = cur.P0 + wid * QBLK, qm = qlo + r32 - 4 * hi;
    char* V_lds = lds; char* K_lds = lds + 2 * SHM_V; const float* bias_l = (const float*)(lds + BIAS_OFF) + 4 * hi;
    float* ws = (float*)(lds + 2 * SHM_V + 2 * SHM_K) + wid * 64; float* li_l = ws, * al_l = ws + 32;
    float m_reg = -1e30f, l_reg = 0; f32x16 o[4] = {};
    const int sr = tid >> 4, sc = (tid & 15) * 8, vst0 = v_st(sr, sc), vst1 = v_st(32 + sr, sc), kws = KSWZ(sr, sc * 2);
    const int vb0 = (int)(uintptr_t)V_lds + v_rd_base(lane);
    const TIn* Kh = cur.K; const TIn* Vh = cur.V;
#define RESC(a) do { if (__any((a) < 1.f)) { if (hi == 0) al_l[r32] = (a); asm volatile("s_waitcnt lgkmcnt(0)" ::: "memory");              \
                     for (int d_ = 0; d_ < 4; ++d_) for (int r = 0; r < 16; ++r) o[d_][r] *= al_l[crow(r, hi)]; } } while (0)
#define KBASE(t) ((j_hi - 1 - (t)) * KVBLK)
#define ACT(t) (KBASE(t) <= qlo + QBLK - 1 && KBASE(t) + KVBLK - 1 >= qlo - W + 1)
#define MASKT(P0_, P1_, t) do { const int kb_ = KBASE(t); if ((!SK || ACT(t)) && (kb_ + KVBLK - 1 > qlo || kb_ <= qlo + QBLK - 1 - W)) mask_tile(P0_, P1_, qm - kb_, (unsigned)W); } while (0)
    constexpr int NQL = F32 ? 16 : 8;
    constexpr bool SK = WSKIP && !F32;
#define SEAM_K0() do { if constexpr (F32) { VMWN(NQL); SWRITE_KF(0); SBAR(); SLOAD_F((const float*)nxt.V, kbn); } else { VMW(); SWRITE_HK(0); } SBAR(); } while (0)
    f32x16 pA0, pA1, pB0, pB1; float mnA, mnB, alA, alB; bf16x8 pa0, pa1, pa2, pa3;
    if constexpr (F32) { VMW(); SWRITE_VF(0); SBAR(); } else { SWRITE_HV(0); SBAR(); }
    if (NT > 1) { if constexpr (F32) SLOAD_F((const float*)Kh, KBASE(1)); else SLOAD_H(Kh, Vh, KBASE(1)); }
    SBAR(); qkt<0, SK>(pA0, pA1, K_lds, r32, hi, S.qr, ACT(0), bias_l + KBASE(0));
    if constexpr (F32) { if (NT > 1) { VMW(); SWRITE_KF(1); SBAR(); SLOAD_F((const float*)Vh, KBASE(1)); } }
    bool dA = false, dB = false;
    MASKT(pA0, pA1, 0); partialSM(pA0, pA1, m_reg, mnA, alA, dA);
    if (NT > 1) { VMW(); if constexpr (F32) { SWRITE_VF(1); SBAR(); if (NT > 2) SLOAD_F((const float*)Kh, KBASE(2)); } else SWRITE_H(1); }
    __syncthreads();
#define HALF_STEP(PX0, PX1, mnX, alX, dX, PY0, PY1, alY, dY, t, KB, VB, SB) do {                                                      \
        if constexpr (!F32) { if ((t) + 1 < NT) SLOAD_H(Kh, Vh, KBASE((t) + 1)); }     \
        SBAR(); qkt<KB, SK>(PX0, PX1, K_lds, r32, hi, S.qr, ACT(t), bias_l + KBASE(t));                                             \
        if (!(dY)) finishSM(PY0, PY1, alY, l_reg, pa0, pa1, pa2, pa3); SBAR();                                                \
        if ((t) + 1 < NT) { if constexpr (F32) { VMW(); SWRITE_KF(SB); SBAR(); SLOAD_F((const float*)Vh, KBASE((t) + 1)); }  \
                            SBAR(); }                                                                                        \
        if (!(dY)) pv_tile<VB, SK>(o, vb0, pa0, pa1, pa2, pa3, ACT((t) - 1)); MASKT(PX0, PX1, (t)); partialSM(PX0, PX1, m_reg, mnX, alX, dX);                                        \
        __syncthreads();                                                                                                      \
        if ((t) + 1 < NT) { VMW(); if constexpr (F32) { SWRITE_VF(SB); SBAR(); if ((t) + 2 < NT) SLOAD_F((const float*)Kh, KBASE((t) + 2)); } \
                            else { SWRITE_H(SB); } }                                                                          \
        RESC(alX); __syncthreads(); } while (0)
    for (int t = 1; t + 1 < NT; t += 2) {
        HALF_STEP(pB0, pB1, mnB, alB, dB, pA0, pA1, alA, dA, t, 1, 0, 0);
        HALF_STEP(pA0, pA1, mnA, alA, dA, pB0, pB1, alB, dB, t + 1, 0, 1, 1);
    }
    const bool even = (NT & 1) == 0;
    if (even) { SBAR(); qkt<1, SK>(pB0, pB1, K_lds, r32, hi, S.qr, ACT(NT - 1), bias_l + KBASE(NT - 1)); SBAR(); } else { BIAS_DMA(nxt); }
    { const char* gsrc_ = (const char*)(cur.G + (size_t)(wid * QBLK + (lane >> 4)) * RS + (lane & 15) * 8);
      _Pragma("unroll") for (int i_ = 0; i_ < 8; ++i_) __builtin_amdgcn_global_load_lds((const unsigned*)(gsrc_ + (size_t)i_ * 4 * RS * 2), (FX_LASU*)(lds + GATE_OFF + wid * 8192 + i_ * 1024), 16, 0, 0); }
#define QROW(e) (nxt.Q + (size_t)(wid * QBLK + r32) * RS + ((e) >> 1) * 16 + hi * 8 + ((e) & 1) * 4)
    if constexpr (F32) { SLOAD_F((const float*)nxt.K, kbn); SBAR();
#pragma unroll
        for (int e = 0; e < 8; ++e) S.tq[e] = *(const f32x4*)QROW(e); }
    else { SLOAD_H(nxt.K, nxt.V, kbn); SBAR();
#pragma unroll
        for (int d0 = 0; d0 < 8; ++d0) S.qr[d0] = load8<TIn>(nxt.Q + (size_t)(wid * QBLK + r32) * RS + d0 * 16 + hi * 8); }
    SBAR();
    if (!dA) finishSM(pA0, pA1, alA, l_reg, pa0, pa1, pa2, pa3); SBAR();
    if constexpr (F32) {
#pragma unroll
        for (int e = 8; e < 16; ++e) S.tq[e] = *(const f32x4*)QROW(e); SBAR(); }
#undef QROW
    if (!dA) pv_tile<0, SK>(o, vb0, pa0, pa1, pa2, pa3, ACT(even ? NT - 2 : NT - 1));
    if (even) { MASKT(pB0, pB1, NT - 1); partialSM(pB0, pB1, m_reg, mnB, alB, dB); __syncthreads(); BIAS_DMA(nxt); RESC(alB);
        if (!dB) { finishSM(pB0, pB1, alB, l_reg, pa0, pa1, pa2, pa3); SBAR(); pv_tile<1, SK>(o, vb0, pa0, pa1, pa2, pa3, ACT(NT - 1)); } }
    SBAR(); SEAM_K0();
    if (hi == 0) li_l[r32] = l_reg; asm volatile("s_waitcnt lgkmcnt(0)" ::: "memory");
    float rli[16];
#pragma unroll
    for (int r = 0; r < 16; ++r) rli[r] = __builtin_amdgcn_rcpf(li_l[crow(r, hi)]);
    TOut* Owl = cur.O + (size_t)(wid * QBLK + 4 * hi) * OS + r32; const char* gll = lds + GATE_OFF + wid * 8192 + hi * 1024 + r32 * 2;
#pragma unroll
    for (int r = 0; r < 16; ++r) { constexpr int dummy_ = 0; const int rc = (r & 3) + 8 * (r >> 2);
#pragma unroll
        for (int d0 = 0; d0 < 4; ++d0) { const float v = o[d0][r] * rli[r];
            const float vn = mk_xor1(v);
            if ((r32 & 1) == 0) { const unsigned gg = *(const unsigned*)(gll + rc * 256 + d0 * 64);
                const float g0 = __uint_as_float(gg << 16), g1 = __uint_as_float(gg & 0xffff0000u);
                const float s0 = __builtin_amdgcn_rcpf(1.f + __expf(-g0)), s1 = __builtin_amdgcn_rcpf(1.f + __expf(-g1));
                *(unsigned*)(Owl + (size_t)rc * OS + d0 * 32) = cvtpk(v * s0, vn * s1); } }
        SBAR(); }
    if constexpr (F32) {
#pragma unroll
        for (int d0 = 0; d0 < 8; ++d0) S.qr[d0] = pack8(S.tq[2 * d0], S.tq[2 * d0 + 1]); }
    __syncthreads();
#undef RESC
#undef KBASE
#undef ACT
#undef MASKT
#undef SEAM_K0
#undef HALF_STEP
}
#undef ROW
#undef VMW
#undef VMWN
#undef SLOAD_H
#undef SWRITE_HK
#undef SWRITE_HV
#undef SWRITE_H
#undef SLOAD_F
#undef SWRITE_KF
#undef SWRITE_VF

}

typedef unsigned short bf16_t;
typedef float f32x4 __attribute__((ext_vector_type(4)));
typedef float f32x16 __attribute__((ext_vector_type(16)));
typedef float f32x2 __attribute__((ext_vector_type(2)));
typedef short bf16x8 __attribute__((ext_vector_type(8)));
typedef short bf16x4 __attribute__((ext_vector_type(4)));
typedef unsigned u32x4 __attribute__((ext_vector_type(4)));
typedef unsigned u32x2 __attribute__((ext_vector_type(2)));
constexpr int DM = 2048, NBATCH = 4, SEQ = 4096, MTOK = NBATCH * SEQ, DFF = 5632;
constexpr float LN_EPS = 1e-5f, RMS_EPS = 1e-5f, DN_ALPHA = 1.6817928305074290f;
constexpr size_t MiB = 1u << 20;
constexpr size_t WS_CTL = 0, CTL_ZERO_BYTES = 1 * MiB;
constexpr size_t WS_MOD = 1 * MiB;
constexpr size_t WS_SK16 = 2 * MiB;
constexpr size_t WS_FB = 3 * MiB;
constexpr size_t WS_ELAST = 4 * MiB;
constexpr size_t WS_ST = 5 * MiB;
constexpr size_t WS_ID = 5 * MiB + 512 * 1024;
constexpr size_t WS_WFOX = 8 * MiB;
constexpr size_t WS_WGLA = 88 * MiB;
constexpr size_t WS_WCONV = 120 * MiB;
constexpr size_t WS_WUP = 152 * MiB;
constexpr size_t WS_WDOWN = 328 * MiB;
constexpr size_t WS_H = 416 * MiB;
constexpr size_t WS_PROJ = 480 * MiB;
constexpr size_t WS_ACT = 832 * MiB;
constexpr size_t WS_QD = 1008 * MiB, WS_KI = 1040 * MiB, WS_KDT = 1072 * MiB, WS_VT = 1104 * MiB;
constexpr size_t WS_OINT = 1168 * MiB;
constexpr size_t WS_QDF = 1296 * MiB;
constexpr size_t WS_N2P = 1328 * MiB;
constexpr size_t WS_XB = 1336 * MiB;
constexpr size_t WS_PART = 1400 * MiB, PART_BYTES = 8 * MiB;
constexpr size_t WS_END = 1408 * MiB;
constexpr int LDS_TOTAL = 163840, MISC_OFF = LDS_TOTAL - 64;
constexpr int CW_BAR = 4096;

__device__ __forceinline__ float bf2f(unsigned short b) { return __uint_as_float(((unsigned)b) << 16); }
__device__ __forceinline__ unsigned pk2(float lo, float hi) { return pg8::cvt_pk_bf16(lo, hi); }
__device__ __forceinline__ unsigned short f2bf(float f) { return (unsigned short)(pk2(f, 0.f) & 0xffffu); }
template <int CTRL> __device__ __forceinline__ float dpp_rot(float v) { return __builtin_bit_cast(float, __builtin_amdgcn_update_dpp(0, __builtin_bit_cast(int, v), CTRL, 0xf, 0xf, false)); }
__device__ __forceinline__ float wave_sum(float v) {
    v += dpp_rot<0x128>(v); v += dpp_rot<0x124>(v); v += dpp_rot<0x122>(v); v += dpp_rot<0x121>(v);
    { auto rr = __builtin_amdgcn_permlane16_swap(__float_as_uint(v), __float_as_uint(v), false, false); v = __uint_as_float(rr[0]) + __uint_as_float(rr[1]); }
    { auto rr = __builtin_amdgcn_permlane32_swap(__float_as_uint(v), __float_as_uint(v), false, false); v = __uint_as_float(rr[0]) + __uint_as_float(rr[1]); }
    return v;
}
__device__ __forceinline__ float log_sigmoid(float x) { return fminf(x, 0.f) - __logf(1.f + __expf(-fabsf(x))); }
__device__ __forceinline__ float silu_f(float x) { return x * __builtin_amdgcn_rcpf(1.f + __expf(-x)); }
__device__ __forceinline__ int crow(int r, int hi) { return (r & 3) + 8 * (r >> 2) + 4 * hi; }
__device__ __forceinline__ void cvt8(const u32x4 w, float (&f)[8]) {
    f[0] = __uint_as_float(w.x << 16); f[1] = __uint_as_float(w.x & 0xffff0000u); f[2] = __uint_as_float(w.y << 16); f[3] = __uint_as_float(w.y & 0xffff0000u);
    f[4] = __uint_as_float(w.z << 16); f[5] = __uint_as_float(w.z & 0xffff0000u); f[6] = __uint_as_float(w.w << 16); f[7] = __uint_as_float(w.w & 0xffff0000u);
}
__device__ __forceinline__ u32x4 pack8f(const float (&f)[8]) { u32x4 w; w.x = pk2(f[0], f[1]); w.y = pk2(f[2], f[3]); w.z = pk2(f[4], f[5]); w.w = pk2(f[6], f[7]); return w; }

#define XB_TMO      128
#define XB_XCNT(j)  (256  + 64 * (j))
#define XB_XSUB(j)  (1280 + 64 * (j))
#define XB_XGEN(j)  (2304 + 64 * (j))
#define XB_TOP      3328
#define XB_TOPGEN   3392
#define XCD_BAR_WORDS 3456
#define XB_SPIN_CAP (1u << 18)
#define LAS __attribute__((address_space(3)))

__device__ __forceinline__ unsigned xb_ld(unsigned* p)              { return __hip_atomic_load(p, __ATOMIC_RELAXED, __HIP_MEMORY_SCOPE_AGENT); }
__device__ __forceinline__ unsigned xb_add(unsigned* p, unsigned v) { return __hip_atomic_fetch_add(p, v, __ATOMIC_RELAXED, __HIP_MEMORY_SCOPE_AGENT); }
__device__ __forceinline__ unsigned xb_xcc_id() { return (unsigned)__builtin_amdgcn_s_getreg((3 << 11) | 20) & 0xFu; }
#define XB_SPIN(cond, bar) do { unsigned _sp = 0; while (cond) { __builtin_amdgcn_s_sleep(1); \
    if ((++_sp & 255u) == 0u) { if (xb_ld(&(bar)[XB_TMO])) break; if (_sp > XB_SPIN_CAP) { atomicAdd(&(bar)[XB_TMO], 1u); break; } } } } while (0)

struct XcdBarrier {
    unsigned* bar; unsigned x;
    volatile LAS unsigned* st;
};

__device__ __forceinline__ XcdBarrier xcd_barrier_post(unsigned* bar, volatile LAS unsigned* st, int xb_tid) {
    XcdBarrier b; b.bar = bar; b.x = xb_xcc_id(); b.st = st;
    if (xb_tid == 0) (void)xb_add(&bar[XB_XCNT(b.x)], 1u);
    return b;
}
__device__ __forceinline__ void xcd_barrier_complete(unsigned* bar, unsigned x, unsigned& nloc, unsigned& nx) {
    const unsigned G = gridDim.x * gridDim.y * gridDim.z;
    unsigned sum, cnt, mine, sp = 0u;
    for (;;) {
        sum = 0u; cnt = 0u; mine = 0u;
#pragma unroll
        for (unsigned j = 0; j < 16; ++j) { const unsigned c = xb_ld(&bar[XB_XCNT(j)]); sum += c; cnt += (c > 0u) ? 1u : 0u; mine = (j == x) ? c : mine; }
        if (sum == G) break;
        __builtin_amdgcn_s_sleep(1);
        if ((++sp & 255u) == 0u) { if (xb_ld(&bar[XB_TMO])) break; if (sp > XB_SPIN_CAP) { atomicAdd(&bar[XB_TMO], 1u); break; } }
    }
    nloc = mine > 0u ? mine : 1u; nx = cnt > 0u ? cnt : 1u;
}

__device__ __forceinline__ void xcd_barrier(const XcdBarrier& b, int xb_tid) {
    asm volatile("s_waitcnt vmcnt(0)" ::: "memory");
    __syncthreads();
    if (xb_tid == 0) {
        unsigned* bar = b.bar;
        __builtin_amdgcn_s_waitcnt(0);
        unsigned nloc = b.st[0], nx = b.st[1];
        if (nloc == 0u) { xcd_barrier_complete(bar, b.x, nloc, nx); b.st[0] = nloc; b.st[1] = nx; }
        const unsigned old = xb_add(&bar[XB_XSUB(b.x)], 1u);
        const unsigned gen = old / nloc;
        if (old + 1u == (gen + 1u) * nloc) {
            __builtin_amdgcn_fence(__ATOMIC_RELEASE, "agent");
            asm volatile("s_waitcnt vmcnt(0)" ::: "memory");
            const unsigned og = xb_add(&bar[XB_TOP], 1u);
            const unsigned tg = og / nx;
            if (og + 1u == (tg + 1u) * nx) xb_add(&bar[XB_TOPGEN], 1u);
            else XB_SPIN(xb_ld(&bar[XB_TOPGEN]) == tg, bar);
            __builtin_amdgcn_fence(__ATOMIC_ACQUIRE, "agent");
            xb_add(&bar[XB_XGEN(b.x)], 1u);
            asm volatile("s_waitcnt vmcnt(0)" ::: "memory");
        } else {
            XB_SPIN(xb_ld(&bar[XB_XGEN(b.x)]) == gen, bar);
            __builtin_amdgcn_fence(__ATOMIC_ACQUIRE, "agent");
            asm volatile("s_waitcnt vmcnt(0)" ::: "memory");
        }
    }
    __syncthreads();
}


#define MK_GRID_VARS int BID = blockIdx.x, NBLK = gridDim.x; asm volatile("" : "+s"(BID), "+s"(NBLK))
struct Args { const float* in[31]; float* out; unsigned char* ws; int ph_lo, ph_hi, flags, pad; };

namespace pg8 {
struct EpiResidLN {
    static constexpr bool PERM = true, AFTER_DRAIN = false;
    unsigned char* w; const float* lngn; const float* lnbn; int goff, scoff, shoff, vpar, slot;
    __device__ __forceinline__ void unit_begin(PG8_LAS unsigned char* lds, const Unit& u, int ui, int wid, int) const {
        int lane; asm volatile("v_mbcnt_lo_u32_b32 %0, -1, 0\n\tv_mbcnt_hi_u32_b32 %0, -1, %0" : "=&v"(lane));
        const float* MOD = (const float*)(w + WS_MOD); const float* stats = (const float*)(w + WS_ST); const int b = (u.pm * BM) >> 12;
        const float* src;
        if (wid == 0) src = MOD + goff + (size_t)b * 12288; else if (wid == 1) src = stats + 2 * MTOK + vpar; else if (wid == 2) src = stats + 2 * MTOK + vpar + 2048;
        else if (wid == 5) src = lngn; else if (wid == 6) src = lnbn; else src = MOD + scoff + (size_t)b * 12288;
        src += u.pn * BM + lane * 4;
        if (wid == 3 || wid == 4) src = stats + (size_t)(u.pm * BM + (wid - 3) * 128) * 2 + lane * 4;
        __builtin_amdgcn_global_load_lds((const unsigned*)src, (PG8_LAS unsigned*)(lds + EPI_LDS_OFF + (ui & 1) * EPI_LDS_PAR + wid * 1024), 16, 0, 0);
        if (wid == 0) __builtin_amdgcn_global_load_lds((const unsigned*)(MOD + shoff + (size_t)b * 12288 + u.pn * BM + lane * 4), (PG8_LAS unsigned*)(lds + EPI_LDS_OFF + (ui & 1) * EPI_LDS_PAR + 8 * 1024), 16, 0, 0);
    }
    __device__ __forceinline__ void operator()(const f32x4 (&acc_)[2][2][4][2], const Unit& u, int wr, int wc, int fr, int fq, PG8_LAS unsigned char* lds, int ui) const {
        f32x4 (&acc)[2][2][4][2] = const_cast<f32x4 (&)[2][2][4][2]>(acc_);
        const int row0 = u.pm * BM + wr * 64 + fr, col0 = u.pn * BM + wc * 32 + 8 * fq;
        bf16_t* X = (bf16_t*)(w + WS_XB); bf16_t* Hn = (bf16_t*)(w + WS_H); float* stats = (float*)(w + WS_ST);
        const PG8_LAS float* lv = (const PG8_LAS float*)(lds + EPI_LDS_OFF + (ui & 1) * EPI_LDS_PAR) + wc * 32 + 8 * fq;
#pragma unroll
        for (int ai = 0; ai < 2; ++ai) {
            u32x4 xb[4][2]; f32x2 st[4];
#pragma unroll
            for (int m = 0; m < 4; ++m) { const bf16_t* rowp = X + (size_t)(row0 + ai * HALF + m * 16) * 2048 + col0; xb[m][0] = *(const u32x4*)(rowp); xb[m][1] = *(const u32x4*)(rowp + HALF); }
            __builtin_amdgcn_sched_barrier(0);
#pragma unroll
            for (int m = 0; m < 4; ++m) st[m] = ((const PG8_LAS f32x2*)(lds + EPI_LDS_OFF + (ui & 1) * EPI_LDS_PAR + 3072))[ai * HALF + wr * 64 + m * 16 + fr];
#pragma unroll
            for (int bj = 0; bj < 2; ++bj) {
                const f32x4 g0 = *(const PG8_LAS f32x4*)(lv + bj * HALF), g1 = *(const PG8_LAS f32x4*)(lv + bj * HALF + 4);
                const f32x4 a0 = *(const PG8_LAS f32x4*)(lv + 256 + bj * HALF), a1 = *(const PG8_LAS f32x4*)(lv + 256 + bj * HALF + 4);
                const f32x4 b0 = *(const PG8_LAS f32x4*)(lv + 512 + bj * HALF), b1 = *(const PG8_LAS f32x4*)(lv + 512 + bj * HALF + 4);
#pragma unroll
                for (int m = 0; m < 4; ++m) {
                    bf16_t* rowp = X + (size_t)(row0 + ai * HALF + m * 16) * 2048 + col0 + bj * HALF; const float mean = st[m][0], rstd = st[m][1];
                    const u32x4 xw = xb[m][bj]; f32x4 x0, x1;
                    x0[0] = __uint_as_float(xw.x << 16); x0[1] = __uint_as_float(xw.x & 0xffff0000u); x0[2] = __uint_as_float(xw.y << 16); x0[3] = __uint_as_float(xw.y & 0xffff0000u);
                    x1[0] = __uint_as_float(xw.z << 16); x1[1] = __uint_as_float(xw.z & 0xffff0000u); x1[2] = __uint_as_float(xw.w << 16); x1[3] = __uint_as_float(xw.w & 0xffff0000u);
                    const f32x4 r0 = (x0 - mean) * rstd * a0 + b0 + g0 * acc[ai][bj][m][0];
                    const f32x4 r1 = (x1 - mean) * rstd * a1 + b1 + g1 * acc[ai][bj][m][1];
                    acc[ai][bj][m][0] = r0; acc[ai][bj][m][1] = r1;
                    u32x4 o; o.x = cvt_pk_bf16(r0[0], r0[1]); o.y = cvt_pk_bf16(r0[2], r0[3]); o.z = cvt_pk_bf16(r1[0], r1[1]); o.w = cvt_pk_bf16(r1[2], r1[3]);
                    *(u32x4*)rowp = o; } }
            __builtin_amdgcn_sched_barrier(0); }
        PG8_LAS float* red = (PG8_LAS float*)(lds + EPI_RED_OFF);
        PG8_LAS f32x2* ms = (PG8_LAS f32x2*)(lds + EPI_MS_OFF);
#pragma unroll
        for (int ai = 0; ai < 2; ++ai)
#pragma unroll
            for (int m = 0; m < 4; ++m) { float s = 0.f, q = 0.f;
#pragma unroll
                for (int bj = 0; bj < 2; ++bj)
#pragma unroll
                    for (int n = 0; n < 2; ++n) { const f32x4 v = acc[ai][bj][m][n]; s += (v[0] + v[1]) + (v[2] + v[3]); q += (v[0] * v[0] + v[1] * v[1]) + (v[2] * v[2] + v[3] * v[3]); }
                s = mk_sum_xor32(mk_sum_xor16(s)); q = mk_sum_xor32(mk_sum_xor16(q));
                if (fq == 0) { PG8_LAS float* d = red + ((ai * HALF + wr * 64 + m * 16 + fr) * 4 + wc) * 2; d[0] = s; d[1] = q; } }
        __syncthreads();
        const int t = (wr * 4 + wc) * 64 + fq * 16 + fr;
        if (t < 256) {
            float S = 0.f, Q = 0.f;
#pragma unroll
            for (int k = 0; k < 4; ++k) { S += red[(t * 4 + k) * 2]; Q += red[(t * 4 + k) * 2 + 1]; }
            Q = fmaxf(Q, 1e-30f);
            unsigned long long* part = (unsigned long long*)(w + WS_PART) + ((size_t)slot * 64 + u.pm) * 8 * 256;
            (void)__hip_atomic_exchange(part + u.pn * 256 + t, ((unsigned long long)__float_as_uint(Q) << 32) | (unsigned long long)__float_as_uint(S), __ATOMIC_RELAXED, __HIP_MEMORY_SCOPE_AGENT);
            float Ss = 0.f, Qs = 0.f;
#pragma unroll
            for (int j = 0; j < 8; ++j) { unsigned long long v; unsigned sp = 0;
                do { v = __hip_atomic_load(part + j * 256 + t, __ATOMIC_RELAXED, __HIP_MEMORY_SCOPE_AGENT); if ((v >> 32) != 0ull) break; __builtin_amdgcn_s_sleep(1); } while (++sp < (1u << 22));
                Ss += __uint_as_float((unsigned)v); Qs += __uint_as_float((unsigned)(v >> 32)); }
            const float mean = Ss * (1.f / 2048.f), var = fmaxf(Qs * (1.f / 2048.f) - mean * mean, 0.f), rstd = 1.f / sqrtf(var + LN_EPS);
            f32x2 mr; mr[0] = mean; mr[1] = rstd; ms[t] = mr;
            if (u.pn == 0) *(f32x2*)(stats + (size_t)(u.pm * BM + t) * 2) = mr;
        }
        __syncthreads();
#pragma unroll
        for (int bj = 0; bj < 2; ++bj) {
            f32x4 gs[2], bs[2];
#pragma unroll
            for (int n = 0; n < 2; ++n) { const f32x4 g = *(const PG8_LAS f32x4*)(lv + 5 * 256 + bj * HALF + n * 4), bb = *(const PG8_LAS f32x4*)(lv + 6 * 256 + bj * HALF + n * 4);
                const f32x4 s1 = 1.f + *(const PG8_LAS f32x4*)(lv + 7 * 256 + bj * HALF + n * 4), s0 = *(const PG8_LAS f32x4*)(lv + 8 * 256 + bj * HALF + n * 4);
                gs[n] = g * s1; bs[n] = bb * s1 + s0; }
#pragma unroll
            for (int ai = 0; ai < 2; ++ai)
#pragma unroll
                for (int m = 0; m < 4; ++m) { const f32x2 mr = ms[ai * HALF + wr * 64 + m * 16 + fr];
                    const f32x4 h0 = ((acc[ai][bj][m][0] - mr[0]) * mr[1]) * gs[0] + bs[0], h1 = ((acc[ai][bj][m][1] - mr[0]) * mr[1]) * gs[1] + bs[1];
                    u32x4 o; o.x = cvt_pk_bf16(h0[0], h0[1]); o.y = cvt_pk_bf16(h0[2], h0[3]); o.z = cvt_pk_bf16(h1[0], h1[1]); o.w = cvt_pk_bf16(h1[2], h1[3]);
                    *(u32x4*)(Hn + (size_t)(row0 + ai * HALF + m * 16) * 2048 + col0 + bj * HALF) = o; } }
    }
};
}

__device__ __forceinline__ void p0_transpose_item(const float* W, int K, int N, bf16_t* WT, int row_off, LAS float* scr, int item, int lane) {
    const int nblk = N / 32, kb = item / nblk, nb = item % nblk, k0 = 64 * kb, n0 = 32 * nb;
    int rbase = row_off + n0; if (row_off < 0) { const int half = n0 >= DFF ? 1 : 0, ch = n0 - half * DFF; rbase = 256 * (ch >> 7) + 128 * half + (ch & 127); }
#pragma unroll 8
    for (int i = 0; i < 32; ++i) { const int kk = 2 * i + (lane >> 5); scr[kk * 33 + (lane & 31)] = W[(size_t)(k0 + kk) * N + n0 + (lane & 31)]; }
    asm volatile("s_waitcnt lgkmcnt(0)" ::: "memory");
    const int c = lane & 7;
#pragma unroll
    for (int j = 0; j < 4; ++j) { const int n = (lane >> 3) + 8 * j; const LAS float* s = scr + (8 * c) * 33 + n;
        u32x4 o; o.x = pk2(s[0 * 33], s[1 * 33]); o.y = pk2(s[2 * 33], s[3 * 33]); o.z = pk2(s[4 * 33], s[5 * 33]); o.w = pk2(s[6 * 33], s[7 * 33]);
        *(u32x4*)(WT + (size_t)(rbase + n) * K + k0 + 8 * c) = o; }
    asm volatile("s_waitcnt lgkmcnt(0)" ::: "memory");
}
typedef const __attribute__((address_space(4))) Args CArgs;
__device__ __forceinline__ void phase_prologue(CArgs* ap, unsigned char* lds, int tid, int wid, int lane) {
    MK_GRID_VARS;
    unsigned char* ws = ap->ws;
    for (int t = BID; t < 192; t += NBLK) {
        float* cond = (float*)lds;
        for (int i = tid; i < 4 * DM; i += 512) { const float c = ap->in[1][i]; cond[i] = c / (1.f + __expf(-c)); }
        __syncthreads();
        const int l = t / 48, col0 = (t % 48) * 256;
        const float* wp = ap->in[2] + ((size_t)l * DM + wid * 256) * 12288 + col0 + 4 * lane;
        f32x4 acc[4] = {{0.f, 0.f, 0.f, 0.f}, {0.f, 0.f, 0.f, 0.f}, {0.f, 0.f, 0.f, 0.f}, {0.f, 0.f, 0.f, 0.f}};
#pragma unroll 8
        for (int k = 0; k < 256; ++k) { const f32x4 wv = *(const f32x4*)(wp + (size_t)k * 12288); const int kk = wid * 256 + k;
#pragma unroll
            for (int b = 0; b < 4; ++b) acc[b] += cond[b * DM + kk] * wv; }
        float* red = (float*)(lds + 32768);
#pragma unroll
        for (int b = 0; b < 4; ++b) *(f32x4*)(red + ((wid * 4 + b) * 256 + 4 * lane)) = acc[b];
        __syncthreads();
        float* mod = (float*)(ws + WS_MOD);
        for (int idx = tid; idx < 1024; idx += 512) { const int b = idx >> 8, col = idx & 255; float s = ap->in[3][l * 12288 + col0 + col];
#pragma unroll
            for (int w = 0; w < 8; ++w) s += red[(w * 4 + b) * 256 + col];
            mod[(size_t)(l * 4 + b) * 12288 + col0 + col] = s; }
        __syncthreads();
    }
    LAS float* scr = (LAS float*)((LAS unsigned char*)lds + wid * 16384);
    const int gw = BID * 8 + wid, NGW = NBLK * 8;
    bf16_t* wfox0 = (bf16_t*)(ws + WS_WFOX); bf16_t* wfox1 = (bf16_t*)(ws + WS_WFOX + 40 * MiB);
    bf16_t* wgla = (bf16_t*)(ws + WS_WGLA); bf16_t* wconv = (bf16_t*)(ws + WS_WCONV);
    bf16_t* wup = (bf16_t*)(ws + WS_WUP); bf16_t* wdn = (bf16_t*)(ws + WS_WDOWN);
    constexpr int I_DD = (DM / 64) * (DM / 32), I_DH = (DM / 64) * (1024 / 32), I_D3 = (DM / 64) * (6144 / 32), I_UP = (DM / 64) * (11264 / 32), I_DN = (DFF / 64) * (DM / 32);
    constexpr int NITEMS = 10 * I_DD + 2 * I_DH + 3 * I_DD + I_D3 + I_DD + 4 * I_UP + 4 * I_DN;
    constexpr size_t DD = (size_t)DM * DM;
#define TJOB(SRC, KK, NN, DST, ROFF, CNT) { if (r < (CNT)) { p0_transpose_item((SRC), (KK), (NN), (DST), (ROFF), scr, r, lane); continue; } r -= (CNT); }
    for (int it = gw; it < NITEMS; it += NGW) {
        int r = it;
        TJOB(ap->in[8], DM, DM, wfox0, 0, I_DD) TJOB(ap->in[9], DM, DM, wfox0, 2048, I_DD) TJOB(ap->in[10], DM, DM, wfox0, 4096, I_DD) TJOB(ap->in[11], DM, DM, wfox0, 6144, I_DD)
        TJOB(ap->in[14], DM, DM, wfox0 + (size_t)8192 * DM, 0, I_DD)
        TJOB(ap->in[8] + DD, DM, DM, wfox1, 0, I_DD) TJOB(ap->in[9] + DD, DM, DM, wfox1, 2048, I_DD) TJOB(ap->in[10] + DD, DM, DM, wfox1, 4096, I_DD) TJOB(ap->in[11] + DD, DM, DM, wfox1, 6144, I_DD)
        TJOB(ap->in[14] + DD, DM, DM, wfox1 + (size_t)8192 * DM, 0, I_DD)
        TJOB(ap->in[15], DM, 1024, wgla, 0, I_DH) TJOB(ap->in[16], DM, 1024, wgla, 1024, I_DH) TJOB(ap->in[17], DM, DM, wgla, 2048, I_DD) TJOB(ap->in[21], DM, DM, wgla, 4096, I_DD)
        TJOB(ap->in[23], DM, DM, wgla + (size_t)6144 * DM, 0, I_DD)
        TJOB(ap->in[24], DM, 6144, wconv, 0, I_D3) TJOB(ap->in[26], DM, DM, wconv + (size_t)6144 * DM, 0, I_DD)
        TJOB(ap->in[27], DM, 11264, wup, -1, I_UP) TJOB(ap->in[27] + (size_t)1 * DM * 11264, DM, 11264, wup + (size_t)1 * 11264 * DM, -1, I_UP)
        TJOB(ap->in[27] + (size_t)2 * DM * 11264, DM, 11264, wup + (size_t)2 * 11264 * DM, -1, I_UP) TJOB(ap->in[27] + (size_t)3 * DM * 11264, DM, 11264, wup + (size_t)3 * 11264 * DM, -1, I_UP)
        TJOB(ap->in[30], DFF, DM, wdn, 0, I_DN) TJOB(ap->in[30] + (size_t)1 * DFF * DM, DFF, DM, wdn + (size_t)1 * DM * DFF, 0, I_DN)
        TJOB(ap->in[30] + (size_t)2 * DFF * DM, DFF, DM, wdn + (size_t)2 * DM * DFF, 0, I_DN) TJOB(ap->in[30] + (size_t)3 * DFF * DM, DFF, DM, wdn + (size_t)3 * DM * DFF, 0, I_DN)
    }
#undef TJOB
}

template <bool SRC_BF, bool SK>
__device__ __forceinline__ void phase_lnmod(const void* src, float* X, bf16_t* H, bool do_ln, bool do_mod, const float* lng, const float* lnb,
                                            const float* sc, const float* sh, int sk_mode, const float* skW, const float* skB, float* sk_out, float* stats,
                                            unsigned char* lds, int tid, int wid, int lane, int vpar = 0) {
    MK_GRID_VARS;
    if constexpr (SK) {
        f32x4* Wl = (f32x4*)lds;
        for (int idx = tid; idx < 8192; idx += 512) { const int ln = idx & 63, q = (idx >> 6) & 3, i = (idx >> 8) & 3, j = idx >> 10;
            Wl[idx] = *(const f32x4*)(skW + (size_t)(256 * j + 4 * ln + i) * 16 + 4 * q); }
        __syncthreads();
    }
    if (stats && BID == 0) for (int i = tid; i < DM; i += 512) { stats[2 * MTOK + vpar + i] = DN_ALPHA * (do_ln ? lng[i] : 1.f); stats[2 * MTOK + vpar + DM + i] = DN_ALPHA * (do_ln ? lnb[i] : 0.f); }
    const int nw = NBLK * 8, gw = BID * 8 + wid, R = (MTOK + nw - 1) / nw, row_begin = gw * R, row_end = (row_begin + R < MTOK) ? row_begin + R : MTOK;
    if (row_begin < row_end) {
        constexpr bool DIST2 = SRC_BF && !SK;
        f32x4 gs[8], bs[8]; f32x4 vn[8]; u32x2 vbA[8], vbB[8];
#define LN_LOAD_ROW(r, VB) do { if constexpr (SRC_BF) { const u32x2* xr = (const u32x2*)((const bf16_t*)src + (size_t)(r) * DM) + lane; _Pragma("unroll") for (int j = 0; j < 8; ++j) VB[j] = xr[64 * j]; } \
                            else { const f32x4* xr = (const f32x4*)((const float*)src + (size_t)(r) * DM) + lane; _Pragma("unroll") for (int j = 0; j < 8; ++j) vn[j] = xr[64 * j]; } } while (0)
#define LN_ROW(row_, v, VB) do { float s_ = 0.f;                                                                                                                     \
            _Pragma("unroll") for (int j = 0; j < 8; ++j) {                                                                                                      \
                if constexpr (SRC_BF) { v[j][0] = __uint_as_float(VB[j].x << 16); v[j][1] = __uint_as_float(VB[j].x & 0xffff0000u); v[j][2] = __uint_as_float(VB[j].y << 16); v[j][3] = __uint_as_float(VB[j].y & 0xffff0000u); } \
                else v[j] = vn[j];                                                                                                                               \
                s_ += (v[j][0] + v[j][1]) + (v[j][2] + v[j][3]); }                                                                                               \
            if constexpr (DIST2) { if ((row_) + 2 < row_lim) LN_LOAD_ROW((row_) + 2, VB); } else { if ((row_) + 1 < row_lim) LN_LOAD_ROW((row_) + 1, VB); }                                                                                                   \
            float mean_ = 0.f, rstd_ = 1.f;                                                                                                                      \
            if (do_ln) {                                                                                                                                         \
                mean_ = wave_sum(s_) * (1.f / DM); float s2_ = 0.f;                                                                                              \
                _Pragma("unroll") for (int j = 0; j < 8; ++j) { v[j] = v[j] - mean_; s2_ += (v[j][0] * v[j][0] + v[j][1] * v[j][1]) + (v[j][2] * v[j][2] + v[j][3] * v[j][3]); } \
                rstd_ = 1.f / sqrtf(wave_sum(s2_) * (1.f / DM) + LN_EPS);                                                                                        \
                _Pragma("unroll") for (int j = 0; j < 8; ++j) v[j] = (v[j] * rstd_) * gs[j] + bs[j];                                                             \
            } else {                                                                                                                                             \
                _Pragma("unroll") for (int j = 0; j < 8; ++j) v[j] = v[j] * gs[j] + bs[j];                                                                       \
            }                                                                                                                                                    \
            if (stats) { if (lane == 0) { f32x2 st; st[0] = mean_; st[1] = rstd_; *(f32x2*)(stats + (size_t)(row_) * 2) = st; } }                                \
            else { f32x4* xo = (f32x4*)(X + (size_t)(row_) * DM) + lane; _Pragma("unroll") for (int j = 0; j < 8; ++j) xo[64 * j] = v[j]; }                      \
            if (do_mod) { u32x2* ho = (u32x2*)(H + (size_t)(row_) * DM) + lane;                                                                                  \
                _Pragma("unroll") for (int j = 0; j < 8; ++j) { u32x2 w; w.x = pk2(v[j][0], v[j][1]); w.y = pk2(v[j][2], v[j][3]); ho[64 * j] = w; } } } while (0)
        if (!do_mod) {
#pragma unroll
            for (int j = 0; j < 8; ++j) { gs[j] = ((const f32x4*)lng)[64 * j + lane]; bs[j] = ((const f32x4*)lnb)[64 * j + lane]; } }
        for (int seg = row_begin; seg < row_end; ) {
            const int cur_b = seg >> 12, seg_lim = (cur_b + 1) << 12, row_lim = seg_lim < row_end ? seg_lim : row_end;
            if (do_mod) {
                const f32x4* sc4 = (const f32x4*)(sc + (size_t)cur_b * 12288) + lane; const f32x4* sh4 = (const f32x4*)(sh + (size_t)cur_b * 12288) + lane;
#pragma unroll
                for (int j = 0; j < 8; ++j) { const f32x4 s1 = 1.f + sc4[64 * j], s0 = sh4[64 * j];
                    if (do_ln) { gs[j] = ((const f32x4*)lng)[64 * j + lane] * s1; bs[j] = ((const f32x4*)lnb)[64 * j + lane] * s1 + s0; } else { gs[j] = s1; bs[j] = s0; } } }
            LN_LOAD_ROW(seg, vbA);
            if constexpr (DIST2) { if (seg + 1 < row_lim) LN_LOAD_ROW(seg + 1, vbB); }
            if constexpr (!SK) {
                for (int row = seg; row < row_lim; row += 2) { f32x4 v[8]; LN_ROW(row, v, vbA); if (row + 1 < row_lim) { if constexpr (DIST2) { LN_ROW(row + 1, v, vbB); } else { LN_ROW(row + 1, v, vbA); } } }
            } else {
                for (int row = seg; row < row_lim; row += 2) {
                    f32x4 va[8], vc[8];
                    LN_ROW(row, va, vbA);
                    const bool two = row + 1 < row_lim;
                    if (two) { LN_ROW(row + 1, vc, vbA); }
                    else {
#pragma unroll
                        for (int j = 0; j < 8; ++j) vc[j] = va[j]; }
                    const f32x4* Wl = (const f32x4*)lds + lane;
                    f32x2 aa[8], ac[8];
#pragma unroll
                    for (int n = 0; n < 8; ++n) { aa[n][0] = 0.f; aa[n][1] = 0.f; ac[n] = aa[n]; }
#pragma unroll
                    for (int j = 0; j < 8; ++j)
#pragma unroll
                        for (int i = 0; i < 4; ++i) { f32x2 ha, hc; ha[0] = va[j][i]; ha[1] = va[j][i]; hc[0] = vc[j][i]; hc[1] = vc[j][i];
#pragma unroll
                            for (int q = 0; q < 4; ++q) { const f32x4 w = Wl[((j * 4 + i) * 4 + q) * 64]; f32x2 w01, w23; w01[0] = w[0]; w01[1] = w[1]; w23[0] = w[2]; w23[1] = w[3];
                                aa[2 * q] = __builtin_elementwise_fma(ha, w01, aa[2 * q]); aa[2 * q + 1] = __builtin_elementwise_fma(ha, w23, aa[2 * q + 1]);
                                ac[2 * q] = __builtin_elementwise_fma(hc, w01, ac[2 * q]); ac[2 * q + 1] = __builtin_elementwise_fma(hc, w23, ac[2 * q + 1]); }
                            if (i == 3) __builtin_amdgcn_sched_barrier(0); }
                    float mine_a = 0.f, mine_c = 0.f;
#pragma unroll
                    for (int n = 0; n < 16; ++n) { const float ta = wave_sum(aa[n >> 1][n & 1]), tc = wave_sum(ac[n >> 1][n & 1]); mine_a = (lane == n) ? ta : mine_a; mine_c = (lane == n) ? tc : mine_c; }
                    if (lane < 16) { float bias = 0.f; if (sk_mode == 1) { bias = skB[lane]; mine_a = log_sigmoid(mine_a + bias); mine_c = log_sigmoid(mine_c + bias); }
                        if (sk_mode == 1) { float* so = sk_out + ((size_t)((row >> 12) * 16 + lane) << 12) + (row & 4095);
                            so[0] = mine_a; if (two) so[1] = mine_c; }
                        else { sk_out[(size_t)row * 16 + lane] = mine_a; if (two) sk_out[(size_t)(row + 1) * 16 + lane] = mine_c; } }
                }
            }
            seg = row_lim;
        }
#undef LN_ROW
    }
}

#undef LN_LOAD_ROW
__device__ __forceinline__ void fox_cumsum(const float* logf  , float* FB  , int wid, int lane) {
    MK_GRID_VARS;
    for (int u = BID * 8 + wid; u < 64; u += NBLK * 8) {
        const int b = u >> 4, hh = u & 15;
        const float* lf = logf + (size_t)u * SEQ + lane * 64; (void)b; (void)hh;
        float v[64]; float s = 0.f;
#pragma unroll
        for (int t = 0; t < 64; t += 4) { const f32x4 x = *(const f32x4*)(lf + t); v[t] = x[0]; v[t + 1] = x[1]; v[t + 2] = x[2]; v[t + 3] = x[3]; }
#pragma unroll
        for (int t = 0; t < 64; ++t) { s += v[t]; v[t] = s; }
        float pre = s;
#pragma unroll
        for (int o = 1; o < 64; o <<= 1) { const float t = mk_shfl_up(pre, o); if (lane >= o) pre += t; }
        const float excl = pre - s;
        float* out = FB + (size_t)u * SEQ + lane * 64;
#pragma unroll
        for (int t = 0; t < 64; t += 4) { f32x4 o4; o4[0] = -(excl + v[t]) * 11.313708499f; o4[1] = -(excl + v[t + 1]) * 11.313708499f; o4[2] = -(excl + v[t + 2]) * 11.313708499f; o4[3] = -(excl + v[t + 3]) * 11.313708499f;
            *(f32x4*)(out + t) = o4; }
    }
}

constexpr float T_SKIP = 24.f;
__device__ __forceinline__ void phase_fox_attn(const bf16_t* PROJ, const float* FB, const float* N2P, bf16_t* O, char* lds, int tid) {
    MK_GRID_VARS;
    using namespace fx;
    typedef BlockRef<bf16, bf16> Ref;
    const int total = 512, stride = NBLK, lane = tid & 63, wid = __builtin_amdgcn_readfirstlane(tid >> 6);
    float* kmx = (float*)(lds + 2 * SHM_V + 2 * SHM_K);
    float* qmx = kmx + 64;
    int* jlo_l = (int*)(lds + LDS_BYTES);
    int* tab = (int*)(lds + LDS_BYTES + 64);
    const bool use_tab = NBLK == 256;
    if (use_tab) {
        if (wid == 0) {
            const float wv = FB[(size_t)lane * SEQ + SEQ - 1];
            const float Wh = mk_sum_xor32(mk_sum_xor16(wv));
            int rank = 0;
#pragma unroll
            for (int hp = 0; hp < 16; ++hp) { const float o = __uint_as_float(__builtin_amdgcn_readlane(__float_as_uint(Wh), hp)); rank += (o < Wh || (o == Wh && hp < (lane & 15))) ? 1 : 0; }
            const int x = BID & 7;
            const unsigned long long mA = __ballot(rank == x && lane < 16), mB = __ballot(rank == 15 - x && lane < 16);
            const int hA = (int)__builtin_ctzll(mA), hB = (int)__builtin_ctzll(mB);
            const int r = lane & 7, bh = ((lane >> 3) & 3) * 16 + ((lane >> 5) ? hB : hA);
            const float wi = __builtin_bit_cast(float, __builtin_amdgcn_ds_bpermute(bh << 2, __builtin_bit_cast(int, wv)));
            const float Wt = (T_SKIP + 30.f) * (4095.f / 64.f) / (wi * SCALE);
            const float est = fminf(4.f * r, Wt) + fminf(4.f * (15 - r), Wt);
            int rk = 0;
#pragma unroll
            for (int o = 0; o < 64; ++o) { const float e = __uint_as_float(__builtin_amdgcn_readlane(__float_as_uint(est), o)); rk += (e > est || (e == est && o < lane)) ? 1 : 0; }
            const int j = BID >> 3;
            const int i1 = (int)__builtin_ctzll(__ballot(rk == j)), i2 = (int)__builtin_ctzll(__ballot(rk == 63 - j));
            const int t0 = __builtin_amdgcn_readlane(bh, i1), t1 = __builtin_amdgcn_readlane(r, i1), t2 = __builtin_amdgcn_readlane(bh, i2), t3 = __builtin_amdgcn_readlane(r, i2);
            if (lane == 0) { tab[0] = t0; tab[1] = t1; tab[2] = t2; tab[3] = t3; }
        }
        __syncthreads();
    }
    {   int idx = 0;
        for (int Lx = BID; Lx < total; Lx += stride, ++idx) {
            int r, bh;
            if (use_tab) { bh = tab[idx * 2]; r = tab[idx * 2 + 1]; }
            else { const int xcd = Lx & 7, k = Lx >> 3, gi = k >> 3; r = (gi & 4) ? 7 - (k & 7) : (k & 7); bh = (gi * 8 + xcd) ^ ((gi & 4) ? 8 : 0); }
            const f32x4* kn = (const f32x4*)(N2P + ((size_t)(64 + bh) * SEQ) * 4);
            const f32x4* qn = (const f32x4*)(N2P + ((size_t)bh * SEQ) * 4);
            float km = 0.f;
#pragma unroll
            for (int e = 0; e < 8; ++e) { const f32x4 v = kn[tid * 8 + e]; km = fmaxf(km, (v[0] + v[1]) + (v[2] + v[3])); }
            km = fmaxf(km, mk_shfl_xor(km, 1)); km = fmaxf(km, mk_shfl_xor(km, 2)); km = fmaxf(km, mk_shfl_xor(km, 4));
            if ((tid & 7) == 0) kmx[tid >> 3] = km;
            for (int pass = 0; pass < 2; ++pass) {
                const int qb = pass ? 15 - r : r, P0 = qb * QB;
                __syncthreads();
                float qm = 0.f;
                if (tid < 256) { const f32x4 v = qn[P0 + tid]; qm = (v[0] + v[1]) + (v[2] + v[3]); }
#pragma unroll
                for (int o = 1; o < 64; o <<= 1) qm = fmaxf(qm, mk_shfl_xor(qm, o));
                if (lane == 0) qmx[wid] = qm;
                __syncthreads();
                if (wid == 0) {
                    const float Q = sqrtf(fmaxf(fmaxf(qmx[0], qmx[1]), fmaxf(qmx[2], qmx[3])));
                    const int jd = P0 / KVBLK;
                    const float Kd = sqrtf(fmaxf(fmaxf(kmx[jd], kmx[jd + 1]), fmaxf(kmx[jd + 2], kmx[jd + 3])));
                    const float* fb = FB + (size_t)bh * SEQ;
                    const float bound = 1.02f * Q * (sqrtf(kmx[lane]) + Kd) + (fb[lane * KVBLK + KVBLK - 1] - fb[P0]);
                    const bool keep = lane < jd && !(bound < -T_SKIP / SCALE);
                    const unsigned long long mask = __ballot(keep);
                    const int jlo = mask ? (int)__builtin_ctzll(mask) : jd;
                    if (lane == 0) jlo_l[idx * 2 + pass] = jlo;
                }
            }
            __syncthreads();
        }
    }
    int L = BID;
    if (L < total) {
        auto mkref = [&](int Lx, int pass, int slot) -> Ref {
            int r, bh;
            if (use_tab) { bh = __builtin_amdgcn_readfirstlane(tab[slot * 2]); r = __builtin_amdgcn_readfirstlane(tab[slot * 2 + 1]); }
            else { const int xcd = Lx & 7, k = Lx >> 3, gi = k >> 3; r = (gi & 4) ? 7 - (k & 7) : (k & 7); bh = (gi * 8 + xcd) ^ ((gi & 4) ? 8 : 0); }
            const int qb = pass ? 15 - r : r;
            const int b = bh >> 4, h = bh & 15; const size_t row0 = (size_t)b * SEQ + (size_t)qb * QB;
            Ref rf; const bf16* P = (const bf16*)PROJ; const size_t TS = (size_t)64 * SEQ * D, hb = (size_t)bh * SEQ * D;
            rf.Q = P + hb + (size_t)qb * QB * D; rf.K = P + TS + hb; rf.V = P + 2 * TS + hb; rf.G = P + 3 * TS + hb + (size_t)qb * QB * D;
            rf.O = (bf16*)O + row0 * OS + h * D; rf.Bias = FB + (size_t)bh * SEQ; rf.P0 = qb * QB; rf.JLO = __builtin_amdgcn_readfirstlane(jlo_l[slot * 2 + pass]); return rf; };
        int pass = 0, slot = 0; Ref cur = mkref(L, 0, 0);
        Seam<bf16> S;
        causal_swa_prime<bf16, bf16>(cur, SEQ, lds, S, tid);
        for (;;) {
            const bool more_pass = pass == 0, more_item = L + stride < total, last = !more_pass && !more_item;
            int passn = pass + 1, Ln = L, slotn = slot;
            if (!more_pass) { passn = 0; Ln = more_item ? L + stride : L; slotn = more_item ? slot + 1 : slot; }
            const Ref nxt = last ? cur : mkref(Ln, passn, slotn);
            causal_swa_block<bf16, bf16>(cur, nxt, SEQ, SEQ, lds, S, tid);
            if (last) break;
            cur = nxt; pass = passn; L = Ln; slot = slotn;
        }
    }
}

__device__ __forceinline__ void phase_gla_prep(const bf16_t* PROJ, const float* A1, const float* wa2, const float* ba, bf16_t* QD, bf16_t* QDF, bf16_t* KI, bf16_t* KDT, bf16_t* VT, float* ELAST,
                                               unsigned char* lds, int tid) {
    MK_GRID_VARS;
    float* a1l = (float*)lds;
    for (int u = BID; u < 512; u += NBLK) {
        const int b = u >> 7, n = (u >> 1) & 63, p = u & 1; const size_t row0 = (size_t)b * SEQ + n * 64;
        __syncthreads();
        for (int i = tid; i < 1024; i += 512) a1l[i] = A1[row0 * 16 + i];
        __syncthreads();
        { const int hh = 2 * p + (tid >> 8), d = tid & 255, col = hh * 256 + d, bh = b * 4 + hh;
          float w2[16];
#pragma unroll
          for (int r = 0; r < 16; ++r) w2[r] = wa2[r * 1024 + col];
          const float bav = ba[col];
          const bf16_t* qp = PROJ + row0 * 6144 + col; const bf16_t* kp = qp + 1024;
          bf16_t* qdp = QD + row0 * 1024 + col; bf16_t* kip = KI + row0 * 1024 + col;
          bf16_t* qfp; { const int dkl = d & 31, x = dkl & 15; qfp = QDF + ((((((size_t)bh * 64 + n) * 8 + (d >> 5)) * 2) * 2 + (dkl >> 4)) * 64 + ((x >> 2) & 1) * 32) * 8 + 4 * (x >> 3) + (x & 3); }
          float kif[64]; float cb = 0.f;
#pragma unroll
          for (int jj = 0; jj < 64; ++jj) {
              const f32x4* ar = (const f32x4*)(a1l + jj * 16); float ga = bav;
#pragma unroll
              for (int q = 0; q < 4; ++q) { const f32x4 av = ar[q]; ga += av[0] * w2[4 * q] + av[1] * w2[4 * q + 1] + av[2] * w2[4 * q + 2] + av[3] * w2[4 * q + 3]; }
              cb += log_sigmoid(ga) * 0.0625f;
              const float qv = bf2f(qp[(size_t)jj * 6144]) * 0.0625f, kv = bf2f(kp[(size_t)jj * 6144]);
              const float e = __expf(cb), ei = __expf(-cb), kin = kv * ei;
              const unsigned short qb = f2bf(qv * e); qdp[(size_t)jj * 1024] = qb; qfp[((jj >> 5) * 128 + (jj & 31)) * 8] = qb; kip[(size_t)jj * 1024] = f2bf(kin); kif[jj] = kin;
          }
          const float el = __expf(cb);
          ELAST[((size_t)bh * 64 + n) * 256 + d] = el;
          u32x4* kd = (u32x4*)KDT + ((((size_t)bh * 64 + n) * 8 + (d >> 5)) * 4) * 64 + (d & 31);
#pragma unroll
          for (int g = 0; g < 8; ++g) { u32x4 w; w.x = pk2(kif[8 * g] * el, kif[8 * g + 1] * el); w.y = pk2(kif[8 * g + 2] * el, kif[8 * g + 3] * el);
              w.z = pk2(kif[8 * g + 4] * el, kif[8 * g + 5] * el); w.w = pk2(kif[8 * g + 6] * el, kif[8 * g + 7] * el); kd[(g >> 1) * 64 + (g & 1) * 32] = w; } }
        { const int c2 = 2 * tid, hh = 2 * p + (c2 >> 9), dv = c2 & 511, bh = b * 4 + hh;
          const unsigned* vp = (const unsigned*)(PROJ + row0 * 6144 + 2048 + hh * 512 + dv);
          unsigned vv[64];
#pragma unroll
          for (int jj = 0; jj < 64; ++jj) vv[jj] = vp[(size_t)jj * 3072];
          u32x4* vt0 = (u32x4*)VT + ((((size_t)bh * 64 + n) * 16 + (dv >> 5)) * 4) * 64 + (dv & 31); u32x4* vt1 = vt0 + 1;
#pragma unroll
          for (int g = 0; g < 8; ++g) { u32x4 lo, hi;
              lo.x = (vv[8 * g] & 0xffffu) | (vv[8 * g + 1] << 16); lo.y = (vv[8 * g + 2] & 0xffffu) | (vv[8 * g + 3] << 16); lo.z = (vv[8 * g + 4] & 0xffffu) | (vv[8 * g + 5] << 16); lo.w = (vv[8 * g + 6] & 0xffffu) | (vv[8 * g + 7] << 16);
              hi.x = (vv[8 * g] >> 16) | (vv[8 * g + 1] & 0xffff0000u); hi.y = (vv[8 * g + 2] >> 16) | (vv[8 * g + 3] & 0xffff0000u); hi.z = (vv[8 * g + 4] >> 16) | (vv[8 * g + 5] & 0xffff0000u); hi.w = (vv[8 * g + 6] >> 16) | (vv[8 * g + 7] & 0xffff0000u);
              vt0[(g >> 1) * 64 + (g & 1) * 32] = lo; vt1[(g >> 1) * 64 + (g & 1) * 32] = hi; } }
    }
}
struct ScanOps { bf16x8 qa[2][2], ka[4], vb[4]; f32x4 ev[4]; };
__device__ __forceinline__ void scan_load(ScanOps& o, const char* qd_u, const char* kdt_u, const char* vt_u, const char* el_u, unsigned qoff, unsigned koff, unsigned eoff) {
#pragma unroll
    for (int mb = 0; mb < 2; ++mb)
#pragma unroll
        for (int ks = 0; ks < 2; ++ks) o.qa[mb][ks] = *(const bf16x8*)(qd_u + (mb * 2 + ks) * 1024 + qoff);
#pragma unroll
    for (int ks = 0; ks < 4; ++ks) { o.ka[ks] = *(const bf16x8*)(kdt_u + ks * 1024 + koff); o.vb[ks] = *(const bf16x8*)(vt_u + ks * 1024 + koff); }
#pragma unroll
    for (int g = 0; g < 4; ++g) o.ev[g] = *(const f32x4*)(el_u + g * 32 + eoff);
}
__device__ __forceinline__ void phase_gla_scan(const bf16_t* QDF, const bf16_t* KDT, const bf16_t* VT, const float* ELAST, bf16_t* OINT, unsigned char* lds, int tid, int wid, int lane) {
    MK_GRID_VARS;
    const int l32 = lane & 31, hi = lane >> 5;
    float* buf = (float*)lds;
    for (int u = BID; u < 256; u += NBLK) {
        const int xcd = u & 7, kk = u >> 3, bh = xcd * 2 + (kk >> 4), s = kk & 15, b = bh >> 2, hh = bh & 3;
        f32x16 S;
#pragma unroll
        for (int r = 0; r < 16; ++r) S[r] = 0.f;
        const char* qd_u0 = (const char*)((const u32x4*)QDF + ((((size_t)bh * 64 * 8 + wid) * 2) * 2) * 64);
        const char* kdt_u0 = (const char*)((const u32x4*)KDT + (((size_t)bh * 64 * 8 + wid) * 4) * 64);
        const char* vt_u0 = (const char*)((const u32x4*)VT + (((size_t)bh * 64 * 16 + s) * 4) * 64);
        const char* el_u0 = (const char*)(ELAST + (size_t)bh * 64 * 256 + 32 * wid);
        const unsigned koff = (unsigned)lane * 16u, qoff = koff, eoff = (unsigned)(4 * hi) * 4u;
#define SCAN_LOAD(c, n_) scan_load((c), qd_u0 + (size_t)(n_) * 8 * 4096, kdt_u0 + (size_t)(n_) * 256 * 64 * 2, vt_u0 + (size_t)(n_) * 512 * 64 * 2, el_u0 + (size_t)(n_) * 256 * 4, qoff, koff, eoff)
#define SCAN_STEP(c, n_) do { bf16x8 sb[2];                                                                                                                   \
            _Pragma("unroll") for (int ks = 0; ks < 2; ++ks) { u32x4 w; w.x = pk2(S[8 * ks], S[8 * ks + 1]); w.y = pk2(S[8 * ks + 2], S[8 * ks + 3]); w.z = pk2(S[8 * ks + 4], S[8 * ks + 5]); w.w = pk2(S[8 * ks + 6], S[8 * ks + 7]); \
                sb[ks] = *reinterpret_cast<bf16x8*>(&w); }                                                                                                     \
            f32x16 op[2];                                                                                                                                      \
            _Pragma("unroll") for (int mb = 0; mb < 2; ++mb) {                                                                                                 \
                _Pragma("unroll") for (int r = 0; r < 16; ++r) op[mb][r] = 0.f;                                                                                \
                _Pragma("unroll") for (int ks = 0; ks < 2; ++ks) op[mb] = __builtin_amdgcn_mfma_f32_32x32x16_bf16((c).qa[mb][ks], sb[ks], op[mb], 0, 0, 0); }  \
            _Pragma("unroll") for (int r = 0; r < 16; ++r) S[r] *= (c).ev[r >> 2][r & 3];                                                                      \
            _Pragma("unroll") for (int ks = 0; ks < 4; ++ks) S = __builtin_amdgcn_mfma_f32_32x32x16_bf16((c).ka[ks], (c).vb[ks], S, 0, 0, 0);                   \
            asm volatile("" : "+v"(S), "+v"(op[0]), "+v"(op[1]));     \
            __builtin_amdgcn_sched_barrier(0); SCAN_LOAD((c), (n_) + 2 < 64 ? (n_) + 2 : 63); __builtin_amdgcn_sched_barrier(0);                                                                 \
            float* pb = buf + ((size_t)((n_) & 1) * 8 + wid) * 2048 + (4 * hi) * 32 + l32;     \
            float* pbe = pb + hi * 32; float* pbo = pb - hi * 32;                                                                                              \
            _Pragma("unroll") for (int mb = 0; mb < 2; ++mb)                                                                                                   \
                _Pragma("unroll") for (int r = 0; r < 16; ++r) ((r & 1) ? pbo : pbe)[(32 * mb + (r & 3) + 8 * (r >> 2)) * 32] = op[mb][r];                     \
            asm volatile("s_waitcnt lgkmcnt(0)" ::: "memory"); __builtin_amdgcn_s_barrier(); asm volatile("" ::: "memory");     \
            { const int tok = tid >> 3, dv = (tid & 7) * 4;                                                                                                    \
              const float* rb = buf + (size_t)((n_) & 1) * 8 * 2048 + (tok ^ ((tok >> 2) & 1)) * 32 + dv; f32x4 acc = *(const f32x4*)rb;                       \
              _Pragma("unroll") for (int w = 1; w < 8; ++w) acc += *(const f32x4*)(rb + w * 2048);                                                             \
              u32x2 ow; ow.x = pk2(acc[0], acc[1]); ow.y = pk2(acc[2], acc[3]);                                                                                      \
              *(u32x2*)(OINT + ((size_t)b * SEQ + (n_) * 64 + tok) * DM + hh * 512 + 32 * s + dv) = ow; } } while (0)
        ScanOps oa, ob; SCAN_LOAD(oa, 0); SCAN_LOAD(ob, 1);
        for (int n = 0; n < 64; n += 2) { SCAN_STEP(oa, n); SCAN_STEP(ob, n + 1); }
#undef SCAN_STEP
#undef SCAN_LOAD
        __syncthreads();
    }
}
#define MK_LASU __attribute__((address_space(3))) unsigned
__device__ __forceinline__ void phase_gla_intra(const bf16_t* PROJ, const bf16_t* QD, const bf16_t* KI, const bf16_t* VT, const bf16_t* OINT, const float* normg, bf16_t* OG,
                                                unsigned char* lds, int tid, int wid, int lane) {
    MK_GRID_VARS;
    bf16_t* attl = (bf16_t*)lds;
    float* rss = (float*)(lds + 64 * 72 * 2);
    float* rstdl = rss + 8 * 64;
    constexpr int RG_OFF = 16384;
    const int l16 = lane & 15, q4 = lane >> 4, l32 = lane & 31, hi = lane >> 5;
    for (int u = BID; u < 1024; u += NBLK) {
        const int b = u >> 8, n = (u >> 2) & 63, hh = u & 3, bh = b * 4 + hh; const size_t row0 = (size_t)b * SEQ + n * 64;
        { const char* src = (const char*)(PROJ + (row0 + wid) * 6144 + 4096 + hh * 512 + lane * 8);
#pragma unroll
          for (int i = 0; i < 8; ++i) __builtin_amdgcn_global_load_lds((const unsigned*)(src + (size_t)i * 8 * 6144 * 2), (MK_LASU*)(lds + RG_OFF + (i * 512 + wid * 64) * 16), 16, 0, 0); }
        f32x16 acc[2][2];
        { const bf16_t* oil = OINT + (row0 + 4 * hi) * DM + hh * 512 + 64 * wid + l32;
#pragma unroll
          for (int mb = 0; mb < 2; ++mb)
#pragma unroll
              for (int nb = 0; nb < 2; ++nb)
#pragma unroll
                  for (int r = 0; r < 16; ++r) acc[mb][nb][r] = bf2f(oil[(size_t)(32 * mb + (r & 3) + 8 * (r >> 2)) * DM + 32 * nb]); }
        bf16x8 vb0[4], vb1[4];
        { const bf16x8* vtp = (const bf16x8*)VT + ((((size_t)bh * 64 + n) * 16 + 2 * wid) * 4) * 64 + lane;
#pragma unroll
          for (int ks = 0; ks < 4; ++ks) { vb0[ks] = vtp[ks * 64]; vb1[ks] = vtp[(4 + ks) * 64]; } }
        const int ti = wid >> 1;
#pragma unroll
        for (int t2 = 0; t2 < 2; ++t2) { const int tj = 2 * (wid & 1) + t2;
            f32x4 c = {0.f, 0.f, 0.f, 0.f};
            if (tj <= ti) {
                const bf16_t* ap = QD + (row0 + 16 * ti + l16) * 1024 + hh * 256 + 8 * q4;
                const bf16_t* bp = KI + (row0 + 16 * tj + l16) * 1024 + hh * 256 + 8 * q4;
#pragma unroll
                for (int st = 0; st < 8; ++st) c = __builtin_amdgcn_mfma_f32_16x16x32_bf16(*(const bf16x8*)(ap + 32 * st), *(const bf16x8*)(bp + 32 * st), c, 0, 0, 0);
            }
#pragma unroll
            for (int r = 0; r < 4; ++r) { const int i = 16 * ti + 4 * q4 + r, jx = 16 * tj + l16; attl[i * 72 + jx] = f2bf(jx <= i ? c[r] : 0.f); } }
        __syncthreads();
#pragma unroll
        for (int ks = 0; ks < 4; ++ks) {
            const bf16x8 a0 = *(const bf16x8*)(attl + l32 * 72 + 16 * ks + 8 * hi), a1 = *(const bf16x8*)(attl + (32 + l32) * 72 + 16 * ks + 8 * hi);
            const bf16x8 b0 = vb0[ks], b1 = vb1[ks];
            acc[0][0] = __builtin_amdgcn_mfma_f32_32x32x16_bf16(a0, b0, acc[0][0], 0, 0, 0); acc[0][1] = __builtin_amdgcn_mfma_f32_32x32x16_bf16(a0, b1, acc[0][1], 0, 0, 0);
            acc[1][0] = __builtin_amdgcn_mfma_f32_32x32x16_bf16(a1, b0, acc[1][0], 0, 0, 0); acc[1][1] = __builtin_amdgcn_mfma_f32_32x32x16_bf16(a1, b1, acc[1][1], 0, 0, 0); }
        float* rssl = rss + wid * 64 + 4 * hi;
#pragma unroll
        for (int mb = 0; mb < 2; ++mb)
#pragma unroll
            for (int r = 0; r < 16; ++r) { const float x0 = acc[mb][0][r], x1 = acc[mb][1][r]; float ss = x0 * x0 + x1 * x1;
                ss += __builtin_bit_cast(float, __builtin_amdgcn_update_dpp(0, __builtin_bit_cast(int, ss), 0x128, 0xf, 0xf, false));
                ss += __builtin_bit_cast(float, __builtin_amdgcn_update_dpp(0, __builtin_bit_cast(int, ss), 0x124, 0xf, 0xf, false));
                ss += __builtin_bit_cast(float, __builtin_amdgcn_update_dpp(0, __builtin_bit_cast(int, ss), 0x122, 0xf, 0xf, false));
                ss += __builtin_bit_cast(float, __builtin_amdgcn_update_dpp(0, __builtin_bit_cast(int, ss), 0x121, 0xf, 0xf, false));
                ss = mk_sum_xor16(ss);
                if (l32 == 0) rssl[32 * mb + (r & 3) + 8 * (r >> 2)] = ss; }
        asm volatile("s_waitcnt vmcnt(0)" ::: "memory");
        __syncthreads();
        if (tid < 64) { float tot = 0.f;
#pragma unroll
            for (int w = 0; w < 8; ++w) tot += rss[w * 64 + tid];
            rstdl[tid] = 1.f / sqrtf(tot * (1.f / 512.f) + RMS_EPS); }
        __syncthreads();
        const float g0 = normg[64 * wid + l32], g1 = normg[64 * wid + 32 + l32];
        const bf16_t* rgl = (const bf16_t*)(lds + RG_OFF) + (4 * hi) * 512 + 64 * wid + l32;
        const float* rsr = rstdl + 4 * hi;
        bf16_t* ogl = OG + (row0 + 4 * hi) * DM + hh * 512 + 64 * wid + l32;
#pragma unroll
        for (int mb = 0; mb < 2; ++mb)
#pragma unroll
            for (int r = 0; r < 16; ++r) { const int rc = 32 * mb + (r & 3) + 8 * (r >> 2);
                const float rstd = rsr[rc];
                const float r0 = bf2f(rgl[rc * 512]), r1 = bf2f(rgl[rc * 512 + 32]);
                ogl[(size_t)rc * DM] = f2bf(acc[mb][0][r] * rstd * g0 * silu_f(r0)); ogl[(size_t)rc * DM + 32] = f2bf(acc[mb][1][r] * rstd * g1 * silu_f(r1)); }
        __syncthreads();
    }
}

__device__ __forceinline__ void phase_conv_core(const bf16_t* PROJ, const float* cw  , bf16_t* OG, int tid) {
    MK_GRID_VARS;
    for (int u = BID; u < MTOK / 64; u += NBLK) {
        const int cg = tid & 255, c0 = 8 * cg, row_start = u * 64 + 32 * (tid >> 8);
        float w[3][8];
#pragma unroll
        for (int k = 0; k < 3; ++k) { const f32x4 a = *(const f32x4*)(cw + k * DM + c0), b = *(const f32x4*)(cw + k * DM + c0 + 4);
#pragma unroll
            for (int e = 0; e < 4; ++e) { w[k][e] = a[e]; w[k][4 + e] = b[e]; } }
        float p2[8], p1[8];
#pragma unroll
        for (int e = 0; e < 8; ++e) { p2[e] = 0.f; p1[e] = 0.f; }
        if ((row_start & (SEQ - 1)) != 0) {
            float c[8], uu[8];
            cvt8(*(const u32x4*)(PROJ + (size_t)(row_start - 2) * 6144 + 2048 + c0), c); cvt8(*(const u32x4*)(PROJ + (size_t)(row_start - 2) * 6144 + 4096 + c0), uu);
#pragma unroll
            for (int e = 0; e < 8; ++e) p2[e] = c[e] * uu[e];
            cvt8(*(const u32x4*)(PROJ + (size_t)(row_start - 1) * 6144 + 2048 + c0), c); cvt8(*(const u32x4*)(PROJ + (size_t)(row_start - 1) * 6144 + 4096 + c0), uu);
#pragma unroll
            for (int e = 0; e < 8; ++e) p1[e] = c[e] * uu[e];
        }
#pragma unroll 4
        for (int r = 0; r < 32; ++r) { const size_t row = (size_t)(row_start + r);
            float gb[8], c[8], uu[8], y[8];
            cvt8(*(const u32x4*)(PROJ + row * 6144 + c0), gb); cvt8(*(const u32x4*)(PROJ + row * 6144 + 2048 + c0), c); cvt8(*(const u32x4*)(PROJ + row * 6144 + 4096 + c0), uu);
#pragma unroll
            for (int e = 0; e < 8; ++e) { const float cu = c[e] * uu[e]; y[e] = gb[e] * (w[0][e] * p2[e] + w[1][e] * p1[e] + w[2][e] * cu); p2[e] = p1[e]; p1[e] = cu; }
            *(u32x4*)(OG + row * DM + c0) = pack8f(y); }
    }
}
__device__ __forceinline__ void phase_ffn_fix(const float* ZH, const float* cw  , const float* cb  , bf16_t* ACT, int tid) {
    MK_GRID_VARS;
    constexpr int NCG = DFF / 8, NIT = (MTOK / 64) * 2 * NCG;
    for (int it = BID * 512 + tid; it < NIT; it += NBLK * 512) {
        const int cg = it % NCG, r = (it / NCG) & 1, blk = it / (2 * NCG), c0 = 8 * cg;
        const bool first = (blk & 63) == 0;
        const float* zb = ZH + (size_t)blk * 4 * 2 * 5632 + c0;
        float y[8];
#pragma unroll
        for (int hq = 0; hq < 2; ++hq) {
            f32x4 za[3], zu[3];
#pragma unroll
            for (int k = 0; k < 3; ++k) { const int s = r + k;
                const bool zero = first && s < 2;
                za[k] = zero ? (f32x4){0.f, 0.f, 0.f, 0.f} : *(const f32x4*)(zb + (size_t)(s * 2) * 5632 + 4 * hq);
                zu[k] = zero ? (f32x4){0.f, 0.f, 0.f, 0.f} : *(const f32x4*)(zb + (size_t)(s * 2 + 1) * 5632 + 4 * hq); }
            f32x4 ya = *(const f32x4*)(cb + c0 + 4 * hq), yu = *(const f32x4*)(cb + DFF + c0 + 4 * hq);
#pragma unroll
            for (int k = 0; k < 3; ++k) { ya += *(const f32x4*)(cw + k * 11264 + c0 + 4 * hq) * za[k]; yu += *(const f32x4*)(cw + k * 11264 + DFF + c0 + 4 * hq) * zu[k]; }
#pragma unroll
            for (int e = 0; e < 4; ++e) y[4 * hq + e] = silu_f(ya[e]) * yu[e]; }
        *(u32x4*)(ACT + (size_t)(blk * 64 + r) * DFF + c0) = pack8f(y);
    }
}

constexpr int PH_FINAL = 65, PH_END = 66;
#ifndef MK_FUSE
#define MK_FUSE 1
#endif
#ifndef MK_DUP
#define MK_DUP 0
#endif
constexpr size_t WS_XD = WS_END, WS_HD = WS_END + 64 * MiB, WS_SKD = WS_END + 128 * MiB, WS_STD = WS_END + 130 * MiB;
__global__ void __launch_bounds__(512, 2) mk_fwd(Args args_) {
    extern __shared__ __attribute__((aligned(16))) unsigned char lds[];
    const int tid0 = threadIdx.x, wid0 = __builtin_amdgcn_readfirstlane(tid0 >> 6);
    const __attribute__((address_space(4))) Args* argp = (const __attribute__((address_space(4))) Args*)__builtin_amdgcn_kernarg_segment_ptr();
    asm volatile("" : "+s"(argp));
#define args (*argp)
    unsigned char* ws = args.ws;
    const int lo = args.ph_lo, hi = args.ph_hi, dummy = args.flags;
    volatile LAS unsigned* MISC = (volatile LAS unsigned*)((LAS unsigned char*)lds + MISC_OFF);
    if (tid0 < 16) MISC[tid0] = 0u;
    __syncthreads();
    XcdBarrier bar; bar.bar = (unsigned*)(ws + WS_CTL) + CW_BAR; bar.x = 0; bar.st = nullptr;
    if (hi - lo > 1) bar = xcd_barrier_post((unsigned*)(ws + WS_CTL) + CW_BAR, MISC, tid0);
#define IN(k) (lo <= (k) && (k) < hi)
#define MK_FUSED_LN(s) (MK_FUSE && gridDim.x == 256 && ((s) == 2 || (s) == 3 || (s) == 4 || (s) == 6))
#define SEAM(k) do { if ((k) + 1 < hi) { XcdBarrier b_ = bar; asm volatile("" : "+s"(b_.bar), "+s"(b_.x)); xcd_barrier(b_, wid0 * 64 + mk_lane()); } } while (0)
#define LOCALS() unsigned char* w = ws; asm volatile("" : "+s"(w)); int wid_ = wid0; asm volatile("" : "+s"(wid_)); int lane_; asm volatile("v_mbcnt_lo_u32_b32 %0, -1, 0\n\tv_mbcnt_hi_u32_b32 %0, -1, %0" : "=&v"(lane_)); const int wid = wid_, lane = lane_, tid = wid * 64 + lane; (void)lane; (void)wid; (void)tid; int BID = blockIdx.x, NBLK = gridDim.x; asm volatile("" : "+s"(BID), "+s"(NBLK)); bf16_t* XB = (bf16_t*)(w + WS_XB); float* MOD = (float*)(w + WS_MOD); float* SK16 = (float*)(w + WS_SK16); float* FB = (float*)(w + WS_FB); float* ELAST = (float*)(w + WS_ELAST); \
    bf16_t* H = (bf16_t*)(w + WS_H); bf16_t* PROJ = (bf16_t*)(w + WS_PROJ); bf16_t* ACT = (bf16_t*)(w + WS_ACT); \
    bf16_t* QD = (bf16_t*)(w + WS_QD); bf16_t* KI = (bf16_t*)(w + WS_KI); bf16_t* KDT = (bf16_t*)(w + WS_KDT); bf16_t* VT = (bf16_t*)(w + WS_VT); bf16_t* OINT = (bf16_t*)(w + WS_OINT); bf16_t* QDF = (bf16_t*)(w + WS_QDF); (void)QDF; \
    (void)XB; (void)MOD; (void)SK16; (void)FB; (void)ELAST; (void)H; (void)PROJ; (void)ACT; (void)QD; (void)KI; (void)KDT; (void)VT; (void)OINT

    if (IN(0)) { LOCALS(); phase_prologue(argp, lds, tid, wid, lane); SEAM(0); }

    if (IN(1)) {
        LOCALS(); const float* modl = MOD;
        const int rep = dummy;
        phase_lnmod<false, true>(args.in[0], nullptr, rep ? (bf16_t*)(w + WS_HD) : H, false, true, args.in[6], args.in[7], modl + 2048, modl, 1, args.in[12], args.in[13], rep ? (float*)(w + WS_SKD) : SK16, (float*)(w + (rep ? WS_STD : WS_ST)), lds, tid, wid, lane);
        SEAM(1);
    }

    for (int sub = 0; sub < 8; ++sub) {
        const int layer = sub >> 1, is_ffn = sub & 1, kind = is_ffn ? 3 : layer % 3, j = layer / 3, base = 1 + 8 * sub;
        if (sub != 0 && IN(base + 0) && !MK_FUSED_LN(sub - 1)) {
            LOCALS(); const float* modl = MOD + (size_t)layer * 4 * 12288;
            const float* lng = is_ffn ? args.in[4] + layer * DM : args.in[6] + (layer - 1) * DM;
            const float* lnb = is_ffn ? args.in[5] + layer * DM : args.in[7] + (layer - 1) * DM;
            const float* sc = modl + (is_ffn ? 8192 : 2048); const float* sh = modl + (is_ffn ? 6144 : 0);
            const int sk = kind == 0 ? 1 : (kind == 1 ? 2 : 0);
            const float* skW = kind == 0 ? args.in[12] + (size_t)j * DM * 16 : args.in[18]; const float* skB = args.in[13] + j * 16;
            const int rep = dummy;
            if (sk) phase_lnmod<true, true>(XB, nullptr, rep ? (bf16_t*)(w + WS_HD) : H, true, true, lng, lnb, sc, sh, sk, skW, skB, rep ? (float*)(w + WS_SKD) : SK16, (float*)(w + (rep ? WS_STD : WS_ST)), lds, tid, wid, lane, (sub & 1) * 4096);
            else phase_lnmod<true, false>(XB, nullptr, rep ? (bf16_t*)(w + WS_HD) : H, true, true, lng, lnb, sc, sh, 0, skW, skB, rep ? (float*)(w + WS_SKD) : SK16, (float*)(w + (rep ? WS_STD : WS_ST)), lds, tid, wid, lane, (sub & 1) * 4096);
            SEAM(base + 0);
        }
        if (IN(base + 1)) {
            LOCALS();
            const bf16_t* Bt; int N;
            if (kind == 0) { Bt = (const bf16_t*)(w + WS_WFOX + (size_t)j * 40 * MiB); N = 8192; fox_cumsum(SK16, FB, wid, lane); }
            else if (kind == 1) { Bt = (const bf16_t*)(w + WS_WGLA); N = 6144; }
            else if (kind == 2) { Bt = (const bf16_t*)(w + WS_WCONV); N = 6144; }
            else { Bt = (const bf16_t*)(w + WS_WUP) + (size_t)layer * 11264 * DM; N = 11264; }
            pg8::Gemm g{H, Bt, MTOK, N, DM}; pg8::StaticOrder S; S.init(MTOK, N, NBLK, BID);
            if (kind == 3) { pg8::EpiFfn E{ACT, (float*)PROJ, args.in[28] + (size_t)layer * 3 * 11264, args.in[29] + (size_t)layer * 11264};
                pg8::gemm_phase<pg8::EpiFfn, pg8::StaticOrder, true, true>((LAS unsigned char*)lds, g, S, E, tid); }
            else { pg8::EpiStore E{PROJ, N, kind == 0 ? 1 : 0, (float*)(w + WS_N2P)};
                pg8::gemm_phase<pg8::EpiStore, pg8::StaticOrder, true, true>((LAS unsigned char*)lds, g, S, E, tid); }
            SEAM(base + 1);
        }
        if (kind == 0) {
            if (IN(base + 2)) { LOCALS(); phase_fox_attn(PROJ, FB, (const float*)(w + WS_N2P), ACT, (char*)lds, tid); SEAM(base + 2); }
        } else if (kind == 1) {
            if (IN(base + 2)) { LOCALS(); phase_gla_prep(PROJ, SK16, args.in[19], args.in[20], QD, QDF, KI, KDT, VT, ELAST, lds, tid); SEAM(base + 2); }
            if (IN(base + 3)) { LOCALS(); phase_gla_scan(QDF, KDT, VT, ELAST, OINT, lds, tid, wid, lane); SEAM(base + 3); }
            if (IN(base + 4)) { LOCALS(); phase_gla_intra(PROJ, QD, KI, VT, OINT, args.in[22], ACT, lds, tid, wid, lane); SEAM(base + 4); }
        } else if (kind == 2) {
            if (IN(base + 2)) { LOCALS(); phase_conv_core(PROJ, args.in[25], ACT, tid); SEAM(base + 2); }
        } else {
            if (IN(base + 2)) { LOCALS(); phase_ffn_fix((const float*)PROJ, args.in[28] + (size_t)layer * 3 * 11264, args.in[29] + (size_t)layer * 11264, ACT, tid); SEAM(base + 2); }
        }
        if (IN(base + 5)) {
            LOCALS(); const float* modl = MOD + (size_t)layer * 4 * 12288;
            const bf16_t* Bt; int K;
            if (kind == 0) { Bt = (const bf16_t*)(w + WS_WFOX + (size_t)j * 40 * MiB) + (size_t)8192 * DM; K = DM; }
            else if (kind == 1) { Bt = (const bf16_t*)(w + WS_WGLA) + (size_t)6144 * DM; K = DM; }
            else if (kind == 2) { Bt = (const bf16_t*)(w + WS_WCONV) + (size_t)6144 * DM; K = DM; }
            else { Bt = (const bf16_t*)(w + WS_WDOWN) + (size_t)layer * DM * DFF; K = DFF; }
            const bool fuse = MK_FUSED_LN(sub);
            pg8::Gemm g{ACT, Bt, MTOK, DM, K}; pg8::StaticOrder S; S.init(MTOK, DM, NBLK, BID, fuse ? 1 : 0);
            if (fuse) {
                const int sn = sub + 1, ln_ = sn >> 1, fn_ = sn & 1;
                const float* lngn = fn_ ? args.in[4] + ln_ * DM : args.in[6] + (ln_ - 1) * DM; const float* lnbn = fn_ ? args.in[5] + ln_ * DM : args.in[7] + (ln_ - 1) * DM;
                if (BID == 0) { float* st = (float*)(w + WS_ST); for (int i = wid * 64 + mk_lane(); i < DM; i += 512) { st[2 * MTOK + (sn & 1) * 4096 + i] = DN_ALPHA * lngn[i]; st[2 * MTOK + (sn & 1) * 4096 + DM + i] = DN_ALPHA * lnbn[i]; } }
                pg8::EpiResidLN E{w, lngn, lnbn, layer * 4 * 12288 + (is_ffn ? 10240 : 4096), ln_ * 4 * 12288 + (fn_ ? 8192 : 2048), ln_ * 4 * 12288 + (fn_ ? 6144 : 0), (sub & 1) * 4096, sub};
                pg8::gemm_phase<pg8::EpiResidLN, pg8::StaticOrder, true, true>((LAS unsigned char*)lds, g, S, E, wid * 64 + mk_lane());
            } else
            { pg8::EpiResid E{sub == 0 ? (const void*)args.in[0] : (const void*)XB, dummy ? (bf16_t*)(w + WS_XD) : XB, modl + (is_ffn ? 10240 : 4096), (sub == 0 ? 1 : 0) | (((sub & 1) * 4096) << 1), (const float*)(w + WS_ST)};
                pg8::gemm_phase<pg8::EpiResid, pg8::StaticOrder, true, true>((LAS unsigned char*)lds, g, S, E, wid * 64 + mk_lane()); }
            SEAM(base + 5);
        }
    }
    if (IN(PH_FINAL)) { LOCALS(); phase_lnmod<true, false>(XB, dummy ? (float*)(w + WS_PROJ) : args.out, H, true, false, args.in[6] + 3 * DM, args.in[7] + 3 * DM, nullptr, nullptr, 0, nullptr, nullptr, nullptr, nullptr, lds, tid, wid, lane); }
#undef LOCALS
#undef IN
#undef SEAM
#undef args
}

extern "C" void kernel_launch(void* const* d_in, const int* in_sizes, int n_in, void* d_out, int out_size, void* d_ws, size_t ws_size, hipStream_t stream) {
    static int grid = 0;
    if (grid == 0) {
        if (n_in != 31 || in_sizes[0] != MTOK * DM || out_size != MTOK * DM || ws_size < WS_END + (MK_DUP ? 136 * MiB : 0)) {
            fprintf(stderr, "kernel_launch: built for 31 inputs, x/out of %d floats, >= %zu bytes of workspace; got n_in %d, in0 %d, out %d, ws %zu; nothing launched\n", MTOK * DM, (size_t)WS_END, n_in, n_in > 0 ? in_sizes[0] : -1, out_size, ws_size);
            grid = -1; return; }
        int dev = 0, cus = 0, per_cu = 0;
        if (hipGetDevice(&dev) != hipSuccess || hipDeviceGetAttribute(&cus, hipDeviceAttributeMultiprocessorCount, dev) != hipSuccess) { fprintf(stderr, "kernel_launch: device query failed\n"); grid = -1; return; }
        if (hipFuncSetAttribute((const void*)mk_fwd, hipFuncAttributeMaxDynamicSharedMemorySize, LDS_TOTAL) != hipSuccess) { fprintf(stderr, "kernel_launch: hipFuncSetAttribute(%d B LDS) failed\n", LDS_TOTAL); grid = -1; return; }
        if (hipOccupancyMaxActiveBlocksPerMultiprocessor(&per_cu, (const void*)mk_fwd, 512, LDS_TOTAL) != hipSuccess || per_cu < 1)
            fprintf(stderr, "kernel_launch: note: occupancy query reports %d workgroups per CU\n", per_cu);
        (void)hipGetLastError();
        grid = cus;
    }
    if (grid < 0) return;
    if (hipMemsetAsync((char*)d_ws + WS_CTL, 0, CTL_ZERO_BYTES, stream) != hipSuccess) { fprintf(stderr, "kernel_launch: memset failed\n"); return; }
    if (hipMemsetAsync((char*)d_ws + WS_PART, 0, PART_BYTES, stream) != hipSuccess) { fprintf(stderr, "kernel_launch: memset failed\n"); return; }
    Args a{};
    for (int i = 0; i < 31; ++i) a.in[i] = (const float*)d_in[i];
    a.out = (float*)d_out; a.ws = (unsigned char*)d_ws;
#if MK_PER_PHASE
    for (int ph = 0; ph < PH_END; ++ph) {
        int group = 64;
        if (ph > 0 && ph < PH_FINAL) { const int sub = (ph - 1) >> 3, loc = (ph - 1) & 7, kind = (sub & 1) ? 3 : (sub >> 1) % 3;
            const bool exists = loc <= 2 || loc == 5 || (kind == 1 && loc <= 4); if (!exists) continue;
            group = loc == 0 ? 4 : loc == 1 ? (1 | (kind == 3 ? 512 : 1024)) : loc == 5 ? (2 | (kind == 3 ? 128 : 256)) : (kind == 0 ? 8 : kind == 1 ? (16 | (loc == 2 ? 2048 : loc == 3 ? 4096 : 8192)) : 32); }
        if (ph == PH_FINAL) group = 4;
        a.ph_lo = ph; a.ph_hi = ph + 1; a.flags = 0;
        hipLaunchKernelGGL(mk_fwd, dim3(grid), dim3(512), LDS_TOTAL, stream, a);
        if ((MK_DUP & group) == (MK_DUP & -MK_DUP) && (MK_DUP & group)) { a.flags = 1; hipLaunchKernelGGL(mk_fwd, dim3(grid), dim3(512), LDS_TOTAL, stream, a); }
    }
#else
    a.ph_lo = 0; a.ph_hi = PH_END;
    hipLaunchKernelGGL(mk_fwd, dim3(grid), dim3(512), LDS_TOTAL, stream, a);
#endif
    const hipError_t le = hipPeekAtLastError();
    if (le != hipSuccess) fprintf(stderr, "kernel_launch: launch failed: %s (grid %d)\n", hipGetErrorName(le), grid);
}
```

```cpp
#include <hip/hip_runtime.h>
#include <hip/hip_bf16.h>
#include <cstdio>
#include <cstdint>

#ifndef MK_PER_PHASE
#define MK_PER_PHASE 0
#endif

__device__ __forceinline__ int mk_lane() { int l; asm volatile("v_mbcnt_lo_u32_b32 %0, -1, 0\n\tv_mbcnt_hi_u32_b32 %0, -1, %0" : "=&v"(l)); return l; }
__device__ __forceinline__ float mk_shfl_xor(float v, int m) { return __builtin_bit_cast(float, __builtin_amdgcn_ds_bpermute((mk_lane() ^ m) << 2, __builtin_bit_cast(int, v))); }
__device__ __forceinline__ float mk_shfl_up(float v, int o) { return __builtin_bit_cast(float, __builtin_amdgcn_ds_bpermute(((mk_lane() - o) & 63) << 2, __builtin_bit_cast(int, v))); }
__device__ __forceinline__ float mk_sum_xor16(float v) { auto rr = __builtin_amdgcn_permlane16_swap(__float_as_uint(v), __float_as_uint(v), false, false); return __uint_as_float(rr[0]) + __uint_as_float(rr[1]); }
__device__ __forceinline__ float mk_sum_xor32(float v) { auto rr = __builtin_amdgcn_permlane32_swap(__float_as_uint(v), __float_as_uint(v), false, false); return __uint_as_float(rr[0]) + __uint_as_float(rr[1]); }
__device__ __forceinline__ float mk_xor1(float v) { return __builtin_bit_cast(float, __builtin_amdgcn_update_dpp(0, __builtin_bit_cast(int, v), 0xB1  , 0xf, 0xf, false)); }

namespace pg8 {
#define PG8_LAS __attribute__((address_space(3)))
typedef unsigned short bf16_t;
typedef short bf16x8 __attribute__((ext_vector_type(8)));
typedef float f32x4 __attribute__((ext_vector_type(4)));
typedef unsigned u32x4 __attribute__((ext_vector_type(4)));
constexpr int BM = 256, BK = 64, HALF = 128, HTB = HALF * BK * 2  , STAGE_BYTES = 8 * HTB, NXCD = 8, WGM = 8;

__host__ __device__ __forceinline__ int lds_byte(int r, int c) { const int st = (r >> 4) * 2 + (c >> 5), rr = r & 15, cc = c & 31, ob = rr * 64 + cc * 2; return st * 1024 + (ob ^ (((ob >> 9) & 1) << 5)); }
__host__ __device__ __forceinline__ void stage_rc(int b, int& R, int& C) { const int st = b / 1024, sb = b % 1024, swz = sb ^ (((sb >> 9) & 1) << 5); R = (st >> 1) * 16 + swz / 64; C = (st & 1) * 32 + (swz % 64) / 2; }
__host__ __device__ __forceinline__ int perm32(int rho) { const int n = rho >> 4, i = rho & 15; return 8 * (i >> 2) + 4 * n + (i & 3); }

struct Unit { int pm, pn; };
struct Gemm { const bf16_t* A; const bf16_t* Bt; int M, N, K; };

struct StaticOrder {
    int nM, nN, nwg, G, c, rg;
    __host__ __device__ void init(int M, int N, int G_, int c_, int rg_ = 0) { nM = M / BM; nN = N / BM; nwg = nM * nN; G = G_; c = c_; rg = rg_; }
    __host__ __device__ bool next(int i, Unit& u) const {
        const long L = (long)i * G + c; if (L >= nwg) return false;
        int wgid = (int)L; { const int q = nwg / NXCD, r = nwg % NXCD, xcd = wgid % NXCD, off = wgid / NXCD; wgid = (xcd < r ? xcd * (q + 1) : r * (q + 1) + (xcd - r) * q) + off; }
        const int nig = WGM * nN, gid = wgid / nig, fm = gid * WGM, gsz = (nM - fm) < WGM ? (nM - fm) : WGM;
        if (rg) { const int o = wgid % nig; u.pm = fm + 4 * (o >> 5) + (o & 3); u.pn = (o >> 2) & 7; return true; }
        u.pm = fm + ((wgid % nig) % gsz); u.pn = (wgid % nig) / gsz; return true;
    }
    __device__ __forceinline__ void a_ready(const Unit&) const {}
    __device__ __forceinline__ void done(const Unit&) const {}
};

__device__ __forceinline__ unsigned cvt_pk_bf16(float lo, float hi) { unsigned r; asm volatile("v_cvt_pk_bf16_f32 %0, %1, %2" : "=v"(r) : "v"(lo), "v"(hi)); return r; }
typedef float f32x2 __attribute__((ext_vector_type(2)));
template <class Epi, class Sched, bool ALIGN_EPI = false, bool SP2 = false>
__device__ __forceinline__ void gemm_phase(PG8_LAS unsigned char* lds, const Gemm g, const Sched& S, const Epi& E, int tid_in) {
    int tid_ = tid_in; asm volatile("" : "+v"(tid_));
    const int tid = tid_, wid = __builtin_amdgcn_readfirstlane(tid >> 6), lane = tid & 63, wr = wid >> 2, wc = wid & 3, fr = lane & 15, fq = lane >> 4;
    const int K = g.K, nt = K / BK;
    unsigned voffA[2], voffB[2];
#pragma unroll
    for (int i = 0; i < 2; ++i) { int R, C; stage_rc(tid * 16 + i * 8192, R, C); const int Rb = Epi::PERM ? ((R & ~31) + perm32(R & 31)) : R;
        voffA[i] = (unsigned)(R * K + C) * 2u; voffB[i] = (unsigned)(Rb * K + C) * 2u; }
    const size_t kstep = (size_t)(BK * 2);
    const size_t hstep = (size_t)HALF * K * 2;
    const size_t tstep = 2 * hstep;
    const unsigned ldsw = (unsigned)wid * 1024u;
    const int aoff = lds_byte(wr * 64 + fr, fq * 8), boff = lds_byte(wc * 32 + fr, fq * 8);
#define PG8_SA(b, h) (((b) * 2 + (h)) * HTB)
#define PG8_SB(b, h) ((4 + (b) * 2 + (h)) * HTB)
#define PG8_STAGE(bufoff, gbase, voff) do { _Pragma("unroll") for (int _i = 0; _i < 2; ++_i) \
        __builtin_amdgcn_global_load_lds((const unsigned*)((const char*)(gbase) + (voff)[_i]), (PG8_LAS unsigned*)(lds + (bufoff) + ldsw + _i * 8192), 16, 0, 0); } while (0)
#define PG8_LDA(dst, b, h) do { _Pragma("unroll") for (int m = 0; m < 4; ++m) _Pragma("unroll") for (int k = 0; k < 2; ++k) dst[m][k] = *(const PG8_LAS bf16x8*)(lds + PG8_SA(b, h) + aoff + m * 2048 + k * 1024); } while (0)
#define PG8_LDB(dst, b, h) do { _Pragma("unroll") for (int n = 0; n < 2; ++n) _Pragma("unroll") for (int k = 0; k < 2; ++k) dst[n][k] = *(const PG8_LAS bf16x8*)(lds + PG8_SB(b, h) + boff + n * 2048 + k * 1024); } while (0)
#define PG8_MMA(ai, bj, At, Bt) do { __builtin_amdgcn_s_setprio(1); _Pragma("unroll") for (int m = 0; m < 4; ++m) _Pragma("unroll") for (int n = 0; n < 2; ++n) _Pragma("unroll") for (int k = 0; k < 2; ++k) \
        acc[ai][bj][m][n] = __builtin_amdgcn_mfma_f32_16x16x32_bf16(Bt[n][k], At[m][k], acc[ai][bj][m][n], 0, 0, 0); __builtin_amdgcn_s_setprio(0); } while (0)
#define PG8_WAIT_V(n) asm volatile("s_waitcnt vmcnt(" #n ")" ::: "memory")
#define PG8_WAIT_L(n) asm volatile("s_waitcnt lgkmcnt(" #n ")" ::: "memory")
#define PG8_BAR __builtin_amdgcn_s_barrier()
#define PG8_SCHED __builtin_amdgcn_sched_barrier(0)
    Unit cur, nxt; int ui = 0;
    if (!S.next(0, cur)) return;
    f32x4 acc[2][2][4][2];
#pragma unroll
    for (int a = 0; a < 2; ++a)
#pragma unroll
        for (int b = 0; b < 2; ++b)
#pragma unroll
            for (int m = 0; m < 4; ++m)
#pragma unroll
                for (int n = 0; n < 2; ++n) acc[a][b][m][n] = (f32x4){0.f, 0.f, 0.f, 0.f};
    bf16x8 At[4][2], B0[2][2], B1[2][2];
    const char* cA = (const char*)g.A + (size_t)cur.pm * tstep; const char* cB = (const char*)g.Bt + (size_t)cur.pn * tstep;
    S.a_ready(cur);
    if constexpr (SP2) {
        PG8_STAGE(PG8_SB(0, 0), cB, voffB); PG8_STAGE(PG8_SB(0, 1), cB + hstep, voffB); PG8_STAGE(PG8_SA(0, 0), cA, voffA); PG8_STAGE(PG8_SA(0, 1), cA + hstep, voffA);
        if (wr == 1) PG8_BAR;
        PG8_WAIT_V(2); PG8_BAR;
        PG8_STAGE(PG8_SB(1, 0), cB + kstep, voffB); PG8_STAGE(PG8_SA(1, 0), cA + kstep, voffA); PG8_STAGE(PG8_SB(1, 1), cB + hstep + kstep, voffB);
        PG8_WAIT_V(6); PG8_BAR;
    } else {
        PG8_STAGE(PG8_SB(0, 0), cB, voffB); PG8_STAGE(PG8_SA(0, 0), cA, voffA); PG8_STAGE(PG8_SB(0, 1), cB + hstep, voffB); PG8_STAGE(PG8_SA(0, 1), cA + hstep, voffA);
        if (wr == 1) PG8_BAR;
        PG8_WAIT_V(4); PG8_BAR;
        PG8_STAGE(PG8_SB(1, 0), cB + kstep, voffB); PG8_STAGE(PG8_SA(1, 0), cA + kstep, voffA); PG8_STAGE(PG8_SB(1, 1), cB + hstep + kstep, voffB);
        PG8_WAIT_V(6); PG8_BAR;
    }
    for (;;) {
        E.unit_begin(lds, cur, ui, wid, lane);
        const bool has_next = S.next(ui + 1, nxt);
        const char* nA = has_next ? (const char*)g.A + (size_t)nxt.pm * tstep : cA; const char* nB = has_next ? (const char*)g.Bt + (size_t)nxt.pn * tstep : cB;
        for (int t = 0; t < nt; t += 2) {
            const bool last = (t == nt - 2);
            const char* a1 = cA + (size_t)(t + 1) * kstep;
            const char* a2 = last ? nA : cA + (size_t)(t + 2) * kstep; const char* b2 = last ? nB : cB + (size_t)(t + 2) * kstep;
            const char* a3 = a2 + kstep; const char* b3 = b2 + kstep;
            if (last && has_next) S.a_ready(nxt);
            if constexpr (SP2) {
            PG8_LDB(B0, 0, 0); PG8_LDB(B1, 0, 1); PG8_SCHED; PG8_LDA(At, 0, 0); PG8_STAGE(PG8_SA(1, 1), a1 + hstep, voffA);
            PG8_WAIT_V(8); PG8_WAIT_L(0); PG8_BAR; PG8_MMA(0, 0, At, B0); PG8_MMA(0, 1, At, B1); PG8_BAR; PG8_SCHED;
            PG8_LDA(At, 0, 1); PG8_STAGE(PG8_SB(0, 0), b2, voffB); PG8_STAGE(PG8_SB(0, 1), b2 + hstep, voffB); PG8_STAGE(PG8_SA(0, 0), a2, voffA);
            PG8_WAIT_V(8); PG8_WAIT_L(0); PG8_BAR; PG8_MMA(1, 0, At, B0); PG8_MMA(1, 1, At, B1); PG8_BAR; PG8_SCHED;
            PG8_LDB(B0, 1, 0); PG8_LDB(B1, 1, 1); PG8_SCHED; PG8_LDA(At, 1, 0); PG8_STAGE(PG8_SA(0, 1), a2 + hstep, voffA);
            PG8_WAIT_V(8); PG8_WAIT_L(0); PG8_BAR; PG8_MMA(0, 0, At, B0); PG8_MMA(0, 1, At, B1); PG8_BAR; PG8_SCHED;
            PG8_LDA(At, 1, 1); PG8_STAGE(PG8_SB(1, 0), b3, voffB); PG8_STAGE(PG8_SB(1, 1), b3 + hstep, voffB); PG8_STAGE(PG8_SA(1, 0), a3, voffA);
            PG8_WAIT_V(8); PG8_WAIT_L(0); PG8_BAR; PG8_MMA(1, 0, At, B0); PG8_MMA(1, 1, At, B1); PG8_BAR; PG8_SCHED;
            } else {
            PG8_LDB(B0, 0, 0); PG8_SCHED; PG8_LDA(At, 0, 0); PG8_STAGE(PG8_SA(1, 1), a1 + hstep, voffA);
            PG8_WAIT_L(8); PG8_BAR; PG8_WAIT_L(0); PG8_MMA(0, 0, At, B0); PG8_BAR; PG8_SCHED;
            PG8_LDB(B1, 0, 1); PG8_STAGE(PG8_SB(0, 0), b2, voffB);
            PG8_BAR; PG8_WAIT_L(0); PG8_MMA(0, 1, At, B1); PG8_BAR;
            PG8_LDA(At, 0, 1); PG8_STAGE(PG8_SA(0, 0), a2, voffA);
            PG8_BAR; PG8_WAIT_L(0); PG8_MMA(1, 0, At, B0); PG8_BAR; PG8_SCHED;
            PG8_STAGE(PG8_SB(0, 1), b2 + hstep, voffB);
            PG8_WAIT_V(6); PG8_BAR; PG8_MMA(1, 1, At, B1); PG8_BAR;
            PG8_LDB(B0, 1, 0); PG8_SCHED; PG8_LDA(At, 1, 0); PG8_STAGE(PG8_SA(0, 1), a2 + hstep, voffA);
            PG8_WAIT_L(8); PG8_BAR; PG8_WAIT_L(0); PG8_MMA(0, 0, At, B0); PG8_BAR; PG8_SCHED;
            PG8_LDB(B1, 1, 1); PG8_STAGE(PG8_SB(1, 0), b3, voffB);
            PG8_BAR; PG8_WAIT_L(0); PG8_MMA(0, 1, At, B1); PG8_BAR;
            PG8_LDA(At, 1, 1); PG8_STAGE(PG8_SA(1, 0), a3, voffA);
            PG8_BAR; PG8_WAIT_L(0); PG8_MMA(1, 0, At, B0); PG8_BAR; PG8_SCHED;
            PG8_STAGE(PG8_SB(1, 1), b3 + hstep, voffB);
            PG8_WAIT_V(6); PG8_BAR; PG8_MMA(1, 1, At, B1); PG8_BAR;
            }
        }
        if constexpr (ALIGN_EPI) { if (wr == 0) PG8_BAR; }
        if constexpr (!Epi::AFTER_DRAIN) { E(acc, cur, wr, wc, fr, fq, lds, ui); S.done(cur); }
        if (!has_next) break;
#pragma unroll
        for (int a = 0; a < 2; ++a)
#pragma unroll
            for (int b = 0; b < 2; ++b)
#pragma unroll
                for (int m = 0; m < 4; ++m)
#pragma unroll
                    for (int n = 0; n < 2; ++n) acc[a][b][m][n] = (f32x4){0.f, 0.f, 0.f, 0.f};
        cur = nxt; cA = nA; cB = nB; ++ui;
        if constexpr (ALIGN_EPI) { if (wr == 1) PG8_BAR; }
    }
    PG8_WAIT_V(0);
    if constexpr (!ALIGN_EPI) { if (wr == 0) PG8_BAR; }
    PG8_BAR;
    if constexpr (Epi::AFTER_DRAIN) { E.fused(acc, cur, wr, wc, fr, fq, lds, wid, lane); S.done(cur); }
#undef PG8_SA
#undef PG8_SB
#undef PG8_STAGE
#undef PG8_LDA
#undef PG8_LDB
#undef PG8_MMA
#undef PG8_WAIT_V
#undef PG8_WAIT_L
#undef PG8_BAR
#undef PG8_SCHED
}
}

namespace pg8 {
constexpr int EPI_LDS_OFF = 131072, EPI_LDS_PAR = 9216, EPI_RED_OFF = EPI_LDS_OFF + 2 * EPI_LDS_PAR  , EPI_MS_OFF = EPI_RED_OFF + 8192  ;
struct EpiStore {
    static constexpr bool PERM = true, AFTER_DRAIN = false;
    bf16_t* O; int ldc; int hm; float* n2p;
    __device__ __forceinline__ void unit_begin(PG8_LAS unsigned char*, const Unit&, int, int, int) const {}
    __device__ __forceinline__ void operator()(const f32x4 (&acc)[2][2][4][2], const Unit& u, int wr, int wc, int fr, int fq, PG8_LAS unsigned char* lds, int ui) const {
        const int row0 = u.pm * BM + wr * 64 + fr, col0 = u.pn * BM + wc * 32 + 8 * fq;
        size_t base[2]; size_t rstride;
        if (hm) { const int b = row0 >> 12, s = row0 & 4095;
#pragma unroll
            for (int bj = 0; bj < 2; ++bj) { const int c = col0 + bj * HALF, t = c >> 11, h = (c >> 7) & 15, d = c & 127; base[bj] = ((size_t)((t * 4 + b) * 16 + h) * 4096 + s) * 128 + d; }
            rstride = 128;
            if (u.pn < 16) {
#pragma unroll
                for (int bj = 0; bj < 2; ++bj) { const int c = col0 + bj * HALF, t = c >> 11, h = (c >> 7) & 15;
                    float* np = n2p + ((size_t)((t * 4 + b) * 16 + h) * 4096 + s) * 4 + wc;
#pragma unroll
                    for (int ai = 0; ai < 2; ++ai)
#pragma unroll
                        for (int m = 0; m < 4; ++m) { const f32x4 v0 = acc[ai][bj][m][0], v1 = acc[ai][bj][m][1];
                            float q = (v0[0] * v0[0] + v0[1] * v0[1]) + (v0[2] * v0[2] + v0[3] * v0[3]) + (v1[0] * v1[0] + v1[1] * v1[1]) + (v1[2] * v1[2] + v1[3] * v1[3]);
                            q = mk_sum_xor32(mk_sum_xor16(q));
                            if (fq == 0) np[(size_t)(ai * HALF + m * 16) * 4] = q; } } }
        }
        else { base[0] = (size_t)row0 * ldc + col0; base[1] = base[0] + HALF; rstride = (size_t)ldc; }
#pragma unroll
        for (int ai = 0; ai < 2; ++ai)
#pragma unroll
            for (int m = 0; m < 4; ++m) {
#pragma unroll
                for (int bj = 0; bj < 2; ++bj) { const f32x4 v0 = acc[ai][bj][m][0], v1 = acc[ai][bj][m][1];
                    u32x4 w; w.x = cvt_pk_bf16(v0[0], v0[1]); w.y = cvt_pk_bf16(v0[2], v0[3]); w.z = cvt_pk_bf16(v1[0], v1[1]); w.w = cvt_pk_bf16(v1[2], v1[3]);
                    *(u32x4*)(O + base[bj] + (size_t)(ai * HALF + m * 16) * rstride) = w; } }
    }
};
struct EpiResid {
    static constexpr bool PERM = true, AFTER_DRAIN = false;
    const void* Xs; bf16_t* Xd; const float* gate; int src_f32; const float* stats;
    __device__ __forceinline__ void unit_begin(PG8_LAS unsigned char* lds, const Unit& u, int ui, int wid, int) const {
        if (wid < 5) { int lane; asm volatile("v_mbcnt_lo_u32_b32 %0, -1, 0\n\tv_mbcnt_hi_u32_b32 %0, -1, %0" : "=&v"(lane));
            const float* src = wid < 3 ? (wid == 0 ? gate + (size_t)((u.pm * BM) >> 12) * 12288 : stats + 2 * 16384 + (src_f32 >> 1) + (wid - 1) * 2048) + u.pn * BM + lane * 4
                                       : stats + (size_t)(u.pm * BM + (wid - 3) * 128) * 2 + lane * 4;
            __builtin_amdgcn_global_load_lds((const unsigned*)src, (PG8_LAS unsigned*)(lds + EPI_LDS_OFF + (ui & 1) * EPI_LDS_PAR + wid * 1024), 16, 0, 0); }
    }
    __device__ __forceinline__ void operator()(const f32x4 (&acc)[2][2][4][2], const Unit& u, int wr, int wc, int fr, int fq, PG8_LAS unsigned char* lds, int ui) const {
        const int row0 = u.pm * BM + wr * 64 + fr, col0 = u.pn * BM + wc * 32 + 8 * fq;
        const PG8_LAS float* lv = (const PG8_LAS float*)(lds + EPI_LDS_OFF + (ui & 1) * EPI_LDS_PAR) + wc * 32 + 8 * fq;
        if (src_f32 & 1) {
            f32x4 gv[2][2], av[2][2], bv[2][2];
#pragma unroll
            for (int bj = 0; bj < 2; ++bj)
#pragma unroll
                for (int n = 0; n < 2; ++n) { gv[bj][n] = *(const PG8_LAS f32x4*)(lv + bj * HALF + n * 4); av[bj][n] = *(const PG8_LAS f32x4*)(lv + 256 + bj * HALF + n * 4); bv[bj][n] = *(const PG8_LAS f32x4*)(lv + 512 + bj * HALF + n * 4); }
#pragma unroll
            for (int ai = 0; ai < 2; ++ai)
#pragma unroll
                for (int mp = 0; mp < 2; ++mp) {
                    f32x4 xv[2][2][2]; f32x2 st[2];
#pragma unroll
                    for (int mm = 0; mm < 2; ++mm) { const size_t row = (size_t)(row0 + ai * HALF + (2 * mp + mm) * 16); st[mm] = *(const f32x2*)(stats + row * 2); const float* rowp = (const float*)Xs + row * 2048 + col0;
#pragma unroll
                        for (int bj = 0; bj < 2; ++bj)
#pragma unroll
                            for (int n = 0; n < 2; ++n) xv[mm][bj][n] = *(const f32x4*)(rowp + bj * HALF + n * 4); }
#pragma unroll
                    for (int mm = 0; mm < 2; ++mm) { bf16_t* rowp = Xd + (size_t)(row0 + ai * HALF + (2 * mp + mm) * 16) * 2048 + col0; const float mean = st[mm][0], rstd = st[mm][1];
#pragma unroll
                        for (int bj = 0; bj < 2; ++bj) {
                            const f32x4 r0 = (xv[mm][bj][0] - mean) * rstd * av[bj][0] + bv[bj][0] + gv[bj][0] * acc[ai][bj][2 * mp + mm][0];
                            const f32x4 r1 = (xv[mm][bj][1] - mean) * rstd * av[bj][1] + bv[bj][1] + gv[bj][1] * acc[ai][bj][2 * mp + mm][1];
                            u32x4 w; w.x = cvt_pk_bf16(r0[0], r0[1]); w.y = cvt_pk_bf16(r0[2], r0[3]); w.z = cvt_pk_bf16(r1[0], r1[1]); w.w = cvt_pk_bf16(r1[2], r1[3]);
                            *(u32x4*)(rowp + bj * HALF) = w; } } }
        } else {
#pragma unroll
            for (int ai = 0; ai < 2; ++ai) {
                u32x4 xb[4][2]; f32x2 st[4];
#pragma unroll
                for (int m = 0; m < 4; ++m) { const size_t row = (size_t)(row0 + ai * HALF + m * 16); const bf16_t* rowp = (const bf16_t*)Xs + row * 2048 + col0;
                    xb[m][0] = *(const u32x4*)(rowp); xb[m][1] = *(const u32x4*)(rowp + HALF); }
                __builtin_amdgcn_sched_barrier(0);
#pragma unroll
                for (int m = 0; m < 4; ++m) st[m] = ((const PG8_LAS f32x2*)(lds + EPI_LDS_OFF + (ui & 1) * EPI_LDS_PAR + 3072))[ai * HALF + wr * 64 + m * 16 + fr];
#pragma unroll
                for (int bj = 0; bj < 2; ++bj) {
                    const f32x4 g0 = *(const PG8_LAS f32x4*)(lv + bj * HALF), g1 = *(const PG8_LAS f32x4*)(lv + bj * HALF + 4);
                    const f32x4 a0 = *(const PG8_LAS f32x4*)(lv + 256 + bj * HALF), a1 = *(const PG8_LAS f32x4*)(lv + 256 + bj * HALF + 4);
                    const f32x4 b0 = *(const PG8_LAS f32x4*)(lv + 512 + bj * HALF), b1 = *(const PG8_LAS f32x4*)(lv + 512 + bj * HALF + 4);
#pragma unroll
                    for (int m = 0; m < 4; ++m) {
                        bf16_t* rowp = Xd + (size_t)(row0 + ai * HALF + m * 16) * 2048 + col0 + bj * HALF; const float mean = st[m][0], rstd = st[m][1];
                        const u32x4 xw = xb[m][bj]; f32x4 x0, x1;
                        x0[0] = __uint_as_float(xw.x << 16); x0[1] = __uint_as_float(xw.x & 0xffff0000u); x0[2] = __uint_as_float(xw.y << 16); x0[3] = __uint_as_float(xw.y & 0xffff0000u);
                        x1[0] = __uint_as_float(xw.z << 16); x1[1] = __uint_as_float(xw.z & 0xffff0000u); x1[2] = __uint_as_float(xw.w << 16); x1[3] = __uint_as_float(xw.w & 0xffff0000u);
                        const f32x4 r0 = (x0 - mean) * rstd * a0 + b0 + g0 * acc[ai][bj][m][0];
                        const f32x4 r1 = (x1 - mean) * rstd * a1 + b1 + g1 * acc[ai][bj][m][1];
                        u32x4 w; w.x = cvt_pk_bf16(r0[0], r0[1]); w.y = cvt_pk_bf16(r0[2], r0[3]); w.z = cvt_pk_bf16(r1[0], r1[1]); w.w = cvt_pk_bf16(r1[2], r1[3]);
                        *(u32x4*)rowp = w; } }
                __builtin_amdgcn_sched_barrier(0); }
        }
    }
};
template <int CTRL> __device__ __forceinline__ float dppf(float v) { return __builtin_bit_cast(float, __builtin_amdgcn_update_dpp(0, __builtin_bit_cast(int, v), CTRL, 0xf, 0xf, true)); }
typedef unsigned u32x2v __attribute__((ext_vector_type(2)));
struct EpiFfn {
    static constexpr bool PERM = true, AFTER_DRAIN = false;
    bf16_t* ACT; float* ZH; const float* cw; const float* cb;
    __device__ __forceinline__ void unit_begin(PG8_LAS unsigned char* lds, const Unit& u, int ui, int wid, int) const {
        if (wid < 4) { int lane; asm volatile("v_mbcnt_lo_u32_b32 %0, -1, 0\n\tv_mbcnt_hi_u32_b32 %0, -1, %0" : "=&v"(lane));
            const float* src = (wid < 3 ? cw + wid * 11264 : cb) + (lane < 32 ? 0 : 5632) + u.pn * 128 + (lane & 31) * 4;
            __builtin_amdgcn_global_load_lds((const unsigned*)src, (PG8_LAS unsigned*)(lds + EPI_LDS_OFF + (ui & 1) * EPI_LDS_PAR + wid * 1024), 16, 0, 0); }
    }
    __device__ __forceinline__ void operator()(const f32x4 (&acc)[2][2][4][2], const Unit& u, int wr, int wc, int fr, int fq, PG8_LAS unsigned char* lds, int ui) const {
#pragma unroll
        for (int n = 0; n < 2; ++n) {
            const int ch0 = u.pn * 128 + wc * 32 + 8 * fq + 4 * n;
            f32x4 wa[3], wu[3];
            const PG8_LAS float* lw = (const PG8_LAS float*)(lds + EPI_LDS_OFF + (ui & 1) * EPI_LDS_PAR) + wc * 32 + 8 * fq + 4 * n;
#pragma unroll
            for (int k = 0; k < 3; ++k) { wa[k] = *(const PG8_LAS f32x4*)(lw + k * 256); wu[k] = *(const PG8_LAS f32x4*)(lw + k * 256 + 128); }
            const f32x4 ba = *(const PG8_LAS f32x4*)(lw + 3 * 256), bu = *(const PG8_LAS f32x4*)(lw + 3 * 256 + 128);
#pragma unroll
            for (int ai = 0; ai < 2; ++ai) { const int blk = u.pm * 4 + ai * 2 + wr;
                if (fr < 2) { float* zp = ZH + ((size_t)(blk * 4 + 2 + fr) * 2) * 5632 + ch0; *(f32x4*)zp = acc[ai][0][0][n]; *(f32x4*)(zp + 5632) = acc[ai][1][0][n]; }
                if (fr >= 14) { float* zp = ZH + ((size_t)((blk + 1) * 4 + fr - 14) * 2) * 5632 + ch0; *(f32x4*)zp = acc[ai][0][3][n]; *(f32x4*)(zp + 5632) = acc[ai][1][3][n]; }
                f32x4 q1a = {0.f, 0.f, 0.f, 0.f}, q0a = q1a, q1u = q1a, q0u = q1a;
#pragma unroll
                for (int m = 0; m < 4; ++m) { float o[4];
                    const f32x4 va = acc[ai][0][m][n], vu = acc[ai][1][m][n];
                    f32x4 t1a = wa[1] * va, t0a = wa[0] * va, t1u = wu[1] * vu, t0u = wu[0] * vu;
                    f32x4 ya = ba + wa[2] * va, yu = bu + wu[2] * vu;
#define FFN_DPP4(Y, T, CTRL) asm volatile("s_nop 1\n\tv_add_f32_dpp %0, %4, %0 " CTRL " row_mask:0xf bank_mask:0xf bound_ctrl:1\n\tv_add_f32_dpp %1, %5, %1 " CTRL " row_mask:0xf bank_mask:0xf bound_ctrl:1\n\t" \
                                          "v_add_f32_dpp %2, %6, %2 " CTRL " row_mask:0xf bank_mask:0xf bound_ctrl:1\n\tv_add_f32_dpp %3, %7, %3 " CTRL " row_mask:0xf bank_mask:0xf bound_ctrl:1" \
                                          : "+v"(Y[0]), "+v"(Y[1]), "+v"(Y[2]), "+v"(Y[3]) : "v"(T[0]), "v"(T[1]), "v"(T[2]), "v"(T[3]))
                    asm volatile("s_nop 4" : "+v"(t1a), "+v"(t0a), "+v"(t1u), "+v"(t0u), "+v"(q1a), "+v"(q0a), "+v"(q1u), "+v"(q0u));
                    FFN_DPP4(ya, t1a, "row_shr:1"); FFN_DPP4(yu, t1u, "row_shr:1"); FFN_DPP4(ya, t0a, "row_shr:2"); FFN_DPP4(yu, t0u, "row_shr:2");
                    if (m) { FFN_DPP4(ya, q1a, "row_shl:15"); FFN_DPP4(yu, q1u, "row_shl:15"); FFN_DPP4(ya, q0a, "row_shl:14"); FFN_DPP4(yu, q0u, "row_shl:14"); }
#undef FFN_DPP4
#pragma unroll
                    for (int e = 0; e < 4; e += 2) {
                        const f32x2 a2 = {ya[e], ya[e + 1]}, u2 = {yu[e], yu[e + 1]}, x2 = a2 * (-1.4426950408889634f);
                        f32x2 d2; d2.x = __builtin_amdgcn_exp2f(x2.x); d2.y = __builtin_amdgcn_exp2f(x2.y); d2 = d2 + 1.0f;
                        f32x2 r2; r2.x = __builtin_amdgcn_rcpf(d2.x); r2.y = __builtin_amdgcn_rcpf(d2.y);
                        const f32x2 o2 = (a2 * u2) * r2; o[e] = o2.x; o[e + 1] = o2.y; }
                    q1a = t1a; q0a = t0a; q1u = t1u; q0u = t0u;
                    if (m > 0 || fr >= 2) { u32x2v w; w.x = cvt_pk_bf16(o[0], o[1]); w.y = cvt_pk_bf16(o[2], o[3]); *(u32x2v*)(ACT + (size_t)(blk * 64 + m * 16 + fr) * 5632 + ch0) = w; }
                    __builtin_amdgcn_sched_barrier(0); } } }
    }
};
}
namespace fx {
using bf16 = __hip_bfloat16;
constexpr int D = 128, RS = 128  , OS = 2048  ;
constexpr float THR = 24.f;     constexpr bool WSKIP = false; constexpr float T_DEAD = 24.f;
constexpr float SCALE = 0.08838834764831845f;
constexpr int NW = 8, QBLK = 32, KVBLK = 64, QB = NW * QBLK;
constexpr int SHM_V = KVBLK * D * 2, SHM_K = KVBLK * D * 2;
constexpr int BIAS_OFF = 2 * SHM_V + 2 * SHM_K + NW * 64 * 4;
constexpr int GATE_OFF = BIAS_OFF + 4096 * 4;
constexpr int LDS_BYTES = GATE_OFF + 8 * 8192;
typedef short bf16x8 __attribute__((ext_vector_type(8)));
typedef short s16x4 __attribute__((ext_vector_type(4)));
typedef float f32x16 __attribute__((ext_vector_type(16)));
typedef float f32x4 __attribute__((ext_vector_type(4)));
typedef unsigned u32x4 __attribute__((ext_vector_type(4)));
template <class A, class Bt> struct same_t { static constexpr bool v = false; };
template <class A> struct same_t<A, A> { static constexpr bool v = true; };
#define KSWZ(row, colB) ((row) * 256 + ((colB) ^ (((row) & 7) << 4)))
#define SBAR() __builtin_amdgcn_sched_barrier(0)
__device__ __forceinline__ int v_st(int k, int c) { const int kk = (k & ~0xC) | ((k & 4) << 1) | ((k & 8) >> 1); return ((kk >> 3) * 4 + (c >> 5)) * 512 + ((kk & 7) * 32 + (c & 31)) * 2; }
__device__ __forceinline__ int v_rd_base(int lane) { return ((lane & 3) << 3) | (((lane >> 2) & 3) << 6) | (((lane >> 4) & 1) << 5) | (((lane >> 5) & 1) << 8); }
constexpr int v_rd_off(int d0, int ks, int half) { return d0 * 512 + ks * 4096 + half * 2048; }
__device__ __forceinline__ int crow(int r, int hi) { return (r & 3) + 8 * (r >> 2) + 4 * hi; }
__device__ __forceinline__ unsigned cvtpk(float lo, float hi) {
    unsigned r; asm volatile("v_cvt_pk_bf16_f32 %0, %1, %2" : "=v"(r) : "v"(lo), "v"(hi)); return r;
}
__device__ __forceinline__ bf16x8 pack8(f32x4 a, f32x4 b) {
    u32x4 w = {cvtpk(a[0], a[1]), cvtpk(a[2], a[3]), cvtpk(b[0], b[1]), cvtpk(b[2], b[3])};
    return *reinterpret_cast<bf16x8*>(&w);
}
template <class T> __device__ __forceinline__ bf16x8 load8(const T* p) {
    if constexpr (same_t<T, float>::v) { return pack8(*(const f32x4*)p, *(const f32x4*)(p + 4)); }
    else { return *reinterpret_cast<const bf16x8*>(p); }
}
__device__ __forceinline__ void mask_tile(f32x16& p0, f32x16& p1, int dq, unsigned W) {
    const float NEG = -__builtin_inff();
#pragma unroll
    for (int r = 0; r < 16; ++r) {
        const int c = (r & 3) + 8 * (r >> 2);
        if ((unsigned)(dq - c) >= W) p0[r] = NEG;
        if ((unsigned)(dq - c - 32) >= W) p1[r] = NEG;
    }
}
__device__ __forceinline__ void partialSM(f32x16& p0, f32x16& p1, float& m_reg, float& mn, float& alpha, bool& dead) {
    float pmax = p0[0]; for (int r = 1; r < 16; ++r) pmax = fmaxf(pmax, p0[r]); for (int r = 0; r < 16; ++r) pmax = fmaxf(pmax, p1[r]);
    { auto rr = __builtin_amdgcn_permlane32_swap(__float_as_uint(pmax), __float_as_uint(pmax), false, false);
      pmax = fmaxf(__uint_as_float(rr[0]), __uint_as_float(rr[1])); }
    constexpr float C2 = 1.4426950408889634f * SCALE;
    dead = __all((pmax - m_reg) * SCALE < -T_DEAD);
    if (dead) { mn = m_reg; alpha = 1.f; return; }
    if (__builtin_expect(__all((pmax - m_reg) * SCALE <= THR), 1)) { mn = m_reg; alpha = 1.f; }
    else { mn = fmaxf(m_reg, pmax); alpha = __builtin_amdgcn_exp2f((m_reg - mn) * C2); m_reg = mn; }
    const float mnL = -mn * C2;
    for (int r = 0; r < 16; ++r) p0[r] = fmaf(p0[r], C2, mnL); for (int r = 0; r < 16; ++r) p1[r] = fmaf(p1[r], C2, mnL);
    for (int r = 0; r < 16; ++r) p0[r] = __builtin_amdgcn_exp2f(p0[r]);
}
__device__ __forceinline__ void finishSM(f32x16& p0, f32x16& p1, float alpha, float& l_reg, bf16x8& pa0, bf16x8& pa1, bf16x8& pa2, bf16x8& pa3) {
    for (int r = 0; r < 16; ++r) p1[r] = __builtin_amdgcn_exp2f(p1[r]);
    float ps = 0; for (int r = 0; r < 16; ++r) ps += p0[r]; for (int r = 0; r < 16; ++r) ps += p1[r];
    { auto rr = __builtin_amdgcn_permlane32_swap(__float_as_uint(ps), __float_as_uint(ps), false, false);
      ps = __uint_as_float(rr[0]) + __uint_as_float(rr[1]); }
    l_reg = l_reg * alpha + ps;
#define PK4(P, B_, OUT) do { unsigned a0 = cvtpk(P[B_+0], P[B_+1]), a1 = cvtpk(P[B_+2], P[B_+3]);                          \
        unsigned b0 = cvtpk(P[B_+4], P[B_+5]), b1 = cvtpk(P[B_+6], P[B_+7]);                                             \
        auto r0 = __builtin_amdgcn_permlane32_swap(a0, b0, false, false); auto r1 = __builtin_amdgcn_permlane32_swap(a1, b1, false, false); \
        u32x4 w = {r0[0], r1[0], r0[1], r1[1]}; OUT = *reinterpret_cast<bf16x8*>(&w); } while (0)
    PK4(p0, 0, pa0); PK4(p0, 8, pa1); PK4(p1, 0, pa2); PK4(p1, 8, pa3);
#undef PK4
}
template <int KB, bool SK>
__device__ __forceinline__ void qkt(f32x16& p0, f32x16& p1, const char* K_lds, int r32, int hi, const bf16x8* qr, bool act, const float* bl) {
    if (SK && !act) { const float NEG = -__builtin_inff();
#pragma unroll
        for (int r = 0; r < 16; ++r) { p0[r] = NEG; p1[r] = NEG; } return; }
#pragma unroll
    for (int g_ = 0; g_ < 4; ++g_) { const f32x4 t0 = *(const f32x4*)(bl + 8 * g_), t1 = *(const f32x4*)(bl + 32 + 8 * g_);
#pragma unroll
        for (int e_ = 0; e_ < 4; ++e_) { p0[4 * g_ + e_] = t0[e_]; p1[4 * g_ + e_] = t1[e_]; } }
    const char* kb[4];
#pragma unroll
    for (int dd = 0; dd < 4; ++dd) kb[dd] = K_lds + KB * SHM_K + KSWZ(r32, (dd * 16 + hi * 8) * 2);
#pragma unroll
    for (int d0 = 0; d0 < 8; ++d0) { const char* a = kb[d0 & 3] + (d0 >> 2) * 128;
        bf16x8 b0 = *reinterpret_cast<const bf16x8*>(a);
        bf16x8 b1 = *reinterpret_cast<const bf16x8*>(a + 32 * 256);
        p0 = __builtin_amdgcn_mfma_f32_32x32x16_bf16(b0, qr[d0], p0, 0, 0, 0);
        p1 = __builtin_amdgcn_mfma_f32_32x32x16_bf16(b1, qr[d0], p1, 0, 0, 0); }
}
template <int VB, bool SK>
__device__ __forceinline__ void pv_tile(f32x16* o, int vb0, bf16x8 pa0, bf16x8 pa1, bf16x8 pa2, bf16x8 pa3, bool act) {
    if (SK && !act) return;
#define TRRD(dst, off) asm volatile("ds_read_b64_tr_b16 %0, %1 offset:%2" : "=&v"(dst) : "v"(vb0), "i"(off) : "memory")
#define PV_D0(d0) do { s16x4 l0, l1, l2, l3, h0, h1, h2, h3; constexpr int b_ = VB * SHM_V + v_rd_off(d0, 0, 0);     \
        TRRD(l0, b_); TRRD(h0, b_ + 2048); TRRD(l1, b_ + 4096); TRRD(h1, b_ + 6144); TRRD(l2, b_ + 8192); TRRD(h2, b_ + 10240); TRRD(l3, b_ + 12288); TRRD(h3, b_ + 14336); \
        asm volatile("s_waitcnt lgkmcnt(0)" ::: "memory"); SBAR();                 \
        o[d0] = __builtin_amdgcn_mfma_f32_32x32x16_bf16(pa0, (bf16x8){l0[0], l0[1], l0[2], l0[3], h0[0], h0[1], h0[2], h0[3]}, o[d0], 0, 0, 0);   \
        o[d0] = __builtin_amdgcn_mfma_f32_32x32x16_bf16(pa1, (bf16x8){l1[0], l1[1], l1[2], l1[3], h1[0], h1[1], h1[2], h1[3]}, o[d0], 0, 0, 0);   \
        o[d0] = __builtin_amdgcn_mfma_f32_32x32x16_bf16(pa2, (bf16x8){l2[0], l2[1], l2[2], l2[3], h2[0], h2[1], h2[2], h2[3]}, o[d0], 0, 0, 0);   \
        o[d0] = __builtin_amdgcn_mfma_f32_32x32x16_bf16(pa3, (bf16x8){l3[0], l3[1], l3[2], l3[3], h3[0], h3[1], h3[2], h3[3]}, o[d0], 0, 0, 0); } while (0)
    PV_D0(0); PV_D0(1); PV_D0(2); PV_D0(3);
#undef PV_D0
#undef TRRD
}

template <class TIn, class TOut> struct BlockRef { const TIn* Q; const TIn* K; const TIn* V; TOut* O; const float* Bias; const TIn* G; int P0; int JLO; };
#define FX_LASU __attribute__((address_space(3))) unsigned
#define BIAS_DMA(ref) do { _Pragma("unroll") for (int i_ = 0; i_ < 2; ++i_) __builtin_amdgcn_global_load_lds((const unsigned*)((ref).Bias + (size_t)(i_ * 512 + tid) * 4), (FX_LASU*)(lds + BIAS_OFF + i_ * 8192 + wid * 1024), 16, 0, 0); } while (0)
template <class TIn> struct Seam {
    bf16x8 qr[8];
    bf16x8 st_v0, st_v1, st_k0, st_k1; f32x4 sf0, sf1, sf2, sf3;
    f32x4 tq[16];
};
__device__ __forceinline__ int swa_jlo(int P0, int W) { const int lowk = P0 - W + 1; return lowk > 0 ? lowk / KVBLK : 0; }
#define ROW(p, k0, rr) ((p) + (size_t)((k0) + (rr)) * RS + sc)
#define VMW() asm volatile("s_waitcnt vmcnt(0)" ::: "memory")
#define VMWN(n) asm volatile("s_waitcnt vmcnt(%0)" :: "i"(n) : "memory")
#define SLOAD_H(Kp, Vp, k0) do { S.st_v0 = load8<TIn>(ROW(Vp, k0, sr)); S.st_v1 = load8<TIn>(ROW(Vp, k0, 32 + sr));              \
                         S.st_k0 = load8<TIn>(ROW(Kp, k0, sr)); S.st_k1 = load8<TIn>(ROW(Kp, k0, 32 + sr)); } while (0)
#define SWRITE_HK(bf) do { *(bf16x8*)(K_lds + (bf) * SHM_K + kws) = S.st_k0; *(bf16x8*)(K_lds + (bf) * SHM_K + kws + 32 * 256) = S.st_k1; } while (0)
#define SWRITE_HV(bf) do { *(bf16x8*)(V_lds + (bf) * SHM_V + vst0) = S.st_v0; *(bf16x8*)(V_lds + (bf) * SHM_V + vst1) = S.st_v1; } while (0)
#define SWRITE_H(bf) do { SWRITE_HV(bf); SWRITE_HK(bf); } while (0)
#define SLOAD_F(p, k0) do { S.sf0 = *(const f32x4*)ROW(p, k0, sr); S.sf1 = *(const f32x4*)(ROW(p, k0, sr) + 4);                \
                            S.sf2 = *(const f32x4*)ROW(p, k0, 32 + sr); S.sf3 = *(const f32x4*)(ROW(p, k0, 32 + sr) + 4); } while (0)
#define SWRITE_KF(bf) do { *(bf16x8*)(K_lds + (bf) * SHM_K + kws) = pack8(S.sf0, S.sf1); *(bf16x8*)(K_lds + (bf) * SHM_K + kws + 32 * 256) = pack8(S.sf2, S.sf3); } while (0)
#define SWRITE_VF(bf) do { *(bf16x8*)(V_lds + (bf) * SHM_V + vst0) = pack8(S.sf0, S.sf1); *(bf16x8*)(V_lds + (bf) * SHM_V + vst1) = pack8(S.sf2, S.sf3); } while (0)
template <class TIn, class TOut>
__device__ __forceinline__ void causal_swa_prime(const BlockRef<TIn, TOut>& cur, int W, char* lds, Seam<TIn>& S, int tid_in) {
    constexpr bool F32 = same_t<TIn, float>::v;
    int tid_l_ = tid_in; asm volatile("" : "+v"(tid_l_));
    const int tid = tid_l_, wid = __builtin_amdgcn_readfirstlane(tid >> 6), lane = tid & 63, r32 = lane & 31, hi = lane >> 5;
    const int sr = tid >> 4, sc = (tid & 15) * 8, kws = KSWZ(sr, sc * 2); char* K_lds = lds + 2 * SHM_V;
    const int kb0 = ((cur.P0 + QB - 1) / KVBLK) * KVBLK;
    for (int d0 = 0; d0 < 8; ++d0) S.qr[d0] = load8<TIn>(cur.Q + (size_t)(wid * QBLK + r32) * RS + d0 * 16 + hi * 8);
    BIAS_DMA(cur);
    if constexpr (F32) { SLOAD_F((const float*)cur.K, kb0); VMW(); SWRITE_KF(0); SBAR(); SLOAD_F((const float*)cur.V, kb0); }
    else { SLOAD_H(cur.K, cur.V, kb0); VMW(); SWRITE_HK(0); }
    __syncthreads();
}
template <class TIn, class TOut>
__device__ __forceinline__ void causal_swa_block(const BlockRef<TIn, TOut>& cur, const BlockRef<TIn, TOut>& nxt, int skv, int W, char* lds, Seam<TIn>& S, int tid_in) {
    constexpr bool F32 = same_t<TIn, float>::v;
    int tid_l_ = tid_in; asm volatile("" : "+v"(tid_l_));
    const int tid = tid_l_, wid = __builtin_amdgcn_readfirstlane(tid >> 6), lane = tid & 63, r32 = lane & 31, hi = lane >> 5;
    const int j_lo = cur.JLO;
    int j_hi = (cur.P0 + QB - 1) / KVBLK + 1; if (j_hi > skv / KVBLK) j_hi = skv / KVBLK;
    const int NT = j_hi - j_lo;
    const int kbn = ((nxt.P0 + QB - 1) / KVBLK) * KVBLK;
    const int qlo = cur.P0 + wid * QBLK, qm = qlo + r32 - 4 * hi;
    char* V_lds = lds; char* K_lds = lds + 2 * SHM_V; const float* bias_l = (const float*)(lds + BIAS_OFF) + 4 * hi;
    float* ws = (float*)(lds + 2 * SHM_V + 2 * SHM_K) + wid * 64; float* li_l = ws, * al_l = ws + 32;
    float m_reg = -1e30f, l_reg = 0; f32x16 o[4] = {};
    const int sr = tid >> 4, sc = (tid & 15) * 8, vst0 = v_st(sr, sc), vst1 = v_st(32 + sr, sc), kws = KSWZ(sr, sc * 2);
    const int vb0 = (int)(uintptr_t)V_lds + v_rd_base(lane);
    const TIn* Kh = cur.K; const TIn* Vh = cur.V;
#define RESC(a) do { if (__any((a) < 1.f)) { if (hi == 0) al_l[r32] = (a); asm volatile("s_waitcnt lgkmcnt(0)" ::: "memory");              \
                     for (int d_ = 0; d_ < 4; ++d_) for (int r = 0; r < 16; ++r) o[d_][r] *= al_l[crow(r, hi)]; } } while (0)
#define KBASE(t) ((j_hi - 1 - (t)) * KVBLK)
#define ACT(t) (KBASE(t) <= qlo + QBLK - 1 && KBASE(t) + KVBLK - 1 >= qlo - W + 1)
#define MASKT(P0_, P1_, t) do { const int kb_ = KBASE(t); if ((!SK || ACT(t)) && (kb_ + KVBLK - 1 > qlo || kb_ <= qlo + QBLK - 1 - W)) mask_tile(P0_, P1_, qm - kb_, (unsigned)W); } while (0)
    constexpr int NQL = F32 ? 16 : 8;
    constexpr bool SK = WSKIP && !F32;
#define SEAM_K0() do { if constexpr (F32) { VMWN(NQL); SWRITE_KF(0); SBAR(); SLOAD_F((const float*)nxt.V, kbn); } else { VMW(); SWRITE_HK(0); } SBAR(); } while (0)
    f32x16 pA0, pA1, pB0, pB1; float mnA, mnB, alA, alB; bf16x8 pa0, pa1, pa2, pa3;
    if constexpr (F32) { VMW(); SWRITE_VF(0); SBAR(); } else { SWRITE_HV(0); SBAR(); }
    if (NT > 1) { if constexpr (F32) SLOAD_F((const float*)Kh, KBASE(1)); else SLOAD_H(Kh, Vh, KBASE(1)); }
    SBAR(); qkt<0, SK>(pA0, pA1, K_lds, r32, hi, S.qr, ACT(0), bias_l + KBASE(0));
    if constexpr (F32) { if (NT > 1) { VMW(); SWRITE_KF(1); SBAR(); SLOAD_F((const float*)Vh, KBASE(1)); } }
    bool dA = false, dB = false;
    MASKT(pA0, pA1, 0); partialSM(pA0, pA1, m_reg, mnA, alA, dA);
    if (NT > 1) { VMW(); if constexpr (F32) { SWRITE_VF(1); SBAR(); if (NT > 2) SLOAD_F((const float*)Kh, KBASE(2)); } else SWRITE_H(1); }
    __syncthreads();
#define HALF_STEP(PX0, PX1, mnX, alX, dX, PY0, PY1, alY, dY, t, KB, VB, SB) do {                                                      \
        if constexpr (!F32) { if ((t) + 1 < NT) SLOAD_H(Kh, Vh, KBASE((t) + 1)); }     \
        SBAR(); qkt<KB, SK>(PX0, PX1, K_lds, r32, hi, S.qr, ACT(t), bias_l + KBASE(t));                                             \
        if (!(dY)) finishSM(PY0, PY1, alY, l_reg, pa0, pa1, pa2, pa3); SBAR();                                                \
        if ((t) + 1 < NT) { if constexpr (F32) { VMW(); SWRITE_KF(SB); SBAR(); SLOAD_F((const float*)Vh, KBASE((t) + 1)); }  \
                            SBAR(); }                                                                                        \
        if (!(dY)) pv_tile<VB, SK>(o, vb0, pa0, pa1, pa2, pa3, ACT((t) - 1)); MASKT(PX0, PX1, (t)); partialSM(PX0, PX1, m_reg, mnX, alX, dX);                                        \
        __syncthreads();                                                                                                      \
        if ((t) + 1 < NT) { VMW(); if constexpr (F32) { SWRITE_VF(SB); SBAR(); if ((t) + 2 < NT) SLOAD_F((const float*)Kh, KBASE((t) + 2)); } \
                            else { SWRITE_H(SB); } }                                                                          \
        RESC(alX); __syncthreads(); } while (0)
    for (int t = 1; t + 1 < NT; t += 2) {
        HALF_STEP(pB0, pB1, mnB, alB, dB, pA0, pA1, alA, dA, t, 1, 0, 0);
        HALF_STEP(pA0, pA1, mnA, alA, dA, pB0, pB1, alB, dB, t + 1, 0, 1, 1);
    }
    const bool even = (NT & 1) == 0;
    if (even) { SBAR(); qkt<1, SK>(pB0, pB1, K_lds, r32, hi, S.qr, ACT(NT - 1), bias_l + KBASE(NT - 1)); SBAR(); } else { BIAS_DMA(nxt); }
    { const char* gsrc_ = (const char*)(cur.G + (size_t)(wid * QBLK + (lane >> 4)) * RS + (lane & 15) * 8);
      _Pragma("unroll") for (int i_ = 0; i_ < 8; ++i_) __builtin_amdgcn_global_load_lds((const unsigned*)(gsrc_ + (size_t)i_ * 4 * RS * 2), (FX_LASU*)(lds + GATE_OFF + wid * 8192 + i_ * 1024), 16, 0, 0); }
#define QROW(e) (nxt.Q + (size_t)(wid * QBLK + r32) * RS + ((e) >> 1) * 16 + hi * 8 + ((e) & 1) * 4)
    if constexpr (F32) { SLOAD_F((const float*)nxt.K, kbn); SBAR();
#pragma unroll
        for (int e = 0; e < 8; ++e) S.tq[e] = *(const f32x4*)QROW(e); }
    else { SLOAD_H(nxt.K, nxt.V, kbn); SBAR();
#pragma unroll
        for (int d0 = 0; d0 < 8; ++d0) S.qr[d0] = load8<TIn>(nxt.Q + (size_t)(wid * QBLK + r32) * RS + d0 * 16 + hi * 8); }
    SBAR();
    if (!dA) finishSM(pA0, pA1, alA, l_reg, pa0, pa1, pa2, pa3); SBAR();
    if constexpr (F32) {
#pragma unroll
        for (int e = 8; e < 16; ++e) S.tq[e] = *(const f32x4*)QROW(e); SBAR(); }
#undef QROW
    if (!dA) pv_tile<0, SK>(o, vb0, pa0, pa1, pa2, pa3, ACT(even ? NT - 2 : NT - 1));
    if (even) { MASKT(pB0, pB1, NT - 1); partialSM(pB0, pB1, m_reg, mnB, alB, dB); __syncthreads(); BIAS_DMA(nxt); RESC(alB);
        if (!dB) { finishSM(pB0, pB1, alB, l_reg, pa0, pa1, pa2, pa3); SBAR(); pv_tile<1, SK>(o, vb0, pa0, pa1, pa2, pa3, ACT(NT - 1)); } }
    SBAR(); SEAM_K0();
    if (hi == 0) li_l[r32] = l_reg; asm volatile("s_waitcnt lgkmcnt(0)" ::: "memory");
    float rli[16];
#pragma unroll
    for (int r = 0; r < 16; ++r) rli[r] = __builtin_amdgcn_rcpf(li_l[crow(r, hi)]);
    TOut* Owl = cur.O + (size_t)(wid * QBLK + 4 * hi) * OS + r32; const char* gll = lds + GATE_OFF + wid * 8192 + hi * 1024 + r32 * 2;
#pragma unroll
    for (int r = 0; r < 16; ++r) { constexpr int dummy_ = 0; const int rc = (r & 3) + 8 * (r >> 2);
#pragma unroll
        for (int d0 = 0; d0 < 4; ++d0) { const float v = o[d0][r] * rli[r];
            const float vn = mk_xor1(v);
            if ((r32 & 1) == 0) { const unsigned gg = *(const unsigned*)(gll + rc * 256 + d0 * 64);
                const float g0 = __uint_as_float(gg << 16), g1 = __uint_as_float(gg & 0xffff0000u);
                const float s0 = __builtin_amdgcn_rcpf(1.f + __expf(-g0)), s1 = __builtin_amdgcn_rcpf(1.f + __expf(-g1));
                *(unsigned*)(Owl + (size_t)rc * OS + d0 * 32) = cvtpk(v * s0, vn * s1); } }
        SBAR(); }
    if constexpr (F32) {
#pragma unroll
        for (int d0 = 0; d0 < 8; ++d0) S.qr[d0] = pack8(S.tq[2 * d0], S.tq[2 * d0 + 1]); }
    __syncthreads();
#undef RESC
#undef KBASE
#undef ACT
#undef MASKT
#undef SEAM_K0
#undef HALF_STEP
}
#undef ROW
#undef VMW
#undef VMWN
#undef SLOAD_H
#undef SWRITE_HK
#undef SWRITE_HV
#undef SWRITE_H
#undef SLOAD_F
#undef SWRITE_KF
#undef SWRITE_VF

}

typedef unsigned short bf16_t;
typedef float f32x4 __attribute__((ext_vector_type(4)));
typedef float f32x16 __attribute__((ext_vector_type(16)));
typedef float f32x2 __attribute__((ext_vector_type(2)));
typedef short bf16x8 __attribute__((ext_vector_type(8)));
typedef short bf16x4 __attribute__((ext_vector_type(4)));
typedef unsigned u32x4 __attribute__((ext_vector_type(4)));
typedef unsigned u32x2 __attribute__((ext_vector_type(2)));
constexpr int DM = 2048, NBATCH = 4, SEQ = 4096, MTOK = NBATCH * SEQ, DFF = 5632;
constexpr float LN_EPS = 1e-5f, RMS_EPS = 1e-5f, DN_ALPHA = 1.6817928305074290f;
constexpr size_t MiB = 1u << 20;
constexpr size_t WS_CTL = 0, CTL_ZERO_BYTES = 1 * MiB;
constexpr size_t WS_MOD = 1 * MiB;
constexpr size_t WS_SK16 = 2 * MiB;
constexpr size_t WS_FB = 3 * MiB;
constexpr size_t WS_ELAST = 4 * MiB;
constexpr size_t WS_ST = 5 * MiB;
constexpr size_t WS_ID = 5 * MiB + 512 * 1024;
constexpr size_t WS_WFOX = 8 * MiB;
constexpr size_t WS_WGLA = 88 * MiB;
constexpr size_t WS_WCONV = 120 * MiB;
constexpr size_t WS_WUP = 152 * MiB;
constexpr size_t WS_WDOWN = 328 * MiB;
constexpr size_t WS_H = 416 * MiB;
constexpr size_t WS_PROJ = 480 * MiB;
constexpr size_t WS_ACT = 832 * MiB;
constexpr size_t WS_QD = 1008 * MiB, WS_KI = 1040 * MiB, WS_KDT = 1072 * MiB, WS_VT = 1104 * MiB;
constexpr size_t WS_OINT = 1168 * MiB;
constexpr size_t WS_QDF = 1296 * MiB;
constexpr size_t WS_N2P = 1328 * MiB;
constexpr size_t WS_XB = 1336 * MiB;
constexpr size_t WS_PART = 1400 * MiB, PART_BYTES = 8 * MiB;
constexpr size_t WS_END = 1408 * MiB;
constexpr int LDS_TOTAL = 163840, MISC_OFF = LDS_TOTAL - 64;
constexpr int CW_BAR = 4096;

__device__ __forceinline__ float bf2f(unsigned short b) { return __uint_as_float(((unsigned)b) << 16); }
__device__ __forceinline__ unsigned pk2(float lo, float hi) { return pg8::cvt_pk_bf16(lo, hi); }
__device__ __forceinline__ unsigned short f2bf(float f) { return (unsigned short)(pk2(f, 0.f) & 0xffffu); }
template <int CTRL> __device__ __forceinline__ float dpp_rot(float v) { return __builtin_bit_cast(float, __builtin_amdgcn_update_dpp(0, __builtin_bit_cast(int, v), CTRL, 0xf, 0xf, false)); }
__device__ __forceinline__ float wave_sum(float v) {
    v += dpp_rot<0x128>(v); v += dpp_rot<0x124>(v); v += dpp_rot<0x122>(v); v += dpp_rot<0x121>(v);
    { auto rr = __builtin_amdgcn_permlane16_swap(__float_as_uint(v), __float_as_uint(v), false, false); v = __uint_as_float(rr[0]) + __uint_as_float(rr[1]); }
    { auto rr = __builtin_amdgcn_permlane32_swap(__float_as_uint(v), __float_as_uint(v), false, false); v = __uint_as_float(rr[0]) + __uint_as_float(rr[1]); }
    return v;
}
__device__ __forceinline__ float log_sigmoid(float x) { return fminf(x, 0.f) - __logf(1.f + __expf(-fabsf(x))); }
__device__ __forceinline__ float silu_f(float x) { return x * __builtin_amdgcn_rcpf(1.f + __expf(-x)); }
__device__ __forceinline__ int crow(int r, int hi) { return (r & 3) + 8 * (r >> 2) + 4 * hi; }
__device__ __forceinline__ void cvt8(const u32x4 w, float (&f)[8]) {
    f[0] = __uint_as_float(w.x << 16); f[1] = __uint_as_float(w.x & 0xffff0000u); f[2] = __uint_as_float(w.y << 16); f[3] = __uint_as_float(w.y & 0xffff0000u);
    f[4] = __uint_as_float(w.z << 16); f[5] = __uint_as_float(w.z & 0xffff0000u); f[6] = __uint_as_float(w.w << 16); f[7] = __uint_as_float(w.w & 0xffff0000u);
}
__device__ __forceinline__ u32x4 pack8f(const float (&f)[8]) { u32x4 w; w.x = pk2(f[0], f[1]); w.y = pk2(f[2], f[3]); w.z = pk2(f[4], f[5]); w.w = pk2(f[6], f[7]); return w; }

#define XB_TMO      128
#define XB_XCNT(j)  (256  + 64 * (j))
#define XB_XSUB(j)  (1280 + 64 * (j))
#define XB_XGEN(j)  (2304 + 64 * (j))
#define XB_TOP      3328
#define XB_TOPGEN   3392
#define XCD_BAR_WORDS 3456
#define XB_SPIN_CAP (1u << 18)
#define LAS __attribute__((address_space(3)))

__device__ __forceinline__ unsigned xb_ld(unsigned* p)              { return __hip_atomic_load(p, __ATOMIC_RELAXED, __HIP_MEMORY_SCOPE_AGENT); }
__device__ __forceinline__ unsigned xb_add(unsigned* p, unsigned v) { return __hip_atomic_fetch_add(p, v, __ATOMIC_RELAXED, __HIP_MEMORY_SCOPE_AGENT); }
__device__ __forceinline__ unsigned xb_xcc_id() { return (unsigned)__builtin_amdgcn_s_getreg((3 << 11) | 20) & 0xFu; }
#define XB_SPIN(cond, bar) do { unsigned _sp = 0; while (cond) { __builtin_amdgcn_s_sleep(1); \
    if ((++_sp & 255u) == 0u) { if (xb_ld(&(bar)[XB_TMO])) break; if (_sp > XB_SPIN_CAP) { atomicAdd(&(bar)[XB_TMO], 1u); break; } } } } while (0)

struct XcdBarrier {
    unsigned* bar; unsigned x;
    volatile LAS unsigned* st;
};

__device__ __forceinline__ XcdBarrier xcd_barrier_post(unsigned* bar, volatile LAS unsigned* st, int xb_tid) {
    XcdBarrier b; b.bar = bar; b.x = xb_xcc_id(); b.st = st;
    if (xb_tid == 0) (void)xb_add(&bar[XB_XCNT(b.x)], 1u);
    return b;
}
__device__ __forceinline__ void xcd_barrier_complete(unsigned* bar, unsigned x, unsigned& nloc, unsigned& nx) {
    const unsigned G = gridDim.x * gridDim.y * gridDim.z;
    unsigned sum, cnt, mine, sp = 0u;
    for (;;) {
        sum = 0u; cnt = 0u; mine = 0u;
#pragma unroll
        for (unsigned j = 0; j < 16; ++j) { const unsigned c = xb_ld(&bar[XB_XCNT(j)]); sum += c; cnt += (c > 0u) ? 1u : 0u; mine = (j == x) ? c : mine; }
        if (sum == G) break;
        __builtin_amdgcn_s_sleep(1);
        if ((++sp & 255u) == 0u) { if (xb_ld(&bar[XB_TMO])) break; if (sp > XB_SPIN_CAP) { atomicAdd(&bar[XB_TMO], 1u); break; } }
    }
    nloc = mine > 0u ? mine : 1u; nx = cnt > 0u ? cnt : 1u;
}

__device__ __forceinline__ void xcd_barrier(const XcdBarrier& b, int xb_tid) {
    asm volatile("s_waitcnt vmcnt(0)" ::: "memory");
    __syncthreads();
    if (xb_tid == 0) {
        unsigned* bar = b.bar;
        __builtin_amdgcn_s_waitcnt(0);
        unsigned nloc = b.st[0], nx = b.st[1];
        if (nloc == 0u) { xcd_barrier_complete(bar, b.x, nloc, nx); b.st[0] = nloc; b.st[1] = nx; }
        const unsigned old = xb_add(&bar[XB_XSUB(b.x)], 1u);
        const unsigned gen = old / nloc;
        if (old + 1u == (gen + 1u) * nloc) {
            __builtin_amdgcn_fence(__ATOMIC_RELEASE, "agent");
            asm volatile("s_waitcnt vmcnt(0)" ::: "memory");
            const unsigned og = xb_add(&bar[XB_TOP], 1u);
            const unsigned tg = og / nx;
            if (og + 1u == (tg + 1u) * nx) xb_add(&bar[XB_TOPGEN], 1u);
            else XB_SPIN(xb_ld(&bar[XB_TOPGEN]) == tg, bar);
            __builtin_amdgcn_fence(__ATOMIC_ACQUIRE, "agent");
            xb_add(&bar[XB_XGEN(b.x)], 1u);
            asm volatile("s_waitcnt vmcnt(0)" ::: "memory");
        } else {
            XB_SPIN(xb_ld(&bar[XB_XGEN(b.x)]) == gen, bar);
            __builtin_amdgcn_fence(__ATOMIC_ACQUIRE, "agent");
            asm volatile("s_waitcnt vmcnt(0)" ::: "memory");
        }
    }
    __syncthreads();
}


#define MK_GRID_VARS int BID = blockIdx.x, NBLK = gridDim.x; asm volatile("" : "+s"(BID), "+s"(NBLK))
struct Args { const float* in[31]; float* out; unsigned char* ws; int ph_lo, ph_hi, flags, pad; };

namespace pg8 {
struct EpiResidLN {
    static constexpr bool PERM = true, AFTER_DRAIN = false;
    unsigned char* w; const float* lngn; const float* lnbn; int goff, scoff, shoff, vpar, slot;
    __device__ __forceinline__ void unit_begin(PG8_LAS unsigned char* lds, const Unit& u, int ui, int wid, int) const {
        int lane; asm volatile("v_mbcnt_lo_u32_b32 %0, -1, 0\n\tv_mbcnt_hi_u32_b32 %0, -1, %0" : "=&v"(lane));
        const float* MOD = (const float*)(w + WS_MOD); const float* stats = (const float*)(w + WS_ST); const int b = (u.pm * BM) >> 12;
        const float* src;
        if (wid == 0) src = MOD + goff + (size_t)b * 12288; else if (wid == 1) src = stats + 2 * MTOK + vpar; else if (wid == 2) src = stats + 2 * MTOK + vpar + 2048;
        else if (wid == 5) src = lngn; else if (wid == 6) src = lnbn; else src = MOD + scoff + (size_t)b * 12288;
        src += u.pn * BM + lane * 4;
        if (wid == 3 || wid == 4) src = stats + (size_t)(u.pm * BM + (wid - 3) * 128) * 2 + lane * 4;
        __builtin_amdgcn_global_load_lds((const unsigned*)src, (PG8_LAS unsigned*)(lds + EPI_LDS_OFF + (ui & 1) * EPI_LDS_PAR + wid * 1024), 16, 0, 0);
        if (wid == 0) __builtin_amdgcn_global_load_lds((const unsigned*)(MOD + shoff + (size_t)b * 12288 + u.pn * BM + lane * 4), (PG8_LAS unsigned*)(lds + EPI_LDS_OFF + (ui & 1) * EPI_LDS_PAR + 8 * 1024), 16, 0, 0);
    }
    __device__ __forceinline__ void operator()(const f32x4 (&acc_)[2][2][4][2], const Unit& u, int wr, int wc, int fr, int fq, PG8_LAS unsigned char* lds, int ui) const {
        f32x4 (&acc)[2][2][4][2] = const_cast<f32x4 (&)[2][2][4][2]>(acc_);
        const int row0 = u.pm * BM + wr * 64 + fr, col0 = u.pn * BM + wc * 32 + 8 * fq;
        bf16_t* X = (bf16_t*)(w + WS_XB); bf16_t* Hn = (bf16_t*)(w + WS_H); float* stats = (float*)(w + WS_ST);
        const PG8_LAS float* lv = (const PG8_LAS float*)(lds + EPI_LDS_OFF + (ui & 1) * EPI_LDS_PAR) + wc * 32 + 8 * fq;
#pragma unroll
        for (int ai = 0; ai < 2; ++ai) {
            u32x4 xb[4][2]; f32x2 st[4];
#pragma unroll
            for (int m = 0; m < 4; ++m) { const bf16_t* rowp = X + (size_t)(row0 + ai * HALF + m * 16) * 2048 + col0; xb[m][0] = *(const u32x4*)(rowp); xb[m][1] = *(const u32x4*)(rowp + HALF); }
            __builtin_amdgcn_sched_barrier(0);
#pragma unroll
            for (int m = 0; m < 4; ++m) st[m] = ((const PG8_LAS f32x2*)(lds + EPI_LDS_OFF + (ui & 1) * EPI_LDS_PAR + 3072))[ai * HALF + wr * 64 + m * 16 + fr];
#pragma unroll
            for (int bj = 0; bj < 2; ++bj) {
                const f32x4 g0 = *(const PG8_LAS f32x4*)(lv + bj * HALF), g1 = *(const PG8_LAS f32x4*)(lv + bj * HALF + 4);
                const f32x4 a0 = *(const PG8_LAS f32x4*)(lv + 256 + bj * HALF), a1 = *(const PG8_LAS f32x4*)(lv + 256 + bj * HALF + 4);
                const f32x4 b0 = *(const PG8_LAS f32x4*)(lv + 512 + bj * HALF), b1 = *(const PG8_LAS f32x4*)(lv + 512 + bj * HALF + 4);
#pragma unroll
                for (int m = 0; m < 4; ++m) {
                    bf16_t* rowp = X + (size_t)(row0 + ai * HALF + m * 16) * 2048 + col0 + bj * HALF; const float mean = st[m][0], rstd = st[m][1];
                    const u32x4 xw = xb[m][bj]; f32x4 x0, x1;
                    x0[0] = __uint_as_float(xw.x << 16); x0[1] = __uint_as_float(xw.x & 0xffff0000u); x0[2] = __uint_as_float(xw.y << 16); x0[3] = __uint_as_float(xw.y & 0xffff0000u);
                    x1[0] = __uint_as_float(xw.z << 16); x1[1] = __uint_as_float(xw.z & 0xffff0000u); x1[2] = __uint_as_float(xw.w << 16); x1[3] = __uint_as_float(xw.w & 0xffff0000u);
                    const f32x4 r0 = (x0 - mean) * rstd * a0 + b0 + g0 * acc[ai][bj][m][0];
                    const f32x4 r1 = (x1 - mean) * rstd * a1 + b1 + g1 * acc[ai][bj][m][1];
                    acc[ai][bj][m][0] = r0; acc[ai][bj][m][1] = r1;
                    u32x4 o; o.x = cvt_pk_bf16(r0[0], r0[1]); o.y = cvt_pk_bf16(r0[2], r0[3]); o.z = cvt_pk_bf16(r1[0], r1[1]); o.w = cvt_pk_bf16(r1[2], r1[3]);
                    *(u32x4*)rowp = o; } }
            __builtin_amdgcn_sched_barrier(0); }
        PG8_LAS float* red = (PG8_LAS float*)(lds + EPI_RED_OFF);
        PG8_LAS f32x2* ms = (PG8_LAS f32x2*)(lds + EPI_MS_OFF);
#pragma unroll
        for (int ai = 0; ai < 2; ++ai)
#pragma unroll
            for (int m = 0; m < 4; ++m) { float s = 0.f, q = 0.f;
#pragma unroll
                for (int bj = 0; bj < 2; ++bj)
#pragma unroll
                    for (int n = 0; n < 2; ++n) { const f32x4 v = acc[ai][bj][m][n]; s += (v[0] + v[1]) + (v[2] + v[3]); q += (v[0] * v[0] + v[1] * v[1]) + (v[2] * v[2] + v[3] * v[3]); }
                s = mk_sum_xor32(mk_sum_xor16(s)); q = mk_sum_xor32(mk_sum_xor16(q));
                if (fq == 0) { PG8_LAS float* d = red + ((ai * HALF + wr * 64 + m * 16 + fr) * 4 + wc) * 2; d[0] = s; d[1] = q; } }
        __syncthreads();
        const int t = (wr * 4 + wc) * 64 + fq * 16 + fr;
        if (t < 256) {
            float S = 0.f, Q = 0.f;
#pragma unroll
            for (int k = 0; k < 4; ++k) { S += red[(t * 4 + k) * 2]; Q += red[(t * 4 + k) * 2 + 1]; }
            Q = fmaxf(Q, 1e-30f);
            unsigned long long* part = (unsigned long long*)(w + WS_PART) + ((size_t)slot * 64 + u.pm) * 8 * 256;
            (void)__hip_atomic_exchange(part + u.pn * 256 + t, ((unsigned long long)__float_as_uint(Q) << 32) | (unsigned long long)__float_as_uint(S), __ATOMIC_RELAXED, __HIP_MEMORY_SCOPE_AGENT);
            float Ss = 0.f, Qs = 0.f; unsigned long long v[8];
            for (unsigned sp = 0; sp < (1u << 20); ++sp) {
                bool ok = true;
#pragma unroll
                for (int j = 0; j < 8; ++j) v[j] = __hip_atomic_load(part + j * 256 + t, __ATOMIC_RELAXED, __HIP_MEMORY_SCOPE_AGENT);
#pragma unroll
                for (int j = 0; j < 8; ++j) ok = ok && ((v[j] >> 32) != 0ull);
                if (__all(ok)) break;
                __builtin_amdgcn_s_sleep(1); }
#pragma unroll
            for (int j = 0; j < 8; ++j) { Ss += __uint_as_float((unsigned)v[j]); Qs += __uint_as_float((unsigned)(v[j] >> 32)); }
            const float mean = Ss * (1.f / 2048.f), var = fmaxf(Qs * (1.f / 2048.f) - mean * mean, 0.f), rstd = 1.f / sqrtf(var + LN_EPS);
            f32x2 mr; mr[0] = mean; mr[1] = rstd; ms[t] = mr;
            if (u.pn == 0) *(f32x2*)(stats + (size_t)(u.pm * BM + t) * 2) = mr;
        }
        __syncthreads();
#pragma unroll
        for (int bj = 0; bj < 2; ++bj) {
            f32x4 gs[2], bs[2];
#pragma unroll
            for (int n = 0; n < 2; ++n) { const f32x4 g = *(const PG8_LAS f32x4*)(lv + 5 * 256 + bj * HALF + n * 4), bb = *(const PG8_LAS f32x4*)(lv + 6 * 256 + bj * HALF + n * 4);
                const f32x4 s1 = 1.f + *(const PG8_LAS f32x4*)(lv + 7 * 256 + bj * HALF + n * 4), s0 = *(const PG8_LAS f32x4*)(lv + 8 * 256 + bj * HALF + n * 4);
                gs[n] = g * s1; bs[n] = bb * s1 + s0; }
#pragma unroll
            for (int ai = 0; ai < 2; ++ai)
#pragma unroll
                for (int m = 0; m < 4; ++m) { const f32x2 mr = ms[ai * HALF + wr * 64 + m * 16 + fr];
                    const f32x4 h0 = ((acc[ai][bj][m][0] - mr[0]) * mr[1]) * gs[0] + bs[0], h1 = ((acc[ai][bj][m][1] - mr[0]) * mr[1]) * gs[1] + bs[1];
                    u32x4 o; o.x = cvt_pk_bf16(h0[0], h0[1]); o.y = cvt_pk_bf16(h0[2], h0[3]); o.z = cvt_pk_bf16(h1[0], h1[1]); o.w = cvt_pk_bf16(h1[2], h1[3]);
                    *(u32x4*)(Hn + (size_t)(row0 + ai * HALF + m * 16) * 2048 + col0 + bj * HALF) = o; } }
    }
};
}

__device__ __forceinline__ void p0_transpose_item(const float* W, int K, int N, bf16_t* WT, int row_off, LAS float* scr, int item, int lane) {
    const int nblk = N / 32, kb = item / nblk, nb = item % nblk, k0 = 64 * kb, n0 = 32 * nb;
    int rbase = row_off + n0; if (row_off < 0) { const int half = n0 >= DFF ? 1 : 0, ch = n0 - half * DFF; rbase = 256 * (ch >> 7) + 128 * half + (ch & 127); }
#pragma unroll 8
    for (int i = 0; i < 32; ++i) { const int kk = 2 * i + (lane >> 5); scr[kk * 33 + (lane & 31)] = W[(size_t)(k0 + kk) * N + n0 + (lane & 31)]; }
    asm volatile("s_waitcnt lgkmcnt(0)" ::: "memory");
    const int c = lane & 7;
#pragma unroll
    for (int j = 0; j < 4; ++j) { const int n = (lane >> 3) + 8 * j; const LAS float* s = scr + (8 * c) * 33 + n;
        u32x4 o; o.x = pk2(s[0 * 33], s[1 * 33]); o.y = pk2(s[2 * 33], s[3 * 33]); o.z = pk2(s[4 * 33], s[5 * 33]); o.w = pk2(s[6 * 33], s[7 * 33]);
        *(u32x4*)(WT + (size_t)(rbase + n) * K + k0 + 8 * c) = o; }
    asm volatile("s_waitcnt lgkmcnt(0)" ::: "memory");
}
typedef const __attribute__((address_space(4))) Args CArgs;
__device__ __forceinline__ void phase_prologue(CArgs* ap, unsigned char* lds, int tid, int wid, int lane) {
    MK_GRID_VARS;
    unsigned char* ws = ap->ws;
    for (int t = BID; t < 192; t += NBLK) {
        float* cond = (float*)lds;
        for (int i = tid; i < 4 * DM; i += 512) { const float c = ap->in[1][i]; cond[i] = c / (1.f + __expf(-c)); }
        __syncthreads();
        const int l = t / 48, col0 = (t % 48) * 256;
        const float* wp = ap->in[2] + ((size_t)l * DM + wid * 256) * 12288 + col0 + 4 * lane;
        f32x4 acc[4] = {{0.f, 0.f, 0.f, 0.f}, {0.f, 0.f, 0.f, 0.f}, {0.f, 0.f, 0.f, 0.f}, {0.f, 0.f, 0.f, 0.f}};
#pragma unroll 8
        for (int k = 0; k < 256; ++k) { const f32x4 wv = *(const f32x4*)(wp + (size_t)k * 12288); const int kk = wid * 256 + k;
#pragma unroll
            for (int b = 0; b < 4; ++b) acc[b] += cond[b * DM + kk] * wv; }
        float* red = (float*)(lds + 32768);
#pragma unroll
        for (int b = 0; b < 4; ++b) *(f32x4*)(red + ((wid * 4 + b) * 256 + 4 * lane)) = acc[b];
        __syncthreads();
        float* mod = (float*)(ws + WS_MOD);
        for (int idx = tid; idx < 1024; idx += 512) { const int b = idx >> 8, col = idx & 255; float s = ap->in[3][l * 12288 + col0 + col];
#pragma unroll
            for (int w = 0; w < 8; ++w) s += red[(w * 4 + b) * 256 + col];
            mod[(size_t)(l * 4 + b) * 12288 + col0 + col] = s; }
        __syncthreads();
    }
    LAS float* scr = (LAS float*)((LAS unsigned char*)lds + wid * 16384);
    const int gw = BID * 8 + wid, NGW = NBLK * 8;
    bf16_t* wfox0 = (bf16_t*)(ws + WS_WFOX); bf16_t* wfox1 = (bf16_t*)(ws + WS_WFOX + 40 * MiB);
    bf16_t* wgla = (bf16_t*)(ws + WS_WGLA); bf16_t* wconv = (bf16_t*)(ws + WS_WCONV);
    bf16_t* wup = (bf16_t*)(ws + WS_WUP); bf16_t* wdn = (bf16_t*)(ws + WS_WDOWN);
    constexpr int I_DD = (DM / 64) * (DM / 32), I_DH = (DM / 64) * (1024 / 32), I_D3 = (DM / 64) * (6144 / 32), I_UP = (DM / 64) * (11264 / 32), I_DN = (DFF / 64) * (DM / 32);
    constexpr int NITEMS = 10 * I_DD + 2 * I_DH + 3 * I_DD + I_D3 + I_DD + 4 * I_UP + 4 * I_DN;
    constexpr size_t DD = (size_t)DM * DM;
#define TJOB(SRC, KK, NN, DST, ROFF, CNT) { if (r < (CNT)) { p0_transpose_item((SRC), (KK), (NN), (DST), (ROFF), scr, r, lane); continue; } r -= (CNT); }
    for (int it = gw; it < NITEMS; it += NGW) {
        int r = it;
        TJOB(ap->in[8], DM, DM, wfox0, 0, I_DD) TJOB(ap->in[9], DM, DM, wfox0, 2048, I_DD) TJOB(ap->in[10], DM, DM, wfox0, 4096, I_DD) TJOB(ap->in[11], DM, DM, wfox0, 6144, I_DD)
        TJOB(ap->in[14], DM, DM, wfox0 + (size_t)8192 * DM, 0, I_DD)
        TJOB(ap->in[8] + DD, DM, DM, wfox1, 0, I_DD) TJOB(ap->in[9] + DD, DM, DM, wfox1, 2048, I_DD) TJOB(ap->in[10] + DD, DM, DM, wfox1, 4096, I_DD) TJOB(ap->in[11] + DD, DM, DM, wfox1, 6144, I_DD)
        TJOB(ap->in[14] + DD, DM, DM, wfox1 + (size_t)8192 * DM, 0, I_DD)
        TJOB(ap->in[15], DM, 1024, wgla, 0, I_DH) TJOB(ap->in[16], DM, 1024, wgla, 1024, I_DH) TJOB(ap->in[17], DM, DM, wgla, 2048, I_DD) TJOB(ap->in[21], DM, DM, wgla, 4096, I_DD)
        TJOB(ap->in[23], DM, DM, wgla + (size_t)6144 * DM, 0, I_DD)
        TJOB(ap->in[24], DM, 6144, wconv, 0, I_D3) TJOB(ap->in[26], DM, DM, wconv + (size_t)6144 * DM, 0, I_DD)
        TJOB(ap->in[27], DM, 11264, wup, -1, I_UP) TJOB(ap->in[27] + (size_t)1 * DM * 11264, DM, 11264, wup + (size_t)1 * 11264 * DM, -1, I_UP)
        TJOB(ap->in[27] + (size_t)2 * DM * 11264, DM, 11264, wup + (size_t)2 * 11264 * DM, -1, I_UP) TJOB(ap->in[27] + (size_t)3 * DM * 11264, DM, 11264, wup + (size_t)3 * 11264 * DM, -1, I_UP)
        TJOB(ap->in[30], DFF, DM, wdn, 0, I_DN) TJOB(ap->in[30] + (size_t)1 * DFF * DM, DFF, DM, wdn + (size_t)1 * DM * DFF, 0, I_DN)
        TJOB(ap->in[30] + (size_t)2 * DFF * DM, DFF, DM, wdn + (size_t)2 * DM * DFF, 0, I_DN) TJOB(ap->in[30] + (size_t)3 * DFF * DM, DFF, DM, wdn + (size_t)3 * DM * DFF, 0, I_DN)
    }
#undef TJOB
}

template <bool SRC_BF, bool SK>
__device__ __forceinline__ void phase_lnmod(const void* src, float* X, bf16_t* H, bool do_ln, bool do_mod, const float* lng, const float* lnb,
                                            const float* sc, const float* sh, int sk_mode, const float* skW, const float* skB, float* sk_out, float* stats,
                                            unsigned char* lds, int tid, int wid, int lane, int vpar = 0) {
    MK_GRID_VARS;
    if constexpr (SK) {
        f32x4* Wl = (f32x4*)lds;
        for (int idx = tid; idx < 8192; idx += 512) { const int ln = idx & 63, q = (idx >> 6) & 3, i = (idx >> 8) & 3, j = idx >> 10;
            Wl[idx] = *(const f32x4*)(skW + (size_t)(256 * j + 4 * ln + i) * 16 + 4 * q); }
        __syncthreads();
    }
    if (stats && BID == 0) for (int i = tid; i < DM; i += 512) { stats[2 * MTOK + vpar + i] = DN_ALPHA * (do_ln ? lng[i] : 1.f); stats[2 * MTOK + vpar + DM + i] = DN_ALPHA * (do_ln ? lnb[i] : 0.f); }
    const int nw = NBLK * 8, gw = BID * 8 + wid, R = (MTOK + nw - 1) / nw, row_begin = gw * R, row_end = (row_begin + R < MTOK) ? row_begin + R : MTOK;
    if (row_begin < row_end) {
        constexpr bool DIST2 = SRC_BF && !SK;
        f32x4 gs[8], bs[8]; f32x4 vn[8]; u32x2 vbA[8], vbB[8];
#define LN_LOAD_ROW(r, VB) do { if constexpr (SRC_BF) { const u32x2* xr = (const u32x2*)((const bf16_t*)src + (size_t)(r) * DM) + lane; _Pragma("unroll") for (int j = 0; j < 8; ++j) VB[j] = xr[64 * j]; } \
                            else { const f32x4* xr = (const f32x4*)((const float*)src + (size_t)(r) * DM) + lane; _Pragma("unroll") for (int j = 0; j < 8; ++j) vn[j] = xr[64 * j]; } } while (0)
#define LN_ROW(row_, v, VB) do { float s_ = 0.f;                                                                                                                     \
            _Pragma("unroll") for (int j = 0; j < 8; ++j) {                                                                                                      \
                if constexpr (SRC_BF) { v[j][0] = __uint_as_float(VB[j].x << 16); v[j][1] = __uint_as_float(VB[j].x & 0xffff0000u); v[j][2] = __uint_as_float(VB[j].y << 16); v[j][3] = __uint_as_float(VB[j].y & 0xffff0000u); } \
                else v[j] = vn[j];                                                                                                                               \
                s_ += (v[j][0] + v[j][1]) + (v[j][2] + v[j][3]); }                                                                                               \
            if constexpr (DIST2) { if ((row_) + 2 < row_lim) LN_LOAD_ROW((row_) + 2, VB); } else { if ((row_) + 1 < row_lim) LN_LOAD_ROW((row_) + 1, VB); }                                                                                                   \
            float mean_ = 0.f, rstd_ = 1.f;                                                                                                                      \
            if (do_ln) {                                                                                                                                         \
                mean_ = wave_sum(s_) * (1.f / DM); float s2_ = 0.f;                                                                                              \
                _Pragma("unroll") for (int j = 0; j < 8; ++j) { v[j] = v[j] - mean_; s2_ += (v[j][0] * v[j][0] + v[j][1] * v[j][1]) + (v[j][2] * v[j][2] + v[j][3] * v[j][3]); } \
                rstd_ = 1.f / sqrtf(wave_sum(s2_) * (1.f / DM) + LN_EPS);                                                                                        \
                _Pragma("unroll") for (int j = 0; j < 8; ++j) v[j] = (v[j] * rstd_) * gs[j] + bs[j];                                                             \
            } else {                                                                                                                                             \
                _Pragma("unroll") for (int j = 0; j < 8; ++j) v[j] = v[j] * gs[j] + bs[j];                                                                       \
            }                                                                                                                                                    \
            if (stats) { if (lane == 0) { f32x2 st; st[0] = mean_; st[1] = rstd_; *(f32x2*)(stats + (size_t)(row_) * 2) = st; } }                                \
            else { f32x4* xo = (f32x4*)(X + (size_t)(row_) * DM) + lane; _Pragma("unroll") for (int j = 0; j < 8; ++j) xo[64 * j] = v[j]; }                      \
            if (do_mod) { u32x2* ho = (u32x2*)(H + (size_t)(row_) * DM) + lane;                                                                                  \
                _Pragma("unroll") for (int j = 0; j < 8; ++j) { u32x2 w; w.x = pk2(v[j][0], v[j][1]); w.y = pk2(v[j][2], v[j][3]); ho[64 * j] = w; } } } while (0)
        if (!do_mod) {
#pragma unroll
            for (int j = 0; j < 8; ++j) { gs[j] = ((const f32x4*)lng)[64 * j + lane]; bs[j] = ((const f32x4*)lnb)[64 * j + lane]; } }
        for (int seg = row_begin; seg < row_end; ) {
            const int cur_b = seg >> 12, seg_lim = (cur_b + 1) << 12, row_lim = seg_lim < row_end ? seg_lim : row_end;
            if (do_mod) {
                const f32x4* sc4 = (const f32x4*)(sc + (size_t)cur_b * 12288) + lane; const f32x4* sh4 = (const f32x4*)(sh + (size_t)cur_b * 12288) + lane;
#pragma unroll
                for (int j = 0; j < 8; ++j) { const f32x4 s1 = 1.f + sc4[64 * j], s0 = sh4[64 * j];
                    if (do_ln) { gs[j] = ((const f32x4*)lng)[64 * j + lane] * s1; bs[j] = ((const f32x4*)lnb)[64 * j + lane] * s1 + s0; } else { gs[j] = s1; bs[j] = s0; } } }
            LN_LOAD_ROW(seg, vbA);
            if constexpr (DIST2) { if (seg + 1 < row_lim) LN_LOAD_ROW(seg + 1, vbB); }
            if constexpr (!SK) {
                for (int row = seg; row < row_lim; row += 2) { f32x4 v[8]; LN_ROW(row, v, vbA); if (row + 1 < row_lim) { if constexpr (DIST2) { LN_ROW(row + 1, v, vbB); } else { LN_ROW(row + 1, v, vbA); } } }
            } else {
                for (int row = seg; row < row_lim; row += 2) {
                    f32x4 va[8], vc[8];
                    LN_ROW(row, va, vbA);
                    const bool two = row + 1 < row_lim;
                    if (two) { LN_ROW(row + 1, vc, vbA); }
                    else {
#pragma unroll
                        for (int j = 0; j < 8; ++j) vc[j] = va[j]; }
                    const f32x4* Wl = (const f32x4*)lds + lane;
                    f32x2 aa[8], ac[8];
#pragma unroll
                    for (int n = 0; n < 8; ++n) { aa[n][0] = 0.f; aa[n][1] = 0.f; ac[n] = aa[n]; }
#pragma unroll
                    for (int j = 0; j < 8; ++j)
#pragma unroll
                        for (int i = 0; i < 4; ++i) { f32x2 ha, hc; ha[0] = va[j][i]; ha[1] = va[j][i]; hc[0] = vc[j][i]; hc[1] = vc[j][i];
#pragma unroll
                            for (int q = 0; q < 4; ++q) { const f32x4 w = Wl[((j * 4 + i) * 4 + q) * 64]; f32x2 w01, w23; w01[0] = w[0]; w01[1] = w[1]; w23[0] = w[2]; w23[1] = w[3];
                                aa[2 * q] = __builtin_elementwise_fma(ha, w01, aa[2 * q]); aa[2 * q + 1] = __builtin_elementwise_fma(ha, w23, aa[2 * q + 1]);
                                ac[2 * q] = __builtin_elementwise_fma(hc, w01, ac[2 * q]); ac[2 * q + 1] = __builtin_elementwise_fma(hc, w23, ac[2 * q + 1]); }
                            if (i == 3) __builtin_amdgcn_sched_barrier(0); }
                    float mine_a = 0.f, mine_c = 0.f;
#pragma unroll
                    for (int n = 0; n < 16; ++n) { const float ta = wave_sum(aa[n >> 1][n & 1]), tc = wave_sum(ac[n >> 1][n & 1]); mine_a = (lane == n) ? ta : mine_a; mine_c = (lane == n) ? tc : mine_c; }
                    if (lane < 16) { float bias = 0.f; if (sk_mode == 1) { bias = skB[lane]; mine_a = log_sigmoid(mine_a + bias); mine_c = log_sigmoid(mine_c + bias); }
                        if (sk_mode == 1) { float* so = sk_out + ((size_t)((row >> 12) * 16 + lane) << 12) + (row & 4095);
                            so[0] = mine_a; if (two) so[1] = mine_c; }
                        else { sk_out[(size_t)row * 16 + lane] = mine_a; if (two) sk_out[(size_t)(row + 1) * 16 + lane] = mine_c; } }
                }
            }
            seg = row_lim;
        }
#undef LN_ROW
    }
}

#undef LN_LOAD_ROW
__device__ __forceinline__ void fox_cumsum(const float* logf  , float* FB  , int wid, int lane) {
    MK_GRID_VARS;
    for (int u = BID * 8 + wid; u < 64; u += NBLK * 8) {
        const int b = u >> 4, hh = u & 15;
        const float* lf = logf + (size_t)u * SEQ + lane * 64; (void)b; (void)hh;
        float v[64]; float s = 0.f;
#pragma unroll
        for (int t = 0; t < 64; t += 4) { const f32x4 x = *(const f32x4*)(lf + t); v[t] = x[0]; v[t + 1] = x[1]; v[t + 2] = x[2]; v[t + 3] = x[3]; }
#pragma unroll
        for (int t = 0; t < 64; ++t) { s += v[t]; v[t] = s; }
        float pre = s;
#pragma unroll
        for (int o = 1; o < 64; o <<= 1) { const float t = mk_shfl_up(pre, o); if (lane >= o) pre += t; }
        const float excl = pre - s;
        float* out = FB + (size_t)u * SEQ + lane * 64;
#pragma unroll
        for (int t = 0; t < 64; t += 4) { f32x4 o4; o4[0] = -(excl + v[t]) * 11.313708499f; o4[1] = -(excl + v[t + 1]) * 11.313708499f; o4[2] = -(excl + v[t + 2]) * 11.313708499f; o4[3] = -(excl + v[t + 3]) * 11.313708499f;
            *(f32x4*)(out + t) = o4; }
    }
}

constexpr float T_SKIP = 24.f;
__device__ __forceinline__ void phase_fox_attn(const bf16_t* PROJ, const float* FB, const float* N2P, bf16_t* O, char* lds, int tid) {
    MK_GRID_VARS;
    using namespace fx;
    typedef BlockRef<bf16, bf16> Ref;
    const int total = 512, stride = NBLK, lane = tid & 63, wid = __builtin_amdgcn_readfirstlane(tid >> 6);
    float* kmx = (float*)(lds + 2 * SHM_V + 2 * SHM_K);
    float* qmx = kmx + 64;
    int* jlo_l = (int*)(lds + LDS_BYTES);
    int* tab = (int*)(lds + LDS_BYTES + 64);
    const bool use_tab = NBLK == 256;
    if (use_tab) {
        if (wid == 0) {
            const float wv = FB[(size_t)lane * SEQ + SEQ - 1];
            const float Wh = mk_sum_xor32(mk_sum_xor16(wv));
            int rank = 0;
#pragma unroll
            for (int hp = 0; hp < 16; ++hp) { const float o = __uint_as_float(__builtin_amdgcn_readlane(__float_as_uint(Wh), hp)); rank += (o < Wh || (o == Wh && hp < (lane & 15))) ? 1 : 0; }
            const int x = BID & 7;
            const unsigned long long mA = __ballot(rank == x && lane < 16), mB = __ballot(rank == 15 - x && lane < 16);
            const int hA = (int)__builtin_ctzll(mA), hB = (int)__builtin_ctzll(mB);
            const int r = lane & 7, bh = ((lane >> 3) & 3) * 16 + ((lane >> 5) ? hB : hA);
            const float wi = __builtin_bit_cast(float, __builtin_amdgcn_ds_bpermute(bh << 2, __builtin_bit_cast(int, wv)));
            const float Wt = (T_SKIP + 30.f) * (4095.f / 64.f) / (wi * SCALE);
            const float est = fminf(4.f * r, Wt) + fminf(4.f * (15 - r), Wt);
            int rk = 0;
#pragma unroll
            for (int o = 0; o < 64; ++o) { const float e = __uint_as_float(__builtin_amdgcn_readlane(__float_as_uint(est), o)); rk += (e > est || (e == est && o < lane)) ? 1 : 0; }
            const int j = BID >> 3;
            const int i1 = (int)__builtin_ctzll(__ballot(rk == j)), i2 = (int)__builtin_ctzll(__ballot(rk == 63 - j));
            const int t0 = __builtin_amdgcn_readlane(bh, i1), t1 = __builtin_amdgcn_readlane(r, i1), t2 = __builtin_amdgcn_readlane(bh, i2), t3 = __builtin_amdgcn_readlane(r, i2);
            if (lane == 0) { tab[0] = t0; tab[1] = t1; tab[2] = t2; tab[3] = t3; }
        }
        __syncthreads();
    }
    {   int idx = 0;
        for (int Lx = BID; Lx < total; Lx += stride, ++idx) {
            int r, bh;
            if (use_tab) { bh = tab[idx * 2]; r = tab[idx * 2 + 1]; }
            else { const int xcd = Lx & 7, k = Lx >> 3, gi = k >> 3; r = (gi & 4) ? 7 - (k & 7) : (k & 7); bh = (gi * 8 + xcd) ^ ((gi & 4) ? 8 : 0); }
            const f32x4* kn = (const f32x4*)(N2P + ((size_t)(64 + bh) * SEQ) * 4);
            const f32x4* qn = (const f32x4*)(N2P + ((size_t)bh * SEQ) * 4);
            float km = 0.f;
#pragma unroll
            for (int e = 0; e < 8; ++e) { const f32x4 v = kn[tid * 8 + e]; km = fmaxf(km, (v[0] + v[1]) + (v[2] + v[3])); }
            km = fmaxf(km, mk_shfl_xor(km, 1)); km = fmaxf(km, mk_shfl_xor(km, 2)); km = fmaxf(km, mk_shfl_xor(km, 4));
            if ((tid & 7) == 0) kmx[tid >> 3] = km;
            for (int pass = 0; pass < 2; ++pass) {
                const int qb = pass ? 15 - r : r, P0 = qb * QB;
                __syncthreads();
                float qm = 0.f;
                if (tid < 256) { const f32x4 v = qn[P0 + tid]; qm = (v[0] + v[1]) + (v[2] + v[3]); }
#pragma unroll
                for (int o = 1; o < 64; o <<= 1) qm = fmaxf(qm, mk_shfl_xor(qm, o));
                if (lane == 0) qmx[wid] = qm;
                __syncthreads();
                if (wid == 0) {
                    const float Q = sqrtf(fmaxf(fmaxf(qmx[0], qmx[1]), fmaxf(qmx[2], qmx[3])));
                    const int jd = P0 / KVBLK;
                    const float Kd = sqrtf(fmaxf(fmaxf(kmx[jd], kmx[jd + 1]), fmaxf(kmx[jd + 2], kmx[jd + 3])));
                    const float* fb = FB + (size_t)bh * SEQ;
                    const float bound = 1.02f * Q * (sqrtf(kmx[lane]) + Kd) + (fb[lane * KVBLK + KVBLK - 1] - fb[P0]);
                    const bool keep = lane < jd && !(bound < -T_SKIP / SCALE);
                    const unsigned long long mask = __ballot(keep);
                    const int jlo = mask ? (int)__builtin_ctzll(mask) : jd;
                    if (lane == 0) jlo_l[idx * 2 + pass] = jlo;
                }
            }
            __syncthreads();
        }
    }
    int L = BID;
    if (L < total) {
        auto mkref = [&](int Lx, int pass, int slot) -> Ref {
            int r, bh;
            if (use_tab) { bh = __builtin_amdgcn_readfirstlane(tab[slot * 2]); r = __builtin_amdgcn_readfirstlane(tab[slot * 2 + 1]); }
            else { const int xcd = Lx & 7, k = Lx >> 3, gi = k >> 3; r = (gi & 4) ? 7 - (k & 7) : (k & 7); bh = (gi * 8 + xcd) ^ ((gi & 4) ? 8 : 0); }
            const int qb = pass ? 15 - r : r;
            const int b = bh >> 4, h = bh & 15; const size_t row0 = (size_t)b * SEQ + (size_t)qb * QB;
            Ref rf; const bf16* P = (const bf16*)PROJ; const size_t TS = (size_t)64 * SEQ * D, hb = (size_t)bh * SEQ * D;
            rf.Q = P + hb + (size_t)qb * QB * D; rf.K = P + TS + hb; rf.V = P + 2 * TS + hb; rf.G = P + 3 * TS + hb + (size_t)qb * QB * D;
            rf.O = (bf16*)O + row0 * OS + h * D; rf.Bias = FB + (size_t)bh * SEQ; rf.P0 = qb * QB; rf.JLO = __builtin_amdgcn_readfirstlane(jlo_l[slot * 2 + pass]); return rf; };
        int pass = 0, slot = 0; Ref cur = mkref(L, 0, 0);
        Seam<bf16> S;
        causal_swa_prime<bf16, bf16>(cur, SEQ, lds, S, tid);
        for (;;) {
            const bool more_pass = pass == 0, more_item = L + stride < total, last = !more_pass && !more_item;
            int passn = pass + 1, Ln = L, slotn = slot;
            if (!more_pass) { passn = 0; Ln = more_item ? L + stride : L; slotn = more_item ? slot + 1 : slot; }
            const Ref nxt = last ? cur : mkref(Ln, passn, slotn);
            causal_swa_block<bf16, bf16>(cur, nxt, SEQ, SEQ, lds, S, tid);
            if (last) break;
            cur = nxt; pass = passn; L = Ln; slot = slotn;
        }
    }
}

__device__ __forceinline__ void phase_gla_prep(const bf16_t* PROJ, const float* A1, const float* wa2, const float* ba, bf16_t* QD, bf16_t* QDF, bf16_t* KI, bf16_t* KDT, bf16_t* VT, float* ELAST,
                                               unsigned char* lds, int tid) {
    MK_GRID_VARS;
    float* a1l = (float*)lds;
    for (int u = BID; u < 512; u += NBLK) {
        const int b = u >> 7, n = (u >> 1) & 63, p = u & 1; const size_t row0 = (size_t)b * SEQ + n * 64;
        __syncthreads();
        for (int i = tid; i < 1024; i += 512) a1l[i] = A1[row0 * 16 + i];
        __syncthreads();
        { const int hh = 2 * p + (tid >> 8), d = tid & 255, col = hh * 256 + d, bh = b * 4 + hh;
          float w2[16];
#pragma unroll
          for (int r = 0; r < 16; ++r) w2[r] = wa2[r * 1024 + col];
          const float bav = ba[col];
          const bf16_t* qp = PROJ + row0 * 6144 + col; const bf16_t* kp = qp + 1024;
          bf16_t* qdp = QD + row0 * 1024 + col; bf16_t* kip = KI + row0 * 1024 + col;
          bf16_t* qfp; { const int dkl = d & 31, x = dkl & 15; qfp = QDF + ((((((size_t)bh * 64 + n) * 8 + (d >> 5)) * 2) * 2 + (dkl >> 4)) * 64 + ((x >> 2) & 1) * 32) * 8 + 4 * (x >> 3) + (x & 3); }
          float kif[64]; float cb = 0.f;
#pragma unroll
          for (int jj = 0; jj < 64; ++jj) {
              const f32x4* ar = (const f32x4*)(a1l + jj * 16); float ga = bav;
#pragma unroll
              for (int q = 0; q < 4; ++q) { const f32x4 av = ar[q]; ga += av[0] * w2[4 * q] + av[1] * w2[4 * q + 1] + av[2] * w2[4 * q + 2] + av[3] * w2[4 * q + 3]; }
              cb += log_sigmoid(ga) * 0.0625f;
              const float qv = bf2f(qp[(size_t)jj * 6144]) * 0.0625f, kv = bf2f(kp[(size_t)jj * 6144]);
              const float e = __expf(cb), ei = __expf(-cb), kin = kv * ei;
              const unsigned short qb = f2bf(qv * e); qdp[(size_t)jj * 1024] = qb; qfp[((jj >> 5) * 128 + (jj & 31)) * 8] = qb; kip[(size_t)jj * 1024] = f2bf(kin); kif[jj] = kin;
          }
          const float el = __expf(cb);
          ELAST[((size_t)bh * 64 + n) * 256 + d] = el;
          u32x4* kd = (u32x4*)KDT + ((((size_t)bh * 64 + n) * 8 + (d >> 5)) * 4) * 64 + (d & 31);
#pragma unroll
          for (int g = 0; g < 8; ++g) { u32x4 w; w.x = pk2(kif[8 * g] * el, kif[8 * g + 1] * el); w.y = pk2(kif[8 * g + 2] * el, kif[8 * g + 3] * el);
              w.z = pk2(kif[8 * g + 4] * el, kif[8 * g + 5] * el); w.w = pk2(kif[8 * g + 6] * el, kif[8 * g + 7] * el); kd[(g >> 1) * 64 + (g & 1) * 32] = w; } }
        { const int c2 = 2 * tid, hh = 2 * p + (c2 >> 9), dv = c2 & 511, bh = b * 4 + hh;
          const unsigned* vp = (const unsigned*)(PROJ + row0 * 6144 + 2048 + hh * 512 + dv);
          unsigned vv[64];
#pragma unroll
          for (int jj = 0; jj < 64; ++jj) vv[jj] = vp[(size_t)jj * 3072];
          u32x4* vt0 = (u32x4*)VT + ((((size_t)bh * 64 + n) * 16 + (dv >> 5)) * 4) * 64 + (dv & 31); u32x4* vt1 = vt0 + 1;
#pragma unroll
          for (int g = 0; g < 8; ++g) { u32x4 lo, hi;
              lo.x = (vv[8 * g] & 0xffffu) | (vv[8 * g + 1] << 16); lo.y = (vv[8 * g + 2] & 0xffffu) | (vv[8 * g + 3] << 16); lo.z = (vv[8 * g + 4] & 0xffffu) | (vv[8 * g + 5] << 16); lo.w = (vv[8 * g + 6] & 0xffffu) | (vv[8 * g + 7] << 16);
              hi.x = (vv[8 * g] >> 16) | (vv[8 * g + 1] & 0xffff0000u); hi.y = (vv[8 * g + 2] >> 16) | (vv[8 * g + 3] & 0xffff0000u); hi.z = (vv[8 * g + 4] >> 16) | (vv[8 * g + 5] & 0xffff0000u); hi.w = (vv[8 * g + 6] >> 16) | (vv[8 * g + 7] & 0xffff0000u);
              vt0[(g >> 1) * 64 + (g & 1) * 32] = lo; vt1[(g >> 1) * 64 + (g & 1) * 32] = hi; } }
    }
}
struct ScanOps { bf16x8 qa[2][2], ka[4], vb[4]; f32x4 ev[4]; };
__device__ __forceinline__ void scan_load(ScanOps& o, const char* qd_u, const char* kdt_u, const char* vt_u, const char* el_u, unsigned qoff, unsigned koff, unsigned eoff) {
#pragma unroll
    for (int mb = 0; mb < 2; ++mb)
#pragma unroll
        for (int ks = 0; ks < 2; ++ks) o.qa[mb][ks] = *(const bf16x8*)(qd_u + (mb * 2 + ks) * 1024 + qoff);
#pragma unroll
    for (int ks = 0; ks < 4; ++ks) { o.ka[ks] = *(const bf16x8*)(kdt_u + ks * 1024 + koff); o.vb[ks] = *(const bf16x8*)(vt_u + ks * 1024 + koff); }
#pragma unroll
    for (int g = 0; g < 4; ++g) o.ev[g] = *(const f32x4*)(el_u + g * 32 + eoff);
}
__device__ __forceinline__ void phase_gla_scan(const bf16_t* QDF, const bf16_t* KDT, const bf16_t* VT, const float* ELAST, bf16_t* OINT, unsigned char* lds, int tid, int wid, int lane) {
    MK_GRID_VARS;
    const int l32 = lane & 31, hi = lane >> 5;
    float* buf = (float*)lds;
    for (int u = BID; u < 256; u += NBLK) {
        const int xcd = u & 7, kk = u >> 3, bh = xcd * 2 + (kk >> 4), s = kk & 15, b = bh >> 2, hh = bh & 3;
        f32x16 S;
#pragma unroll
        for (int r = 0; r < 16; ++r) S[r] = 0.f;
        const char* qd_u0 = (const char*)((const u32x4*)QDF + ((((size_t)bh * 64 * 8 + wid) * 2) * 2) * 64);
        const char* kdt_u0 = (const char*)((const u32x4*)KDT + (((size_t)bh * 64 * 8 + wid) * 4) * 64);
        const char* vt_u0 = (const char*)((const u32x4*)VT + (((size_t)bh * 64 * 16 + s) * 4) * 64);
        const char* el_u0 = (const char*)(ELAST + (size_t)bh * 64 * 256 + 32 * wid);
        const unsigned koff = (unsigned)lane * 16u, qoff = koff, eoff = (unsigned)(4 * hi) * 4u;
#define SCAN_LOAD(c, n_) scan_load((c), qd_u0 + (size_t)(n_) * 8 * 4096, kdt_u0 + (size_t)(n_) * 256 * 64 * 2, vt_u0 + (size_t)(n_) * 512 * 64 * 2, el_u0 + (size_t)(n_) * 256 * 4, qoff, koff, eoff)
#define SCAN_STEP(c, n_) do { bf16x8 sb[2];                                                                                                                   \
            _Pragma("unroll") for (int ks = 0; ks < 2; ++ks) { u32x4 w; w.x = pk2(S[8 * ks], S[8 * ks + 1]); w.y = pk2(S[8 * ks + 2], S[8 * ks + 3]); w.z = pk2(S[8 * ks + 4], S[8 * ks + 5]); w.w = pk2(S[8 * ks + 6], S[8 * ks + 7]); \
                sb[ks] = *reinterpret_cast<bf16x8*>(&w); }                                                                                                     \
            f32x16 op[2];                                                                                                                                      \
            _Pragma("unroll") for (int mb = 0; mb < 2; ++mb) {                                                                                                 \
                _Pragma("unroll") for (int r = 0; r < 16; ++r) op[mb][r] = 0.f;                                                                                \
                _Pragma("unroll") for (int ks = 0; ks < 2; ++ks) op[mb] = __builtin_amdgcn_mfma_f32_32x32x16_bf16((c).qa[mb][ks], sb[ks], op[mb], 0, 0, 0); }  \
            _Pragma("unroll") for (int r = 0; r < 16; ++r) S[r] *= (c).ev[r >> 2][r & 3];                                                                      \
            _Pragma("unroll") for (int ks = 0; ks < 4; ++ks) S = __builtin_amdgcn_mfma_f32_32x32x16_bf16((c).ka[ks], (c).vb[ks], S, 0, 0, 0);                   \
            asm volatile("" : "+v"(S), "+v"(op[0]), "+v"(op[1]));     \
            __builtin_amdgcn_sched_barrier(0); SCAN_LOAD((c), (n_) + 2 < 64 ? (n_) + 2 : 63); __builtin_amdgcn_sched_barrier(0);                                                                 \
            float* pb = buf + ((size_t)((n_) & 1) * 8 + wid) * 2048 + (4 * hi) * 32 + l32;     \
            float* pbe = pb + hi * 32; float* pbo = pb - hi * 32;                                                                                              \
            _Pragma("unroll") for (int mb = 0; mb < 2; ++mb)                                                                                                   \
                _Pragma("unroll") for (int r = 0; r < 16; ++r) ((r & 1) ? pbo : pbe)[(32 * mb + (r & 3) + 8 * (r >> 2)) * 32] = op[mb][r];                     \
            asm volatile("s_waitcnt lgkmcnt(0)" ::: "memory"); __builtin_amdgcn_s_barrier(); asm volatile("" ::: "memory");     \
            { const int tok = tid >> 3, dv = (tid & 7) * 4;                                                                                                    \
              const float* rb = buf + (size_t)((n_) & 1) * 8 * 2048 + (tok ^ ((tok >> 2) & 1)) * 32 + dv; f32x4 acc = *(const f32x4*)rb;                       \
              _Pragma("unroll") for (int w = 1; w < 8; ++w) acc += *(const f32x4*)(rb + w * 2048);                                                             \
              u32x2 ow; ow.x = pk2(acc[0], acc[1]); ow.y = pk2(acc[2], acc[3]);                                                                                      \
              *(u32x2*)(OINT + ((size_t)b * SEQ + (n_) * 64 + tok) * DM + hh * 512 + 32 * s + dv) = ow; } } while (0)
        ScanOps oa, ob; SCAN_LOAD(oa, 0); SCAN_LOAD(ob, 1);
        for (int n = 0; n < 64; n += 2) { SCAN_STEP(oa, n); SCAN_STEP(ob, n + 1); }
#undef SCAN_STEP
#undef SCAN_LOAD
        __syncthreads();
    }
}
#define MK_LASU __attribute__((address_space(3))) unsigned
__device__ __forceinline__ void phase_gla_intra(const bf16_t* PROJ, const bf16_t* QD, const bf16_t* KI, const bf16_t* VT, const bf16_t* OINT, const float* normg, bf16_t* OG,
                                                unsigned char* lds, int tid, int wid, int lane) {
    MK_GRID_VARS;
    bf16_t* attl = (bf16_t*)lds;
    float* rss = (float*)(lds + 64 * 72 * 2);
    float* rstdl = rss + 8 * 64;
    constexpr int RG_OFF = 16384;
    const int l16 = lane & 15, q4 = lane >> 4, l32 = lane & 31, hi = lane >> 5;
    for (int u = BID; u < 1024; u += NBLK) {
        const int b = u >> 8, n = (u >> 2) & 63, hh = u & 3, bh = b * 4 + hh; const size_t row0 = (size_t)b * SEQ + n * 64;
        { const char* src = (const char*)(PROJ + (row0 + wid) * 6144 + 4096 + hh * 512 + lane * 8);
#pragma unroll
          for (int i = 0; i < 8; ++i) __builtin_amdgcn_global_load_lds((const unsigned*)(src + (size_t)i * 8 * 6144 * 2), (MK_LASU*)(lds + RG_OFF + (i * 512 + wid * 64) * 16), 16, 0, 0); }
        f32x16 acc[2][2];
        { const bf16_t* oil = OINT + (row0 + 4 * hi) * DM + hh * 512 + 64 * wid + l32;
#pragma unroll
          for (int mb = 0; mb < 2; ++mb)
#pragma unroll
              for (int nb = 0; nb < 2; ++nb)
#pragma unroll
                  for (int r = 0; r < 16; ++r) acc[mb][nb][r] = bf2f(oil[(size_t)(32 * mb + (r & 3) + 8 * (r >> 2)) * DM + 32 * nb]); }
        bf16x8 vb0[4], vb1[4];
        { const bf16x8* vtp = (const bf16x8*)VT + ((((size_t)bh * 64 + n) * 16 + 2 * wid) * 4) * 64 + lane;
#pragma unroll
          for (int ks = 0; ks < 4; ++ks) { vb0[ks] = vtp[ks * 64]; vb1[ks] = vtp[(4 + ks) * 64]; } }
        const int ti = wid >> 1;
#pragma unroll
        for (int t2 = 0; t2 < 2; ++t2) { const int tj = 2 * (wid & 1) + t2;
            f32x4 c = {0.f, 0.f, 0.f, 0.f};
            if (tj <= ti) {
                const bf16_t* ap = QD + (row0 + 16 * ti + l16) * 1024 + hh * 256 + 8 * q4;
                const bf16_t* bp = KI + (row0 + 16 * tj + l16) * 1024 + hh * 256 + 8 * q4;
#pragma unroll
                for (int st = 0; st < 8; ++st) c = __builtin_amdgcn_mfma_f32_16x16x32_bf16(*(const bf16x8*)(ap + 32 * st), *(const bf16x8*)(bp + 32 * st), c, 0, 0, 0);
            }
#pragma unroll
            for (int r = 0; r < 4; ++r) { const int i = 16 * ti + 4 * q4 + r, jx = 16 * tj + l16; attl[i * 72 + jx] = f2bf(jx <= i ? c[r] : 0.f); } }
        __syncthreads();
#pragma unroll
        for (int ks = 0; ks < 4; ++ks) {
            const bf16x8 a0 = *(const bf16x8*)(attl + l32 * 72 + 16 * ks + 8 * hi), a1 = *(const bf16x8*)(attl + (32 + l32) * 72 + 16 * ks + 8 * hi);
            const bf16x8 b0 = vb0[ks], b1 = vb1[ks];
            acc[0][0] = __builtin_amdgcn_mfma_f32_32x32x16_bf16(a0, b0, acc[0][0], 0, 0, 0); acc[0][1] = __builtin_amdgcn_mfma_f32_32x32x16_bf16(a0, b1, acc[0][1], 0, 0, 0);
            acc[1][0] = __builtin_amdgcn_mfma_f32_32x32x16_bf16(a1, b0, acc[1][0], 0, 0, 0); acc[1][1] = __builtin_amdgcn_mfma_f32_32x32x16_bf16(a1, b1, acc[1][1], 0, 0, 0); }
        float* rssl = rss + wid * 64 + 4 * hi;
#pragma unroll
        for (int mb = 0; mb < 2; ++mb)
#pragma unroll
            for (int r = 0; r < 16; ++r) { const float x0 = acc[mb][0][r], x1 = acc[mb][1][r]; float ss = x0 * x0 + x1 * x1;
                ss += __builtin_bit_cast(float, __builtin_amdgcn_update_dpp(0, __builtin_bit_cast(int, ss), 0x128, 0xf, 0xf, false));
                ss += __builtin_bit_cast(float, __builtin_amdgcn_update_dpp(0, __builtin_bit_cast(int, ss), 0x124, 0xf, 0xf, false));
                ss += __builtin_bit_cast(float, __builtin_amdgcn_update_dpp(0, __builtin_bit_cast(int, ss), 0x122, 0xf, 0xf, false));
                ss += __builtin_bit_cast(float, __builtin_amdgcn_update_dpp(0, __builtin_bit_cast(int, ss), 0x121, 0xf, 0xf, false));
                ss = mk_sum_xor16(ss);
                if (l32 == 0) rssl[32 * mb + (r & 3) + 8 * (r >> 2)] = ss; }
        asm volatile("s_waitcnt vmcnt(0)" ::: "memory");
        __syncthreads();
        if (tid < 64) { float tot = 0.f;
#pragma unroll
            for (int w = 0; w < 8; ++w) tot += rss[w * 64 + tid];
            rstdl[tid] = 1.f / sqrtf(tot * (1.f / 512.f) + RMS_EPS); }
        __syncthreads();
        const float g0 = normg[64 * wid + l32], g1 = normg[64 * wid + 32 + l32];
        const bf16_t* rgl = (const bf16_t*)(lds + RG_OFF) + (4 * hi) * 512 + 64 * wid + l32;
        const float* rsr = rstdl + 4 * hi;
        bf16_t* ogl = OG + (row0 + 4 * hi) * DM + hh * 512 + 64 * wid + l32;
#pragma unroll
        for (int mb = 0; mb < 2; ++mb)
#pragma unroll
            for (int r = 0; r < 16; ++r) { const int rc = 32 * mb + (r & 3) + 8 * (r >> 2);
                const float rstd = rsr[rc];
                const float r0 = bf2f(rgl[rc * 512]), r1 = bf2f(rgl[rc * 512 + 32]);
                ogl[(size_t)rc * DM] = f2bf(acc[mb][0][r] * rstd * g0 * silu_f(r0)); ogl[(size_t)rc * DM + 32] = f2bf(acc[mb][1][r] * rstd * g1 * silu_f(r1)); }
        __syncthreads();
    }
}

__device__ __forceinline__ void phase_conv_core(const bf16_t* PROJ, const float* cw  , bf16_t* OG, int tid) {
    MK_GRID_VARS;
    for (int u = BID; u < MTOK / 64; u += NBLK) {
        const int cg = tid & 255, c0 = 8 * cg, row_start = u * 64 + 32 * (tid >> 8);
        float w[3][8];
#pragma unroll
        for (int k = 0; k < 3; ++k) { const f32x4 a = *(const f32x4*)(cw + k * DM + c0), b = *(const f32x4*)(cw + k * DM + c0 + 4);
#pragma unroll
            for (int e = 0; e < 4; ++e) { w[k][e] = a[e]; w[k][4 + e] = b[e]; } }
        float p2[8], p1[8];
#pragma unroll
        for (int e = 0; e < 8; ++e) { p2[e] = 0.f; p1[e] = 0.f; }
        if ((row_start & (SEQ - 1)) != 0) {
            float c[8], uu[8];
            cvt8(*(const u32x4*)(PROJ + (size_t)(row_start - 2) * 6144 + 2048 + c0), c); cvt8(*(const u32x4*)(PROJ + (size_t)(row_start - 2) * 6144 + 4096 + c0), uu);
#pragma unroll
            for (int e = 0; e < 8; ++e) p2[e] = c[e] * uu[e];
            cvt8(*(const u32x4*)(PROJ + (size_t)(row_start - 1) * 6144 + 2048 + c0), c); cvt8(*(const u32x4*)(PROJ + (size_t)(row_start - 1) * 6144 + 4096 + c0), uu);
#pragma unroll
            for (int e = 0; e < 8; ++e) p1[e] = c[e] * uu[e];
        }
#pragma unroll 4
        for (int r = 0; r < 32; ++r) { const size_t row = (size_t)(row_start + r);
            float gb[8], c[8], uu[8], y[8];
            cvt8(*(const u32x4*)(PROJ + row * 6144 + c0), gb); cvt8(*(const u32x4*)(PROJ + row * 6144 + 2048 + c0), c); cvt8(*(const u32x4*)(PROJ + row * 6144 + 4096 + c0), uu);
#pragma unroll
            for (int e = 0; e < 8; ++e) { const float cu = c[e] * uu[e]; y[e] = gb[e] * (w[0][e] * p2[e] + w[1][e] * p1[e] + w[2][e] * cu); p2[e] = p1[e]; p1[e] = cu; }
            *(u32x4*)(OG + row * DM + c0) = pack8f(y); }
    }
}
__device__ __forceinline__ void phase_ffn_fix(const float* ZH, const float* cw  , const float* cb  , bf16_t* ACT, int tid) {
    MK_GRID_VARS;
    constexpr int NCG = DFF / 8, NIT = (MTOK / 64) * 2 * NCG;
    for (int it = BID * 512 + tid; it < NIT; it += NBLK * 512) {
        const int cg = it % NCG, r = (it / NCG) & 1, blk = it / (2 * NCG), c0 = 8 * cg;
        const bool first = (blk & 63) == 0;
        const float* zb = ZH + (size_t)blk * 4 * 2 * 5632 + c0;
        float y[8];
#pragma unroll
        for (int hq = 0; hq < 2; ++hq) {
            f32x4 za[3], zu[3];
#pragma unroll
            for (int k = 0; k < 3; ++k) { const int s = r + k;
                const bool zero = first && s < 2;
                za[k] = zero ? (f32x4){0.f, 0.f, 0.f, 0.f} : *(const f32x4*)(zb + (size_t)(s * 2) * 5632 + 4 * hq);
                zu[k] = zero ? (f32x4){0.f, 0.f, 0.f, 0.f} : *(const f32x4*)(zb + (size_t)(s * 2 + 1) * 5632 + 4 * hq); }
            f32x4 ya = *(const f32x4*)(cb + c0 + 4 * hq), yu = *(const f32x4*)(cb + DFF + c0 + 4 * hq);
#pragma unroll
            for (int k = 0; k < 3; ++k) { ya += *(const f32x4*)(cw + k * 11264 + c0 + 4 * hq) * za[k]; yu += *(const f32x4*)(cw + k * 11264 + DFF + c0 + 4 * hq) * zu[k]; }
#pragma unroll
            for (int e = 0; e < 4; ++e) y[4 * hq + e] = silu_f(ya[e]) * yu[e]; }
        *(u32x4*)(ACT + (size_t)(blk * 64 + r) * DFF + c0) = pack8f(y);
    }
}

constexpr int PH_FINAL = 65, PH_END = 66;
#ifndef MK_FUSE
#define MK_FUSE 1
#endif
#ifndef MK_DUP
#define MK_DUP 0
#endif
constexpr size_t WS_XD = WS_END, WS_HD = WS_END + 64 * MiB, WS_SKD = WS_END + 128 * MiB, WS_STD = WS_END + 130 * MiB;
__global__ void __launch_bounds__(512, 2) mk_fwd(Args args_) {
    extern __shared__ __attribute__((aligned(16))) unsigned char lds[];
    const int tid0 = threadIdx.x, wid0 = __builtin_amdgcn_readfirstlane(tid0 >> 6);
    const __attribute__((address_space(4))) Args* argp = (const __attribute__((address_space(4))) Args*)__builtin_amdgcn_kernarg_segment_ptr();
    asm volatile("" : "+s"(argp));
#define args (*argp)
    unsigned char* ws = args.ws;
    const int lo = args.ph_lo, hi = args.ph_hi, dummy = args.flags;
    volatile LAS unsigned* MISC = (volatile LAS unsigned*)((LAS unsigned char*)lds + MISC_OFF);
    if (tid0 < 16) MISC[tid0] = 0u;
    __syncthreads();
    XcdBarrier bar; bar.bar = (unsigned*)(ws + WS_CTL) + CW_BAR; bar.x = 0; bar.st = nullptr;
    if (hi - lo > 1) bar = xcd_barrier_post((unsigned*)(ws + WS_CTL) + CW_BAR, MISC, tid0);
#define IN(k) (lo <= (k) && (k) < hi)
#define MK_FUSED_LN(s) (MK_FUSE && gridDim.x == 256 && ((s) == 2 || (s) == 3 || (s) == 4 || (s) == 6))
#define SEAM(k) do { if ((k) + 1 < hi) { XcdBarrier b_ = bar; asm volatile("" : "+s"(b_.bar), "+s"(b_.x)); xcd_barrier(b_, wid0 * 64 + mk_lane()); } } while (0)
#define LOCALS() unsigned char* w = ws; asm volatile("" : "+s"(w)); int wid_ = wid0; asm volatile("" : "+s"(wid_)); int lane_; asm volatile("v_mbcnt_lo_u32_b32 %0, -1, 0\n\tv_mbcnt_hi_u32_b32 %0, -1, %0" : "=&v"(lane_)); const int wid = wid_, lane = lane_, tid = wid * 64 + lane; (void)lane; (void)wid; (void)tid; int BID = blockIdx.x, NBLK = gridDim.x; asm volatile("" : "+s"(BID), "+s"(NBLK)); bf16_t* XB = (bf16_t*)(w + WS_XB); float* MOD = (float*)(w + WS_MOD); float* SK16 = (float*)(w + WS_SK16); float* FB = (float*)(w + WS_FB); float* ELAST = (float*)(w + WS_ELAST); \
    bf16_t* H = (bf16_t*)(w + WS_H); bf16_t* PROJ = (bf16_t*)(w + WS_PROJ); bf16_t* ACT = (bf16_t*)(w + WS_ACT); \
    bf16_t* QD = (bf16_t*)(w + WS_QD); bf16_t* KI = (bf16_t*)(w + WS_KI); bf16_t* KDT = (bf16_t*)(w + WS_KDT); bf16_t* VT = (bf16_t*)(w + WS_VT); bf16_t* OINT = (bf16_t*)(w + WS_OINT); bf16_t* QDF = (bf16_t*)(w + WS_QDF); (void)QDF; \
    (void)XB; (void)MOD; (void)SK16; (void)FB; (void)ELAST; (void)H; (void)PROJ; (void)ACT; (void)QD; (void)KI; (void)KDT; (void)VT; (void)OINT

    if (IN(0)) { LOCALS(); phase_prologue(argp, lds, tid, wid, lane); SEAM(0); }

    if (IN(1)) {
        LOCALS(); const float* modl = MOD;
        const int rep = dummy;
        phase_lnmod<false, true>(args.in[0], nullptr, rep ? (bf16_t*)(w + WS_HD) : H, false, true, args.in[6], args.in[7], modl + 2048, modl, 1, args.in[12], args.in[13], rep ? (float*)(w + WS_SKD) : SK16, (float*)(w + (rep ? WS_STD : WS_ST)), lds, tid, wid, lane);
        SEAM(1);
    }

    for (int sub = 0; sub < 8; ++sub) {
        const int layer = sub >> 1, is_ffn = sub & 1, kind = is_ffn ? 3 : layer % 3, j = layer / 3, base = 1 + 8 * sub;
        if (sub != 0 && IN(base + 0) && !MK_FUSED_LN(sub - 1)) {
            LOCALS(); const float* modl = MOD + (size_t)layer * 4 * 12288;
            const float* lng = is_ffn ? args.in[4] + layer * DM : args.in[6] + (layer - 1) * DM;
            const float* lnb = is_ffn ? args.in[5] + layer * DM : args.in[7] + (layer - 1) * DM;
            const float* sc = modl + (is_ffn ? 8192 : 2048); const float* sh = modl + (is_ffn ? 6144 : 0);
            const int sk = kind == 0 ? 1 : (kind == 1 ? 2 : 0);
            const float* skW = kind == 0 ? args.in[12] + (size_t)j * DM * 16 : args.in[18]; const float* skB = args.in[13] + j * 16;
            const int rep = dummy;
            if (sk) phase_lnmod<true, true>(XB, nullptr, rep ? (bf16_t*)(w + WS_HD) : H, true, true, lng, lnb, sc, sh, sk, skW, skB, rep ? (float*)(w + WS_SKD) : SK16, (float*)(w + (rep ? WS_STD : WS_ST)), lds, tid, wid, lane, (sub & 1) * 4096);
            else phase_lnmod<true, false>(XB, nullptr, rep ? (bf16_t*)(w + WS_HD) : H, true, true, lng, lnb, sc, sh, 0, skW, skB, rep ? (float*)(w + WS_SKD) : SK16, (float*)(w + (rep ? WS_STD : WS_ST)), lds, tid, wid, lane, (sub & 1) * 4096);
            SEAM(base + 0);
        }
        if (IN(base + 1)) {
            LOCALS();
            const bf16_t* Bt; int N;
            if (kind == 0) { Bt = (const bf16_t*)(w + WS_WFOX + (size_t)j * 40 * MiB); N = 8192; fox_cumsum(SK16, FB, wid, lane); }
            else if (kind == 1) { Bt = (const bf16_t*)(w + WS_WGLA); N = 6144; }
            else if (kind == 2) { Bt = (const bf16_t*)(w + WS_WCONV); N = 6144; }
            else { Bt = (const bf16_t*)(w + WS_WUP) + (size_t)layer * 11264 * DM; N = 11264; }
            pg8::Gemm g{H, Bt, MTOK, N, DM}; pg8::StaticOrder S; S.init(MTOK, N, NBLK, BID);
            if (kind == 3) { pg8::EpiFfn E{ACT, (float*)PROJ, args.in[28] + (size_t)layer * 3 * 11264, args.in[29] + (size_t)layer * 11264};
                pg8::gemm_phase<pg8::EpiFfn, pg8::StaticOrder, true, true>((LAS unsigned char*)lds, g, S, E, tid); }
            else { pg8::EpiStore E{PROJ, N, kind == 0 ? 1 : 0, (float*)(w + WS_N2P)};
                pg8::gemm_phase<pg8::EpiStore, pg8::StaticOrder, true, true>((LAS unsigned char*)lds, g, S, E, tid); }
            SEAM(base + 1);
        }
        if (kind == 0) {
            if (IN(base + 2)) { LOCALS(); phase_fox_attn(PROJ, FB, (const float*)(w + WS_N2P), ACT, (char*)lds, tid); SEAM(base + 2); }
        } else if (kind == 1) {
            if (IN(base + 2)) { LOCALS(); phase_gla_prep(PROJ, SK16, args.in[19], args.in[20], QD, QDF, KI, KDT, VT, ELAST, lds, tid); SEAM(base + 2); }
            if (IN(base + 3)) { LOCALS(); phase_gla_scan(QDF, KDT, VT, ELAST, OINT, lds, tid, wid, lane); SEAM(base + 3); }
            if (IN(base + 4)) { LOCALS(); phase_gla_intra(PROJ, QD, KI, VT, OINT, args.in[22], ACT, lds, tid, wid, lane); SEAM(base + 4); }
        } else if (kind == 2) {
            if (IN(base + 2)) { LOCALS(); phase_conv_core(PROJ, args.in[25], ACT, tid); SEAM(base + 2); }
        } else {
            if (IN(base + 2)) { LOCALS(); phase_ffn_fix((const float*)PROJ, args.in[28] + (size_t)layer * 3 * 11264, args.in[29] + (size_t)layer * 11264, ACT, tid); SEAM(base + 2); }
        }
        if (IN(base + 5)) {
            LOCALS(); const float* modl = MOD + (size_t)layer * 4 * 12288;
            const bf16_t* Bt; int K;
            if (kind == 0) { Bt = (const bf16_t*)(w + WS_WFOX + (size_t)j * 40 * MiB) + (size_t)8192 * DM; K = DM; }
            else if (kind == 1) { Bt = (const bf16_t*)(w + WS_WGLA) + (size_t)6144 * DM; K = DM; }
            else if (kind == 2) { Bt = (const bf16_t*)(w + WS_WCONV) + (size_t)6144 * DM; K = DM; }
            else { Bt = (const bf16_t*)(w + WS_WDOWN) + (size_t)layer * DM * DFF; K = DFF; }
            const bool fuse = MK_FUSED_LN(sub);
            pg8::Gemm g{ACT, Bt, MTOK, DM, K}; pg8::StaticOrder S; S.init(MTOK, DM, NBLK, BID, fuse ? 1 : 0);
            if (fuse) {
                const int sn = sub + 1, ln_ = sn >> 1, fn_ = sn & 1;
                const float* lngn = fn_ ? args.in[4] + ln_ * DM : args.in[6] + (ln_ - 1) * DM; const float* lnbn = fn_ ? args.in[5] + ln_ * DM : args.in[7] + (ln_ - 1) * DM;
                if (BID == 0) { float* st = (float*)(w + WS_ST); for (int i = wid * 64 + mk_lane(); i < DM; i += 512) { st[2 * MTOK + (sn & 1) * 4096 + i] = DN_ALPHA * lngn[i]; st[2 * MTOK + (sn & 1) * 4096 + DM + i] = DN_ALPHA * lnbn[i]; } }
                pg8::EpiResidLN E{w, lngn, lnbn, layer * 4 * 12288 + (is_ffn ? 10240 : 4096), ln_ * 4 * 12288 + (fn_ ? 8192 : 2048), ln_ * 4 * 12288 + (fn_ ? 6144 : 0), (sub & 1) * 4096, sub};
                pg8::gemm_phase<pg8::EpiResidLN, pg8::StaticOrder, true, true>((LAS unsigned char*)lds, g, S, E, wid * 64 + mk_lane());
            } else
            { pg8::EpiResid E{sub == 0 ? (const void*)args.in[0] : (const void*)XB, dummy ? (bf16_t*)(w + WS_XD) : XB, modl + (is_ffn ? 10240 : 4096), (sub == 0 ? 1 : 0) | (((sub & 1) * 4096) << 1), (const float*)(w + WS_ST)};
                pg8::gemm_phase<pg8::EpiResid, pg8::StaticOrder, true, true>((LAS unsigned char*)lds, g, S, E, wid * 64 + mk_lane()); }
            SEAM(base + 5);
        }
    }
    if (IN(PH_FINAL)) { LOCALS(); phase_lnmod<true, false>(XB, dummy ? (float*)(w + WS_PROJ) : args.out, H, true, false, args.in[6] + 3 * DM, args.in[7] + 3 * DM, nullptr, nullptr, 0, nullptr, nullptr, nullptr, nullptr, lds, tid, wid, lane); }
#undef LOCALS
#undef IN
#undef SEAM
#undef args
}

extern "C" void kernel_launch(void* const* d_in, const int* in_sizes, int n_in, void* d_out, int out_size, void* d_ws, size_t ws_size, hipStream_t stream) {
    static int grid = 0;
    if (grid == 0) {
        if (n_in != 31 || in_sizes[0] != MTOK * DM || out_size != MTOK * DM || ws_size < WS_END + (MK_DUP ? 136 * MiB : 0)) {
            fprintf(stderr, "kernel_launch: built for 31 inputs, x/out of %d floats, >= %zu bytes of workspace; got n_in %d, in0 %d, out %d, ws %zu; nothing launched\n", MTOK * DM, (size_t)WS_END, n_in, n_in > 0 ? in_sizes[0] : -1, out_size, ws_size);
            grid = -1; return; }
        int dev = 0, cus = 0, per_cu = 0;
        if (hipGetDevice(&dev) != hipSuccess || hipDeviceGetAttribute(&cus, hipDeviceAttributeMultiprocessorCount, dev) != hipSuccess) { fprintf(stderr, "kernel_launch: device query failed\n"); grid = -1; return; }
        if (hipFuncSetAttribute((const void*)mk_fwd, hipFuncAttributeMaxDynamicSharedMemorySize, LDS_TOTAL) != hipSuccess) { fprintf(stderr, "kernel_launch: hipFuncSetAttribute(%d B LDS) failed\n", LDS_TOTAL); grid = -1; return; }
        if (hipOccupancyMaxActiveBlocksPerMultiprocessor(&per_cu, (const void*)mk_fwd, 512, LDS_TOTAL) != hipSuccess || per_cu < 1)
            fprintf(stderr, "kernel_launch: note: occupancy query reports %d workgroups per CU\n", per_cu);
        (void)hipGetLastError();
        grid = cus;
    }
    if (grid < 0) return;
    if (hipMemsetAsync((char*)d_ws + WS_CTL, 0, CTL_ZERO_BYTES, stream) != hipSuccess) { fprintf(stderr, "kernel_launch: memset failed\n"); return; }
    if (hipMemsetAsync((char*)d_ws + WS_PART, 0, PART_BYTES, stream) != hipSuccess) { fprintf(stderr, "kernel_launch: memset failed\n"); return; }
    Args a{};
    for (int i = 0; i < 31; ++i) a.in[i] = (const float*)d_in[i];
    a.out = (float*)d_out; a.ws = (unsigned char*)d_ws;
#if MK_PER_PHASE
    for (int ph = 0; ph < PH_END; ++ph) {
        int group = 64;
        if (ph > 0 && ph < PH_FINAL) { const int sub = (ph - 1) >> 3, loc = (ph - 1) & 7, kind = (sub & 1) ? 3 : (sub >> 1) % 3;
            const bool exists = loc <= 2 || loc == 5 || (kind == 1 && loc <= 4); if (!exists) continue;
            group = loc == 0 ? 4 : loc == 1 ? (1 | (kind == 3 ? 512 : 1024)) : loc == 5 ? (2 | (kind == 3 ? 128 : 256)) : (kind == 0 ? 8 : kind == 1 ? (16 | (loc == 2 ? 2048 : loc == 3 ? 4096 : 8192)) : 32); }
        if (ph == PH_FINAL) group = 4;
        a.ph_lo = ph; a.ph_hi = ph + 1; a.flags = 0;
        hipLaunchKernelGGL(mk_fwd, dim3(grid), dim3(512), LDS_TOTAL, stream, a);
        if ((MK_DUP & group) == (MK_DUP & -MK_DUP) && (MK_DUP & group)) { a.flags = 1; hipLaunchKernelGGL(mk_fwd, dim3(grid), dim3(512), LDS_TOTAL, stream, a); }
    }
#else
    a.ph_lo = 0; a.ph_hi = PH_END;
    hipLaunchKernelGGL(mk_fwd, dim3(grid), dim3(512), LDS_TOTAL, stream, a);
#endif
    const hipError_t le = hipPeekAtLastError();
    if (le != hipSuccess) fprintf(stderr, "kernel_launch: launch failed: %s (grid %d)\n", hipGetErrorName(le), grid);
}
```
